# Optimizing an MI355X kernel written in HIP

```python
import math
import jax, jax.numpy as jnp
from jax import lax
import numpy as np

D_MODEL = 1024
BATCH = 8
SEQ = 2048
DEPTH = 2
DEC_BATCH = 128
DEC_SEQ = 8
PAST_LEN = 16384
PAGE_SIZE = 128

N_EVEN = (DEPTH + 1) // 2
N_ODD = DEPTH // 2
RWKV_HEADS = 8
RWKV_HEAD = 64
RWKV_W = RWKV_HEADS * RWKV_HEAD
DECAY_LORA = 64
AAA_LORA = 64
GATE_LORA = 128
RWKV_PROJ = 3 * RWKV_W + DECAY_LORA + AAA_LORA + GATE_LORA
RWKV_SPLITS = [RWKV_W, 2 * RWKV_W, 3 * RWKV_W, 3 * RWKV_W + DECAY_LORA, 3 * RWKV_W + DECAY_LORA + AAA_LORA]
GN_EPS = 64e-5
GLA_HEADS = 4
GLA_DK = 64
GLA_DV = 128
GLA_K = GLA_HEADS * GLA_DK
GLA_V = GLA_HEADS * GLA_DV
GLA_GATE_LORA = 16
GLA_TAU = 16.0
GLA_CHUNK = 32
GLA_PROJ = 2 * GLA_K + 2 * GLA_V + GLA_GATE_LORA
GLA_SPLITS = [GLA_K, 2 * GLA_K, 2 * GLA_K + GLA_V, 2 * GLA_K + GLA_V + GLA_GATE_LORA]
MIX_IN = RWKV_PROJ + GLA_PROJ
MIX_OUT = RWKV_W + GLA_V
S5_WIDTH = D_MODEL
S5_GROUP = 16
S5_GROUPS = S5_WIDTH // S5_GROUP
S5_STATE = 64
DT_MIN = 1e-3
DT_MAX = 1e-1
D_FF = 4 * D_MODEL
NORM_EPS = 1e-6

kernel_name = 'hybrid_rwkv7_gla_s5_decode_step'


def rmsnorm(x, g):
    xf = x.astype(jnp.float32)
    y = xf * lax.rsqrt(jnp.mean(xf * xf, axis=-1, keepdims=True) + NORM_EPS)
    return (y * g.astype(jnp.float32)).astype(x.dtype)


def rwkv7_mix(p, shift0, S0, mix, w0, w2, a0, a2, g2, k_k, k_a, r_k, gn_g, gn_b):
    B, T, _ = p.shape
    prev = jnp.concatenate([shift0[:, None, :].astype(jnp.float32), p[:, :-1]], axis=1)
    z = p + (prev - p) * mix
    r, k, v, xw, xa, xg = jnp.split(z, RWKV_SPLITS, axis=-1)
    w = -jax.nn.softplus(-(w0 + jnp.tanh(xw) @ w2)) - 0.5
    decay = jnp.exp(-jnp.exp(w))
    a = jax.nn.sigmoid(a0 + xa @ a2)
    g = jax.nn.sigmoid(xg) @ g2
    heads = lambda t: t.reshape(B, T, RWKV_HEADS, RWKV_HEAD)
    kk = heads(k * k_k)
    kk = kk * lax.rsqrt(jnp.maximum(jnp.sum(kk * kk, axis=-1, keepdims=True), 1e-24))
    k = k * (1.0 + (a - 1.0) * k_a)
    rh, kh, vh, wh, ah = heads(r), heads(k), heads(v), heads(decay), heads(a)

    def step(S, inp):
        r_t, w_t, k_t, v_t, kk_t, a_t = inp
        s_kk = jnp.einsum('bhij,bhj->bhi', S, kk_t)
        S = (S * w_t[:, :, None, :]
             - s_kk[..., None] * (kk_t * a_t)[:, :, None, :]
             + v_t[..., None] * k_t[:, :, None, :])
        return S, jnp.einsum('bhij,bhj->bhi', S, r_t)

    xs = tuple(jnp.moveaxis(t, 1, 0) for t in (rh, wh, kh, vh, kk, ah))
    S_T, y = lax.scan(step, S0.astype(jnp.float32), xs)
    y = jnp.moveaxis(y, 0, 1)
    mean_y = jnp.mean(y, axis=-1, keepdims=True)
    var_y = jnp.mean(jnp.square(y - mean_y), axis=-1, keepdims=True)
    yn = ((y - mean_y) * lax.rsqrt(var_y + GN_EPS)).reshape(B, T, RWKV_W) * gn_g + gn_b
    bonus = jnp.sum(rh * kh * r_k.reshape(RWKV_HEADS, RWKV_HEAD), axis=-1, keepdims=True) * vh
    out = (yn + bonus.reshape(B, T, RWKV_W)) * g
    return out, p[:, -1], S_T


def gla_chunked(q, k, v, gk, S0):
    B, T, H, DK = q.shape
    DV = v.shape[-1]
    C = min(GLA_CHUNK, T)
    pad = (-T) % C
    if pad:
        padt = lambda t: jnp.pad(t, ((0, 0), (0, pad), (0, 0), (0, 0)))
        q, k, v, gk = padt(q), padt(k), padt(v), padt(gk)
    Tp = T + pad
    n = Tp // C
    blk = lambda t: t.reshape(B, n, C, H, t.shape[-1]).transpose(1, 0, 2, 3, 4)
    qc, kc, vc, gc = blk(q), blk(k), blk(v), blk(gk)
    bc = jnp.cumsum(gc, axis=2)
    b_last = bc[:, :, -1]
    q_t = qc * jnp.exp(bc)
    k_t = kc * jnp.exp(-bc)
    k_s = kc * jnp.exp(b_last[:, :, None] - bc)
    mask = jnp.tril(jnp.ones((C, C), dtype=bool))
    att = jnp.where(mask, jnp.einsum('nbihd,nbjhd->nbhij', q_t, k_t), 0.0)
    o_intra = jnp.einsum('nbhij,nbjhv->nbihv', att, vc)

    def step(S, inp):
        q_n, k_n, v_n, bl = inp
        o = jnp.einsum('bihd,bhdv->bihv', q_n, S)
        S = jnp.exp(bl)[..., None] * S + jnp.einsum('bjhd,bjhv->bhdv', k_n, v_n)
        return S, o

    S_T, o_inter = lax.scan(step, S0, (q_t, k_s, vc, b_last))
    o = (o_intra + o_inter).transpose(1, 0, 2, 3, 4).reshape(B, Tp, H, DV)[:, :T]
    return o, S_T


def gla_mix(p, S0, wa2, ba, g_norm):
    B, T, _ = p.shape
    q, k, v, xa, gz = jnp.split(p, GLA_SPLITS, axis=-1)
    gk = jax.nn.log_sigmoid(xa @ wa2 + ba) / GLA_TAU
    q = q * GLA_DK ** -0.5
    hk = lambda t: t.reshape(B, T, GLA_HEADS, GLA_DK)
    o, S_T = gla_chunked(hk(q), hk(k), v.reshape(B, T, GLA_HEADS, GLA_DV), hk(gk), S0.astype(jnp.float32))
    o = o * lax.rsqrt(jnp.mean(o * o, axis=-1, keepdims=True) + NORM_EPS) * g_norm
    o = o.reshape(B, T, GLA_V) * jax.nn.silu(gz)
    return o, S_T


def _cplx_affine_combine(left, right):
    ar1, ai1, br1, bi1 = left
    ar2, ai2, br2, bi2 = right
    return (ar2 * ar1 - ai2 * ai1, ar2 * ai1 + ai2 * ar1,
            ar2 * br1 - ai2 * bi1 + br2, ar2 * bi1 + ai2 * br1 + bi2)


def s5_scan(u, x0_re, x0_im, lam_re, lam_im, log_dt, b_re, b_im, c_re, c_im, d_skip):
    B, T, E = u.shape
    uf = u.astype(jnp.float32)
    ug = uf.reshape(B, T, S5_GROUPS, S5_GROUP)
    dt = jnp.exp(log_dt.astype(jnp.float32))[:, None]
    lr = lam_re.astype(jnp.float32)
    li = lam_im.astype(jnp.float32)
    mag = jnp.exp(lr * dt)
    ang = li * dt
    ab_re, ab_im = mag * jnp.cos(ang), mag * jnp.sin(ang)
    den = lr * lr + li * li
    f_re = ((ab_re - 1.0) * lr + ab_im * li) / den
    f_im = (ab_im * lr - (ab_re - 1.0) * li) / den
    bb_re = f_re[..., None] * b_re - f_im[..., None] * b_im
    bb_im = f_re[..., None] * b_im + f_im[..., None] * b_re
    e_re = jnp.einsum('btgc,gpc->tbgp', ug, bb_re)
    e_im = jnp.einsum('btgc,gpc->tbgp', ug, bb_im)
    x0r = x0_re.astype(jnp.float32)
    x0i = x0_im.astype(jnp.float32)
    e_re = e_re.at[0].add(ab_re * x0r - ab_im * x0i)
    e_im = e_im.at[0].add(ab_re * x0i + ab_im * x0r)
    a_re = jnp.broadcast_to(ab_re, (T, 1) + ab_re.shape)
    a_im = jnp.broadcast_to(ab_im, (T, 1) + ab_im.shape)
    _, _, s_re, s_im = lax.associative_scan(_cplx_affine_combine, (a_re, a_im, e_re, e_im), axis=0)
    y = jnp.einsum('tbgp,gcp->btgc', s_re, c_re) - jnp.einsum('tbgp,gcp->btgc', s_im, c_im)
    y = y.reshape(B, T, E) + d_skip * uf
    return y, s_re[-1], s_im[-1]


def even_mixer(h, shift0, wkv0, gla0, prm, i):
    p = jnp.matmul(h, prm['w_mix_in'][i]).astype(jnp.float32)
    o_r, sh, wkv = rwkv7_mix(p[..., :RWKV_PROJ], shift0, wkv0, prm['rwkv_mu'][i], prm['rwkv_w0'][i],
                             prm['rwkv_w2'][i], prm['rwkv_a0'][i], prm['rwkv_a2'][i], prm['rwkv_g2'][i],
                             prm['rwkv_k_k'][i], prm['rwkv_k_a'][i], prm['rwkv_r_k'][i],
                             prm['rwkv_gn_g'][i], prm['rwkv_gn_b'][i])
    o_g, gl = gla_mix(p[..., RWKV_PROJ:], gla0, prm['gla_wa2'][i], prm['gla_ba'][i], prm['gla_norm'][i])
    o = jnp.concatenate([o_r, o_g], axis=-1).astype(h.dtype)
    return jnp.matmul(o, prm['w_mix_out'][i]), sh, wkv, gl


def odd_mixer(h, s_re0, s_im0, prm, i):
    u = jnp.matmul(h, prm['s5_w_in'][i])
    y, s_re, s_im = s5_scan(u, s_re0, s_im0, prm['s5_lam_re'][i], prm['s5_lam_im'][i], prm['s5_log_dt'][i],
                            prm['s5_b_re'][i], prm['s5_b_im'][i], prm['s5_c_re'][i], prm['s5_c_im'][i],
                            prm['s5_d'][i])
    zo = jnp.matmul(jax.nn.gelu(y).astype(h.dtype), prm['s5_w_out'][i])
    out = zo[..., :D_MODEL] * jax.nn.sigmoid(zo[..., D_MODEL:])
    return out, s_re, s_im


def trunk(x, st_shift, st_wkv, st_gla, st_re, st_im, prm):
    new_shift, new_wkv, new_gla, new_re, new_im = [], [], [], [], []
    for layer in range(DEPTH):
        i = layer // 2
        h = rmsnorm(x, prm['norm_mix_pre'][layer])
        if layer % 2 == 0:
            m, sh, wkv, gl = even_mixer(h, st_shift[i], st_wkv[i], st_gla[i], prm, i)
            new_shift.append(sh)
            new_wkv.append(wkv)
            new_gla.append(gl)
        else:
            m, sre, sim = odd_mixer(h, st_re[i], st_im[i], prm, i)
            new_re.append(sre)
            new_im.append(sim)
        x = x + rmsnorm(m, prm['norm_mix_post'][layer])
        h = rmsnorm(x, prm['norm_ffn_pre'][layer])
        f = jnp.matmul(jnp.square(jax.nn.relu(jnp.matmul(h, prm['w_ff_up'][layer]))), prm['w_ff_down'][layer])
        x = x + rmsnorm(f, prm['norm_ffn_post'][layer])
    st = lambda lst: jnp.stack(lst).astype(x.dtype)
    return x, st(new_shift), st(new_wkv), st(new_gla), st(new_re), st(new_im)


def setup_inputs(seed: int = 0) -> dict:
    key = jax.random.key(seed)
    keys = iter(jax.random.split(key, 64))

    def nrm(shape, scale):
        return jax.random.normal(next(keys), shape, jnp.float32) * scale

    def gain(shape):
        return 1.0 + nrm(shape, 0.02)

    def unif(shape, lo, hi):
        return jax.random.uniform(next(keys), shape, jnp.float32, minval=lo, maxval=hi)

    E, L = N_EVEN, N_ODD
    G, P = S5_GROUPS, S5_STATE
    inp = {}
    inp['x_prompt'] = nrm((BATCH, SEQ, D_MODEL), 1.0)
    inp['x_sample'] = nrm((DEC_BATCH, DEC_SEQ, D_MODEL), 1.0)
    inp['state_rwkv_shift'] = nrm((E, DEC_BATCH, RWKV_PROJ), 1.0)
    inp['state_rwkv_wkv'] = nrm((E, DEC_BATCH, RWKV_HEADS, RWKV_HEAD, RWKV_HEAD), 0.5)
    inp['state_gla'] = nrm((E, DEC_BATCH, GLA_HEADS, GLA_DK, GLA_DV), 0.5)
    inp['state_s5_re'] = nrm((L, DEC_BATCH, G, P), 0.5)
    inp['state_s5_im'] = nrm((L, DEC_BATCH, G, P), 0.5)
    inp['norm_mix_pre'] = gain((DEPTH, D_MODEL))
    inp['norm_mix_post'] = gain((DEPTH, D_MODEL))
    inp['norm_ffn_pre'] = gain((DEPTH, D_MODEL))
    inp['norm_ffn_post'] = gain((DEPTH, D_MODEL))
    inp['w_mix_in'] = nrm((E, D_MODEL, MIX_IN), D_MODEL ** -0.5)
    inp['w_mix_out'] = nrm((E, MIX_OUT, D_MODEL), MIX_OUT ** -0.5)
    inp['rwkv_mu'] = unif((E, RWKV_PROJ), 0.0, 1.0)
    inp['rwkv_w0'] = unif((E, RWKV_W), -6.0, -1.0)
    inp['rwkv_w2'] = nrm((E, DECAY_LORA, RWKV_W), 0.1)
    inp['rwkv_a0'] = nrm((E, RWKV_W), 0.1)
    inp['rwkv_a2'] = nrm((E, AAA_LORA, RWKV_W), 0.1)
    inp['rwkv_g2'] = nrm((E, GATE_LORA, RWKV_W), GATE_LORA ** -0.5)
    inp['rwkv_k_k'] = 0.85 + nrm((E, RWKV_W), 0.02)
    inp['rwkv_k_a'] = 1.0 + nrm((E, RWKV_W), 0.02)
    inp['rwkv_r_k'] = nrm((E, RWKV_W), 0.1)
    inp['rwkv_gn_g'] = gain((E, RWKV_W))
    inp['rwkv_gn_b'] = nrm((E, RWKV_W), 0.02)
    inp['gla_wa2'] = nrm((E, GLA_GATE_LORA, GLA_K), GLA_GATE_LORA ** -0.5)
    inp['gla_ba'] = nrm((E, GLA_K), 0.1)
    inp['gla_norm'] = gain((E, GLA_DV))
    inp['s5_w_in'] = nrm((L, D_MODEL, S5_WIDTH), D_MODEL ** -0.5)
    inp['s5_lam_re'] = -0.5 + nrm((L, G, P), 0.01)
    inp['s5_lam_im'] = math.pi * jnp.arange(P, dtype=jnp.float32)[None, None, :] + nrm((L, G, P), 0.01)
    inp['s5_log_dt'] = unif((L, G), math.log(DT_MIN), math.log(DT_MAX))
    inp['s5_b_re'] = nrm((L, G, P, S5_GROUP), (2.0 * S5_GROUP) ** -0.5)
    inp['s5_b_im'] = nrm((L, G, P, S5_GROUP), (2.0 * S5_GROUP) ** -0.5)
    inp['s5_c_re'] = nrm((L, G, S5_GROUP, P), (2.0 * P) ** -0.5)
    inp['s5_c_im'] = nrm((L, G, S5_GROUP, P), (2.0 * P) ** -0.5)
    inp['s5_d'] = nrm((L, S5_WIDTH), 1.0)
    inp['s5_w_out'] = nrm((L, S5_WIDTH, 2 * D_MODEL), S5_WIDTH ** -0.5)
    inp['w_ff_up'] = nrm((DEPTH, D_MODEL, D_FF), D_MODEL ** -0.5)
    inp['w_ff_down'] = nrm((DEPTH, D_FF, D_MODEL), D_FF ** -0.5)
    return inp


def reference(x_prompt, x_sample, state_rwkv_shift, state_rwkv_wkv, state_gla, state_s5_re, state_s5_im,
              norm_mix_pre, norm_mix_post, norm_ffn_pre, norm_ffn_post,
              w_mix_in, w_mix_out, rwkv_mu, rwkv_w0, rwkv_w2, rwkv_a0, rwkv_a2, rwkv_g2,
              rwkv_k_k, rwkv_k_a, rwkv_r_k, rwkv_gn_g, rwkv_gn_b, gla_wa2, gla_ba, gla_norm,
              s5_w_in, s5_lam_re, s5_lam_im, s5_log_dt, s5_b_re, s5_b_im, s5_c_re, s5_c_im, s5_d, s5_w_out,
              w_ff_up, w_ff_down):
    prm = dict(norm_mix_pre=norm_mix_pre, norm_mix_post=norm_mix_post, norm_ffn_pre=norm_ffn_pre,
               norm_ffn_post=norm_ffn_post, w_mix_in=w_mix_in, w_mix_out=w_mix_out, rwkv_mu=rwkv_mu,
               rwkv_w0=rwkv_w0, rwkv_w2=rwkv_w2, rwkv_a0=rwkv_a0, rwkv_a2=rwkv_a2, rwkv_g2=rwkv_g2,
               rwkv_k_k=rwkv_k_k, rwkv_k_a=rwkv_k_a, rwkv_r_k=rwkv_r_k, rwkv_gn_g=rwkv_gn_g,
               rwkv_gn_b=rwkv_gn_b, gla_wa2=gla_wa2, gla_ba=gla_ba, gla_norm=gla_norm,
               s5_w_in=s5_w_in, s5_lam_re=s5_lam_re, s5_lam_im=s5_lam_im, s5_log_dt=s5_log_dt,
               s5_b_re=s5_b_re, s5_b_im=s5_b_im, s5_c_re=s5_c_re, s5_c_im=s5_c_im, s5_d=s5_d,
               s5_w_out=s5_w_out, w_ff_up=w_ff_up, w_ff_down=w_ff_down)
    Bp = x_prompt.shape[0]
    dt_p = x_prompt.dtype
    z_shift = jnp.zeros((N_EVEN, Bp) + state_rwkv_shift.shape[2:], dt_p)
    z_wkv = jnp.zeros((N_EVEN, Bp) + state_rwkv_wkv.shape[2:], dt_p)
    z_gla = jnp.zeros((N_EVEN, Bp) + state_gla.shape[2:], dt_p)
    z_re = jnp.zeros((N_ODD, Bp) + state_s5_re.shape[2:], dt_p)
    z_im = jnp.zeros((N_ODD, Bp) + state_s5_im.shape[2:], dt_p)
    y_prompt, sh_p, wkv_p, gla_p, re_p, im_p = trunk(x_prompt, z_shift, z_wkv, z_gla, z_re, z_im, prm)
    y_sample, sh_s, wkv_s, gla_s, re_s, im_s = trunk(x_sample, state_rwkv_shift, state_rwkv_wkv, state_gla,
                                                     state_s5_re, state_s5_im, prm)
    return (y_prompt, y_sample, sh_p, sh_s, wkv_p, wkv_s, gla_p, gla_s, re_p, re_s, im_p, im_s)
```

```cpp
#include <hip/hip_runtime.h>
#include <cstdio>
#include <cstdint>
#define MK_N_LAUNCHES 17
namespace pg8 {
#define PG8_LAS __attribute__((address_space(3)))
typedef unsigned short bf16_t;
typedef short bf16x8 __attribute__((ext_vector_type(8)));
typedef float f32x4 __attribute__((ext_vector_type(4)));
typedef unsigned u32x4 __attribute__((ext_vector_type(4)));
constexpr int BM = 256, BK = 64, HALF = 128, HTB = HALF * BK * 2  , STAGE_BYTES = 8 * HTB, NXCD = 8, WGM = 8;

__host__ __device__ __forceinline__ int lds_byte(int r, int c) { const int st = (r >> 4) * 2 + (c >> 5), rr = r & 15, cc = c & 31, ob = rr * 64 + cc * 2; return st * 1024 + (ob ^ (((ob >> 9) & 1) << 5)); }
__host__ __device__ __forceinline__ void stage_rc(int b, int& R, int& C) { const int st = b / 1024, sb = b % 1024, swz = sb ^ (((sb >> 9) & 1) << 5); R = (st >> 1) * 16 + swz / 64; C = (st & 1) * 32 + (swz % 64) / 2; }
__host__ __device__ __forceinline__ int perm32(int rho) { const int n = rho >> 4, i = rho & 15; return 8 * (i >> 2) + 4 * n + (i & 3); }

struct Unit { int pm, pn; };
struct Gemm { const bf16_t* A; const bf16_t* Bt; int M, N, K; };

struct StaticOrder {
    int nM, nN, nwg, G, c;
    __host__ __device__ void init(int M, int N, int G_, int c_) { nM = M / BM; nN = N / BM; nwg = nM * nN; G = G_; c = c_; }
    __host__ __device__ bool next(int i, Unit& u) const {
        const long L = (long)i * G + c; if (L >= nwg) return false;
        int wgid = (int)L; { const int q = nwg / NXCD, r = nwg % NXCD, xcd = wgid % NXCD, off = wgid / NXCD; wgid = (xcd < r ? xcd * (q + 1) : r * (q + 1) + (xcd - r) * q) + off; }
        const int nig = WGM * nN, gid = wgid / nig, fm = gid * WGM, gsz = (nM - fm) < WGM ? (nM - fm) : WGM;
        u.pm = fm + ((wgid % nig) % gsz); u.pn = (wgid % nig) / gsz; return true;
    }
    __device__ __forceinline__ void a_ready(const Unit&) const {}
    __device__ __forceinline__ void done(const Unit&) const {}
};

__device__ __forceinline__ unsigned cvt_pk_bf16(float lo, float hi) { unsigned r; asm volatile("v_cvt_pk_bf16_f32 %0, %1, %2" : "=v"(r) : "v"(lo), "v"(hi)); return r; }
typedef float f32x2 __attribute__((ext_vector_type(2)));
template <int ACT> struct EpiBf16 {
    static constexpr bool PERM = true, AFTER_DRAIN = false;
    bf16_t* O; int ldc;
    __device__ __forceinline__ void operator()(const f32x4 (&acc)[2][2][4][2], const Unit& u, int wr, int wc, int fr, int fq) const {
        const int row0 = u.pm * BM + wr * 64 + fr; const int col0 = u.pn * BM + wc * 32 + 8 * fq;
#pragma unroll
        for (int ai = 0; ai < 2; ++ai)
#pragma unroll
            for (int m = 0; m < 4; ++m) { bf16_t* rowp = O + (size_t)(row0 + ai * HALF + m * 16) * ldc + col0;
#pragma unroll
                for (int bj = 0; bj < 2; ++bj) { f32x4 v0 = acc[ai][bj][m][0], v1 = acc[ai][bj][m][1];
                    if (ACT == 3) {
#pragma unroll
                        for (int j = 0; j < 4; ++j) { const float a = fmaxf(v0[j], 0.f), b = fmaxf(v1[j], 0.f); v0[j] = a * a; v1[j] = b * b; } }
                    u32x4 w; w.x = cvt_pk_bf16(v0[0], v0[1]); w.y = cvt_pk_bf16(v0[2], v0[3]); w.z = cvt_pk_bf16(v1[0], v1[1]); w.w = cvt_pk_bf16(v1[2], v1[3]);
                    *(u32x4*)(rowp + bj * HALF) = w; } }
    }
};
struct EpiF32 {
    static constexpr bool PERM = false, AFTER_DRAIN = false;
    float* C; int ldc;
    __device__ __forceinline__ void operator()(const f32x4 (&acc)[2][2][4][2], const Unit& u, int wr, int wc, int fr, int fq) const {
        const int row0 = u.pm * BM + wr * 64 + fr, col0 = u.pn * BM + wc * 32 + 4 * fq;
#pragma unroll
        for (int ai = 0; ai < 2; ++ai)
#pragma unroll
            for (int m = 0; m < 4; ++m) { float* rowp = C + (size_t)(row0 + ai * HALF + m * 16) * ldc + col0;
#pragma unroll
                for (int bj = 0; bj < 2; ++bj)
#pragma unroll
                    for (int n = 0; n < 2; ++n) *(f32x4*)(rowp + bj * HALF + n * 16) = acc[ai][bj][m][n]; }
    }
};
struct EpiGlu {
    static constexpr bool PERM = false, AFTER_DRAIN = false;
    float* C; int ldc;
    __device__ __forceinline__ void operator()(const f32x4 (&acc)[2][2][4][2], const Unit& u, int wr, int wc, int fr, int fq) const {
        const int row0 = u.pm * BM + wr * 64 + fr, col0 = u.pn * HALF + wc * 32 + 4 * fq;
#pragma unroll
        for (int ai = 0; ai < 2; ++ai)
#pragma unroll
            for (int m = 0; m < 4; ++m) { float* rowp = C + (size_t)(row0 + ai * HALF + m * 16) * ldc + col0;
#pragma unroll
                for (int n = 0; n < 2; ++n) { const f32x4 v = acc[ai][0][m][n], g = acc[ai][1][m][n]; f32x4 o;
#pragma unroll
                    for (int j = 0; j < 4; ++j) o[j] = v[j] / (1.0f + __expf(-g[j]));
                    *(f32x4*)(rowp + n * 16) = o; } }
    }
};

template <class Epi, class Sched, bool ALIGN_EPI = false, bool SP2 = false>
__device__ __forceinline__ void gemm_phase(PG8_LAS unsigned char* lds, const Gemm g, const Sched& S, const Epi& E) {
    const int tid = threadIdx.x, wid = __builtin_amdgcn_readfirstlane(tid >> 6), lane = tid & 63, wr = wid >> 2, wc = wid & 3, fr = lane & 15, fq = lane >> 4;
    const int K = g.K, nt = K / BK;
    unsigned voffA[2], voffB[2];
#pragma unroll
    for (int i = 0; i < 2; ++i) { int R, C; stage_rc(tid * 16 + i * 8192, R, C); const int Rb = Epi::PERM ? ((R & ~31) + perm32(R & 31)) : R;
        voffA[i] = (unsigned)(R * K + C) * 2u; voffB[i] = (unsigned)(Rb * K + C) * 2u; }
    const size_t kstep = (size_t)(BK * 2);
    const size_t hstep = (size_t)HALF * K * 2;
    const size_t tstep = 2 * hstep;
    const unsigned ldsw = (unsigned)wid * 1024u;
    const int aoff = lds_byte(wr * 64 + fr, fq * 8), boff = lds_byte(wc * 32 + fr, fq * 8);
#define PG8_SA(b, h) (((b) * 2 + (h)) * HTB)
#define PG8_SB(b, h) ((4 + (b) * 2 + (h)) * HTB)
#define PG8_STAGE(bufoff, gbase, voff) do { _Pragma("unroll") for (int _i = 0; _i < 2; ++_i) \
        __builtin_amdgcn_global_load_lds((const unsigned*)((const char*)(gbase) + (voff)[_i]), (PG8_LAS unsigned*)(lds + (bufoff) + ldsw + _i * 8192), 16, 0, 0); } while (0)
#define PG8_LDA(dst, b, h) do { _Pragma("unroll") for (int m = 0; m < 4; ++m) _Pragma("unroll") for (int k = 0; k < 2; ++k) dst[m][k] = *(const PG8_LAS bf16x8*)(lds + PG8_SA(b, h) + aoff + m * 2048 + k * 1024); } while (0)
#define PG8_LDB(dst, b, h) do { _Pragma("unroll") for (int n = 0; n < 2; ++n) _Pragma("unroll") for (int k = 0; k < 2; ++k) dst[n][k] = *(const PG8_LAS bf16x8*)(lds + PG8_SB(b, h) + boff + n * 2048 + k * 1024); } while (0)
#define PG8_MMA(ai, bj, At, Bt) do { __builtin_amdgcn_s_setprio(1); _Pragma("unroll") for (int m = 0; m < 4; ++m) _Pragma("unroll") for (int n = 0; n < 2; ++n) _Pragma("unroll") for (int k = 0; k < 2; ++k) \
        acc[ai][bj][m][n] = __builtin_amdgcn_mfma_f32_16x16x32_bf16(Bt[n][k], At[m][k], acc[ai][bj][m][n], 0, 0, 0); __builtin_amdgcn_s_setprio(0); } while (0)
#define PG8_WAIT_V(n) asm volatile("s_waitcnt vmcnt(" #n ")" ::: "memory")
#define PG8_WAIT_L(n) asm volatile("s_waitcnt lgkmcnt(" #n ")" ::: "memory")
#define PG8_BAR __builtin_amdgcn_s_barrier()
#define PG8_SCHED __builtin_amdgcn_sched_barrier(0)
    Unit cur, nxt; int ui = 0;
    if (!S.next(0, cur)) return;
    f32x4 acc[2][2][4][2];
#pragma unroll
    for (int a = 0; a < 2; ++a)
#pragma unroll
        for (int b = 0; b < 2; ++b)
#pragma unroll
            for (int m = 0; m < 4; ++m)
#pragma unroll
                for (int n = 0; n < 2; ++n) acc[a][b][m][n] = (f32x4){0.f, 0.f, 0.f, 0.f};
    bf16x8 At[4][2], B0[2][2], B1[2][2];
    const char* cA = (const char*)g.A + (size_t)cur.pm * tstep; const char* cB = (const char*)g.Bt + (size_t)cur.pn * tstep;
    S.a_ready(cur);
    if constexpr (SP2) {
        PG8_STAGE(PG8_SB(0, 0), cB, voffB); PG8_STAGE(PG8_SB(0, 1), cB + hstep, voffB); PG8_STAGE(PG8_SA(0, 0), cA, voffA); PG8_STAGE(PG8_SA(0, 1), cA + hstep, voffA);
        if (wr == 1) PG8_BAR;
        PG8_WAIT_V(2); PG8_BAR;
        PG8_STAGE(PG8_SB(1, 0), cB + kstep, voffB); PG8_STAGE(PG8_SA(1, 0), cA + kstep, voffA); PG8_STAGE(PG8_SB(1, 1), cB + hstep + kstep, voffB);
        PG8_WAIT_V(6); PG8_BAR;
    } else {
        PG8_STAGE(PG8_SB(0, 0), cB, voffB); PG8_STAGE(PG8_SA(0, 0), cA, voffA); PG8_STAGE(PG8_SB(0, 1), cB + hstep, voffB); PG8_STAGE(PG8_SA(0, 1), cA + hstep, voffA);
        if (wr == 1) PG8_BAR;
        PG8_WAIT_V(4); PG8_BAR;
        PG8_STAGE(PG8_SB(1, 0), cB + kstep, voffB); PG8_STAGE(PG8_SA(1, 0), cA + kstep, voffA); PG8_STAGE(PG8_SB(1, 1), cB + hstep + kstep, voffB);
        PG8_WAIT_V(6); PG8_BAR;
    }
    for (;;) {
        const bool has_next = S.next(ui + 1, nxt);
        const char* nA = has_next ? (const char*)g.A + (size_t)nxt.pm * tstep : cA; const char* nB = has_next ? (const char*)g.Bt + (size_t)nxt.pn * tstep : cB;
        for (int t = 0; t < nt; t += 2) {
            const bool last = (t == nt - 2);
            const char* a1 = cA + (size_t)(t + 1) * kstep;
            const char* a2 = last ? nA : cA + (size_t)(t + 2) * kstep; const char* b2 = last ? nB : cB + (size_t)(t + 2) * kstep;
            const char* a3 = a2 + kstep; const char* b3 = b2 + kstep;
            if (last && has_next) S.a_ready(nxt);
            if constexpr (SP2) {
            PG8_LDB(B0, 0, 0); PG8_LDB(B1, 0, 1); PG8_SCHED; PG8_LDA(At, 0, 0); PG8_STAGE(PG8_SA(1, 1), a1 + hstep, voffA);
            PG8_WAIT_V(8); PG8_WAIT_L(0); PG8_BAR; PG8_MMA(0, 0, At, B0); PG8_MMA(0, 1, At, B1); PG8_BAR; PG8_SCHED;
            PG8_LDA(At, 0, 1); PG8_STAGE(PG8_SB(0, 0), b2, voffB); PG8_STAGE(PG8_SB(0, 1), b2 + hstep, voffB); PG8_STAGE(PG8_SA(0, 0), a2, voffA);
            PG8_WAIT_V(8); PG8_WAIT_L(0); PG8_BAR; PG8_MMA(1, 0, At, B0); PG8_MMA(1, 1, At, B1); PG8_BAR; PG8_SCHED;
            PG8_LDB(B0, 1, 0); PG8_LDB(B1, 1, 1); PG8_SCHED; PG8_LDA(At, 1, 0); PG8_STAGE(PG8_SA(0, 1), a2 + hstep, voffA);
            PG8_WAIT_V(8); PG8_WAIT_L(0); PG8_BAR; PG8_MMA(0, 0, At, B0); PG8_MMA(0, 1, At, B1); PG8_BAR; PG8_SCHED;
            PG8_LDA(At, 1, 1); PG8_STAGE(PG8_SB(1, 0), b3, voffB); PG8_STAGE(PG8_SB(1, 1), b3 + hstep, voffB); PG8_STAGE(PG8_SA(1, 0), a3, voffA);
            PG8_WAIT_V(8); PG8_WAIT_L(0); PG8_BAR; PG8_MMA(1, 0, At, B0); PG8_MMA(1, 1, At, B1); PG8_BAR; PG8_SCHED;
            } else {
            PG8_LDB(B0, 0, 0); PG8_SCHED; PG8_LDA(At, 0, 0); PG8_STAGE(PG8_SA(1, 1), a1 + hstep, voffA);
            PG8_WAIT_L(8); PG8_BAR; PG8_WAIT_L(0); PG8_MMA(0, 0, At, B0); PG8_BAR; PG8_SCHED;
            PG8_LDB(B1, 0, 1); PG8_STAGE(PG8_SB(0, 0), b2, voffB);
            PG8_BAR; PG8_WAIT_L(0); PG8_MMA(0, 1, At, B1); PG8_BAR;
            PG8_LDA(At, 0, 1); PG8_STAGE(PG8_SA(0, 0), a2, voffA);
            PG8_BAR; PG8_WAIT_L(0); PG8_MMA(1, 0, At, B0); PG8_BAR; PG8_SCHED;
            PG8_STAGE(PG8_SB(0, 1), b2 + hstep, voffB);
            PG8_WAIT_V(6); PG8_BAR; PG8_MMA(1, 1, At, B1); PG8_BAR;
            PG8_LDB(B0, 1, 0); PG8_SCHED; PG8_LDA(At, 1, 0); PG8_STAGE(PG8_SA(0, 1), a2 + hstep, voffA);
            PG8_WAIT_L(8); PG8_BAR; PG8_WAIT_L(0); PG8_MMA(0, 0, At, B0); PG8_BAR; PG8_SCHED;
            PG8_LDB(B1, 1, 1); PG8_STAGE(PG8_SB(1, 0), b3, voffB);
            PG8_BAR; PG8_WAIT_L(0); PG8_MMA(0, 1, At, B1); PG8_BAR;
            PG8_LDA(At, 1, 1); PG8_STAGE(PG8_SA(1, 0), a3, voffA);
            PG8_BAR; PG8_WAIT_L(0); PG8_MMA(1, 0, At, B0); PG8_BAR; PG8_SCHED;
            PG8_STAGE(PG8_SB(1, 1), b3 + hstep, voffB);
            PG8_WAIT_V(6); PG8_BAR; PG8_MMA(1, 1, At, B1); PG8_BAR;
            }
        }
        if constexpr (ALIGN_EPI) { if (wr == 0) PG8_BAR; }
        if constexpr (!Epi::AFTER_DRAIN) { E(acc, cur, wr, wc, fr, fq); S.done(cur); }
        if (!has_next) break;
#pragma unroll
        for (int a = 0; a < 2; ++a)
#pragma unroll
            for (int b = 0; b < 2; ++b)
#pragma unroll
                for (int m = 0; m < 4; ++m)
#pragma unroll
                    for (int n = 0; n < 2; ++n) acc[a][b][m][n] = (f32x4){0.f, 0.f, 0.f, 0.f};
        cur = nxt; cA = nA; cB = nB; ++ui;
        if constexpr (ALIGN_EPI) { if (wr == 1) PG8_BAR; }
    }
    PG8_WAIT_V(0);
    if constexpr (!ALIGN_EPI) { if (wr == 0) PG8_BAR; }
    PG8_BAR;
    if constexpr (Epi::AFTER_DRAIN) { E.fused(acc, cur, wr, wc, fr, fq, lds, wid, lane); S.done(cur); }
#undef PG8_SA
#undef PG8_SB
#undef PG8_STAGE
#undef PG8_LDA
#undef PG8_LDB
#undef PG8_MMA
#undef PG8_WAIT_V
#undef PG8_WAIT_L
#undef PG8_BAR
#undef PG8_SCHED
}
}

#define GAS __attribute__((address_space(1)))
#define LAS __attribute__((address_space(3)))
typedef unsigned short bf16;
typedef unsigned v4u __attribute__((ext_vector_type(4)));
typedef unsigned v2u __attribute__((ext_vector_type(2)));
typedef float f32x4 __attribute__((ext_vector_type(4)));
typedef float f32x2 __attribute__((ext_vector_type(2)));
typedef float f32x16 __attribute__((ext_vector_type(16)));
typedef short bf16x8 __attribute__((ext_vector_type(8)));
#define LDS_WAIT() asm volatile("s_waitcnt lgkmcnt(0)" ::: "memory")

constexpr int NWAVES = 8;
constexpr int TP = 16384, TS = 1024, TT = 17408, D = 1024, FF = 4096;
constexpr int NMIX = 3584, NMIX_REAL = 3344, PRW = 1792, GB = 1792;
constexpr int GQ = GB, GK = GB + 256, GV = GB + 512, GXA = GB + 1024, GGZ = GB + 1040;
enum { I_XP = 0, I_XS, I_SSH, I_SWKV, I_SGLA, I_SRE, I_SIM, I_NMPRE, I_NMPOST, I_NFPRE, I_NFPOST, I_WMIXIN, I_WMIXOUT, I_MU, I_W0, I_W2, I_A0, I_A2, I_G2,
       I_KK, I_KA, I_RK, I_GNG, I_GNB, I_WA2, I_BA, I_GNORM, I_S5WIN, I_LAMRE, I_LAMIM, I_LOGDT, I_BRE, I_BIM, I_CRE, I_CIM, I_S5D, I_S5WOUT, I_WUP, I_WDN, N_IN };
constexpr size_t O_Y = 0, O_SHP = 17825792, O_SHS = 17840128, O_WKVP = 18069504, O_WKVS = 18331648, O_GLAP = 22525952, O_GLAS = 22788096,
                 O_REP = 26982400, O_RES = 27015168, O_IMP = 27539456, O_IMS = 27572224, O_END = 28096512;
constexpr size_t KiB = 1024, MiB = 1024 * 1024;
constexpr size_t WS_CTL = 0, CTL_ZERO_BYTES = 64 * KiB;
constexpr size_t WS_SLOTW = 256 * KiB;
constexpr size_t WS_RM = WS_SLOTW + 16 * MiB;
constexpr size_t WS_RH = WS_RM + 68 * MiB;
constexpr size_t WS_R2 = WS_RH + 34 * MiB;
constexpr size_t WS_END = WS_R2 + 136 * MiB;
static_assert(WS_END <= 256 * MiB, "ws map");
constexpr size_t SW_W1T = 0, SW_W2T = 7 * MiB, SW_LW2 = 9 * MiB, SW_LA2 = 9 * MiB + 64 * KiB, SW_LG2 = 9 * MiB + 128 * KiB, SW_LWA2 = 9 * MiB + 256 * KiB;
constexpr size_t SW_UP = 0, SW_DN = 8 * MiB;
constexpr size_t SW_S5IN = 0, SW_S5OUT = 2 * MiB, SW_BOP = 6 * MiB, SW_COP = 6 * MiB + 256 * KiB, SW_LAM = 6 * MiB + 768 * KiB;
constexpr int CW_BAR = 4096;
constexpr int RING_BYTES = 131072, LDSCTL_OFF = RING_BYTES, MISC_OFF = LDSCTL_OFF + 320, LDS_BYTES = 147456;
constexpr int N_PHASES = 17;

__device__ __forceinline__ unsigned f2bf(float f) { unsigned u = __builtin_bit_cast(unsigned, f); return (u + 0x7fffu + ((u >> 16) & 1u)) >> 16; }
__device__ __forceinline__ unsigned pk2(float lo, float hi) { return f2bf(lo) | (f2bf(hi) << 16); }
__device__ __forceinline__ float bflo(unsigned u) { return __builtin_bit_cast(float, u << 16); }
__device__ __forceinline__ float bfhi(unsigned u) { return __builtin_bit_cast(float, u & 0xffff0000u); }
__device__ __forceinline__ f32x4 unpk4(v2u v) { return (f32x4){bflo(v.x), bfhi(v.x), bflo(v.y), bfhi(v.y)}; }
__device__ __forceinline__ float wave_sum(float v) {
#pragma unroll
    for (int o = 1; o < 64; o <<= 1) v += __shfl_xor(v, o);
    return v;
}
__device__ __forceinline__ float ar8(float x) {
    x += __builtin_amdgcn_update_dpp(0.f, x, 0xB1, 0xF, 0xF, true);
    x += __builtin_amdgcn_update_dpp(0.f, x, 0x4E, 0xF, 0xF, true);
    x += __builtin_amdgcn_update_dpp(0.f, x, 0x141, 0xF, 0xF, true);
    return x;
}
__device__ __forceinline__ float ar16(float x) { x = ar8(x); x += __builtin_amdgcn_update_dpp(0.f, x, 0x140, 0xF, 0xF, true); return x; }
__device__ __forceinline__ float dpp_xor1(float x) { return __builtin_amdgcn_update_dpp(0.f, x, 0xB1, 0xF, 0xF, true); }
__device__ __forceinline__ bool tok_first(int tok) { return tok < TP ? (tok & 2047) == 0 : (tok & 7) == 0; }
__device__ __forceinline__ bool tok_last(int tok) { return tok < TP ? (tok & 2047) == 2047 : (tok & 7) == 7; }
__device__ __forceinline__ float sigmoidf_(float v) { return 1.0f / (1.0f + __expf(-v)); }

#define XB_TMO      128
#define XB_XCNT(j)  (256  + 64 * (j))
#define XB_XSUB(j)  (1280 + 64 * (j))
#define XB_XGEN(j)  (2304 + 64 * (j))
#define XB_TOP      3328
#define XB_TOPGEN   3392
#define XCD_BAR_WORDS 3456
#define XB_SPIN_CAP (1u << 18)

__device__ __forceinline__ unsigned xb_ld(unsigned* p)              { return __hip_atomic_load(p, __ATOMIC_RELAXED, __HIP_MEMORY_SCOPE_AGENT); }
__device__ __forceinline__ unsigned xb_add(unsigned* p, unsigned v) { return __hip_atomic_fetch_add(p, v, __ATOMIC_RELAXED, __HIP_MEMORY_SCOPE_AGENT); }
__device__ __forceinline__ unsigned xb_xcc_id() { return (unsigned)__builtin_amdgcn_s_getreg((3 << 11) | 20) & 0xFu; }
#define XB_SPIN(cond, bar) do { unsigned _sp = 0; while (cond) { __builtin_amdgcn_s_sleep(1); \
    if ((++_sp & 255u) == 0u) { if (xb_ld(&(bar)[XB_TMO])) break; if (_sp > XB_SPIN_CAP) { atomicAdd(&(bar)[XB_TMO], 1u); break; } } } } while (0)

struct XcdBarrier {
    unsigned* bar; unsigned x;
    volatile LAS unsigned* st;
};

__device__ __forceinline__ XcdBarrier xcd_barrier_post(unsigned* bar, volatile LAS unsigned* st) {
    XcdBarrier b; b.bar = bar; b.x = xb_xcc_id(); b.st = st;
    if (threadIdx.x == 0) (void)xb_add(&bar[XB_XCNT(b.x)], 1u);
    return b;
}
__device__ __forceinline__ void xcd_barrier_complete(unsigned* bar, unsigned x, unsigned& nloc, unsigned& nx) {
    const unsigned G = gridDim.x * gridDim.y * gridDim.z;
    unsigned sum, cnt, mine, sp = 0u;
    for (;;) {
        sum = 0u; cnt = 0u; mine = 0u;
#pragma unroll
        for (unsigned j = 0; j < 16; ++j) { const unsigned c = xb_ld(&bar[XB_XCNT(j)]); sum += c; cnt += (c > 0u) ? 1u : 0u; mine = (j == x) ? c : mine; }
        if (sum == G) break;
        __builtin_amdgcn_s_sleep(1);
        if ((++sp & 255u) == 0u) { if (xb_ld(&bar[XB_TMO])) break; if (sp > XB_SPIN_CAP) { atomicAdd(&bar[XB_TMO], 1u); break; } }
    }
    nloc = mine > 0u ? mine : 1u; nx = cnt > 0u ? cnt : 1u;
}

__device__ __forceinline__ void xcd_barrier(const XcdBarrier& b) {
    asm volatile("s_waitcnt vmcnt(0)" ::: "memory");
    __syncthreads();
    if (threadIdx.x == 0) {
        unsigned* bar = b.bar;
        __builtin_amdgcn_s_waitcnt(0);
        unsigned nloc = b.st[0], nx = b.st[1];
        if (nloc == 0u) { xcd_barrier_complete(bar, b.x, nloc, nx); b.st[0] = nloc; b.st[1] = nx; }
        const unsigned old = xb_add(&bar[XB_XSUB(b.x)], 1u);
        const unsigned gen = old / nloc;
        if (old + 1u == (gen + 1u) * nloc) {
            __builtin_amdgcn_fence(__ATOMIC_RELEASE, "agent");
            asm volatile("s_waitcnt vmcnt(0)" ::: "memory");
            const unsigned og = xb_add(&bar[XB_TOP], 1u);
            const unsigned tg = og / nx;
            if (og + 1u == (tg + 1u) * nx) xb_add(&bar[XB_TOPGEN], 1u);
            else XB_SPIN(xb_ld(&bar[XB_TOPGEN]) == tg, bar);
            __builtin_amdgcn_fence(__ATOMIC_ACQUIRE, "agent");
            xb_add(&bar[XB_XGEN(b.x)], 1u);
            asm volatile("s_waitcnt vmcnt(0)" ::: "memory");
        } else {
            XB_SPIN(xb_ld(&bar[XB_XGEN(b.x)]) == gen, bar);
            __builtin_amdgcn_fence(__ATOMIC_ACQUIRE, "agent");
            asm volatile("s_waitcnt vmcnt(0)" ::: "memory");
        }
    }
    __syncthreads();
}

__device__ __forceinline__ void transpose_item(const float* W, int K, int Nsrc, bf16* WT, int mode, LAS float* scr, int item, int nblk, int lane) {
    const int kb = item / nblk, nb = item % nblk, k0 = 64 * kb, n0 = 32 * nb;
    const int nn = n0 + (lane & 31);
#pragma unroll 8
    for (int i = 0; i < 32; ++i) { const int kk = 2 * i + (lane >> 5); scr[kk * 33 + (lane & 31)] = (nn < Nsrc) ? W[(size_t)(k0 + kk) * Nsrc + nn] : 0.f; }
    LDS_WAIT(); asm volatile("" ::: "memory");
    int rb = n0;
    if (mode == 1) { const int c = n0; rb = (c < 1024) ? (256 * (c >> 7) + (c & 127)) : (256 * ((c - 1024) >> 7) + 128 + ((c - 1024) & 127)); }
    const int c8 = lane & 7;
#pragma unroll
    for (int j = 0; j < 4; ++j) { const int n = (lane >> 3) + 8 * j; const LAS float* s = scr + (8 * c8) * 33 + n;
        v4u o; o.x = pk2(s[0 * 33], s[1 * 33]); o.y = pk2(s[2 * 33], s[3 * 33]); o.z = pk2(s[4 * 33], s[5 * 33]); o.w = pk2(s[6 * 33], s[7 * 33]);
        *(v4u*)(WT + (size_t)(rb + n) * K + k0 + 8 * c8) = o; }
    LDS_WAIT(); asm volatile("" ::: "memory");
}
__device__ __forceinline__ void transpose_matrix(const float* W, int K, int Nsrc, int Ncover, bf16* WT, int mode, LAS float* scr, int gw, int NGW, int lane) {
    const int nblk = Ncover / 32, nitems = (K / 64) * nblk;
    for (int it = gw; it < nitems; it += NGW) transpose_item(W, K, Nsrc, WT, mode, scr, it, nblk, lane);
}

template <bool HAS_M, bool WRITE_X, bool WRITE_H>
__device__ __forceinline__ void rowfix_rows(int gw, int NGW, int lane, const float* xp, const float* xs, const float* m, const float* gpost, float* xout, const float* gpre, bf16* h) {
    f32x4 gp[4], gq[4];
#pragma unroll
    for (int j = 0; j < 4; ++j) { gp[j] = HAS_M ? ((const f32x4*)gpost)[lane + 64 * j] : (f32x4){0.f, 0.f, 0.f, 0.f}; gq[j] = WRITE_H ? ((const f32x4*)gpre)[lane + 64 * j] : (f32x4){0.f, 0.f, 0.f, 0.f}; }
    for (int row = gw; row < TT; row += NGW) {
        const float* xr = row < TP ? xp + (size_t)row * D : xs + (size_t)(row - TP) * D;
        f32x4 v[4];
#pragma unroll
        for (int j = 0; j < 4; ++j) v[j] = ((const f32x4*)xr)[lane + 64 * j];
        if (HAS_M) {
            f32x4 mm[4]; float s = 0.f;
#pragma unroll
            for (int j = 0; j < 4; ++j) { mm[j] = ((const f32x4*)(m + (size_t)row * D))[lane + 64 * j]; s += (mm[j].x * mm[j].x + mm[j].y * mm[j].y) + (mm[j].z * mm[j].z + mm[j].w * mm[j].w); }
            const float rs = rsqrtf(wave_sum(s) * (1.0f / D) + 1e-6f);
#pragma unroll
            for (int j = 0; j < 4; ++j) v[j] = v[j] + (mm[j] * rs) * gp[j];
        }
        if (WRITE_X) {
#pragma unroll
            for (int j = 0; j < 4; ++j) ((f32x4*)(xout + (size_t)row * D))[lane + 64 * j] = v[j];
        }
        if (WRITE_H) {
            float s2 = 0.f;
#pragma unroll
            for (int j = 0; j < 4; ++j) s2 += (v[j].x * v[j].x + v[j].y * v[j].y) + (v[j].z * v[j].z + v[j].w * v[j].w);
            const float rs2 = rsqrtf(wave_sum(s2) * (1.0f / D) + 1e-6f);
            unsigned long long* o8 = (unsigned long long*)(h + (size_t)row * D) + lane;
#pragma unroll
            for (int j = 0; j < 4; ++j) { const f32x4 o = (v[j] * rs2) * gq[j]; o8[64 * j] = (unsigned long long)pk2(o.x, o.y) | ((unsigned long long)pk2(o.z, o.w) << 32); }
        }
    }
}

template <int K, int ACT  , bool SHIFT>
__device__ __forceinline__ void prep_afrags(bf16x8 (&A)[K / 16], const bf16* P, int tok, int colbase, const float* mu, const float* shift_state, int kh) {
    const bf16* prow = P + (size_t)tok * NMIX + colbase + 8 * kh;
    const bool first = tok_first(tok);
#pragma unroll
    for (int ks = 0; ks < K / 16; ++ks) {
        const v4u c = *(const v4u*)(prow + 16 * ks);
        float x[8] = {bflo(c.x), bfhi(c.x), bflo(c.y), bfhi(c.y), bflo(c.z), bfhi(c.z), bflo(c.w), bfhi(c.w)};
        if (SHIFT) {
            float pv[8];
            if (!first) { const v4u p = *(const v4u*)(prow - NMIX + 16 * ks); pv[0] = bflo(p.x); pv[1] = bfhi(p.x); pv[2] = bflo(p.y); pv[3] = bfhi(p.y); pv[4] = bflo(p.z); pv[5] = bfhi(p.z); pv[6] = bflo(p.w); pv[7] = bfhi(p.w); }
            else if (tok >= TP) { const float* s = shift_state + (size_t)((tok - TP) >> 3) * PRW + colbase + 8 * kh + 16 * ks; const f32x4 s0 = *(const f32x4*)s, s1 = *(const f32x4*)(s + 4);
                pv[0] = s0.x; pv[1] = s0.y; pv[2] = s0.z; pv[3] = s0.w; pv[4] = s1.x; pv[5] = s1.y; pv[6] = s1.z; pv[7] = s1.w; }
            else {
#pragma unroll
                for (int j = 0; j < 8; ++j) pv[j] = 0.f; }
            const float* mp = mu + colbase + 8 * kh + 16 * ks; const f32x4 m0 = *(const f32x4*)mp, m1 = *(const f32x4*)(mp + 4);
            const float mv[8] = {m0.x, m0.y, m0.z, m0.w, m1.x, m1.y, m1.z, m1.w};
#pragma unroll
            for (int j = 0; j < 8; ++j) x[j] = x[j] + (pv[j] - x[j]) * mv[j];
        }
#pragma unroll
        for (int j = 0; j < 8; ++j) { if (ACT == 1) x[j] = tanhf(x[j]); if (ACT == 2) x[j] = sigmoidf_(x[j]); }
        v4u o; o.x = pk2(x[0], x[1]); o.y = pk2(x[2], x[3]); o.z = pk2(x[4], x[5]); o.w = pk2(x[6], x[7]);
        A[ks] = __builtin_bit_cast(bf16x8, o);
    }
}
template <int K>
__device__ __forceinline__ f32x16 prep_mma(const bf16x8 (&A)[K / 16], const bf16* WT, int n0, int lane) {
    const bf16* brow = WT + (size_t)(n0 + (lane & 31)) * K + 8 * (lane >> 5);
    f32x16 acc;
#pragma unroll
    for (int r = 0; r < 16; ++r) acc[r] = 0.f;
#pragma unroll
    for (int ks = 0; ks < K / 16; ++ks) { const bf16x8 b = *(const bf16x8*)(brow + 16 * ks); acc = __builtin_amdgcn_mfma_f32_32x32x16_bf16(A[ks], b, acc, 0, 0, 0); }
    return acc;
}
__device__ __forceinline__ void phase_prep(int gw, int NGW, int lane, const float* const* in, const bf16* P, const bf16* w2T, const bf16* a2T, const bf16* g2T, const bf16* wa2T,
                                           float* wdec, bf16* abuf, bf16* gbuf, float* ebuf) {
    const int n = lane & 31, hh = lane >> 5, kh = hh;
    for (int u = gw; u < (TT / 32) * 4; u += NGW) {
        const int tile = u >> 2, job = u & 3, tok0 = tile * 32, tok = tok0 + (lane & 31);
        if (job == 0) {
            bf16x8 A[4]; prep_afrags<64, 1, true>(A, P, tok, 1536, in[I_MU], in[I_SSH], kh);
            for (int nt = 0; nt < 16; ++nt) { const f32x16 acc = prep_mma<64>(A, w2T, 32 * nt, lane); const float bias = in[I_W0][32 * nt + n];
#pragma unroll
                for (int r = 0; r < 16; ++r) { const int mm = 8 * (r >> 2) + 4 * hh + (r & 3); const float v = bias + acc[r];
                    const float sg = 1.0f / (1.0f + expf(-v)); wdec[(size_t)(tok0 + mm) * 512 + 32 * nt + n] = expf(-0.6065306597126334f * sg); } }
        } else if (job == 1) {
            bf16x8 A[4]; prep_afrags<64, 0, true>(A, P, tok, 1600, in[I_MU], in[I_SSH], kh);
            for (int nt = 0; nt < 16; ++nt) { const f32x16 acc = prep_mma<64>(A, a2T, 32 * nt, lane); const float bias = in[I_A0][32 * nt + n];
#pragma unroll
                for (int r = 0; r < 16; ++r) { const int mm = 8 * (r >> 2) + 4 * hh + (r & 3); const float v = sigmoidf_(bias + acc[r]); const float nb = dpp_xor1(v);
                    if (!(lane & 1)) *(unsigned*)(abuf + (size_t)(tok0 + mm) * 512 + 32 * nt + n) = pk2(v, nb); } }
        } else if (job == 2) {
            bf16x8 A[8]; prep_afrags<128, 2, true>(A, P, tok, 1664, in[I_MU], in[I_SSH], kh);
            for (int nt = 0; nt < 16; ++nt) { const f32x16 acc = prep_mma<128>(A, g2T, 32 * nt, lane);
#pragma unroll
                for (int r = 0; r < 16; ++r) { const int mm = 8 * (r >> 2) + 4 * hh + (r & 3); const float v = acc[r]; const float nb = dpp_xor1(v);
                    if (!(lane & 1)) *(unsigned*)(gbuf + (size_t)(tok0 + mm) * 512 + 32 * nt + n) = pk2(v, nb); } }
        } else {
            bf16x8 A[1]; prep_afrags<16, 0, false>(A, P, tok, GXA, nullptr, nullptr, kh);
            for (int nt = 0; nt < 8; ++nt) { const f32x16 acc = prep_mma<16>(A, wa2T, 32 * nt, lane); const float bias = in[I_BA][32 * nt + n];
#pragma unroll
                for (int r = 0; r < 16; ++r) { const int mm = 8 * (r >> 2) + 4 * hh + (r & 3); const float v = bias + acc[r];
                    const float ls = fminf(v, 0.f) - log1pf(expf(-fabsf(v))); ebuf[(size_t)(tok0 + mm) * 256 + 32 * nt + n] = expf(ls * 0.0625f); } }
        }
    }
}

constexpr int SS_R = 352, SS_G = 224, SLOT_FLOATS = 16 * SS_R, YB_OFF_FLOATS = 2 * SLOT_FLOATS;
struct ItemD { int type, tok0, Tlen, h, r0, nch; const float* init; float* fin; const float* shift0; };
struct ScanCtx { const float* const* in; float* out; const bf16* P; const float* wdec; const bf16* abuf; const float* ebuf; float* yr; float* og; };

__device__ __forceinline__ ItemD scan_item(const ScanCtx& C, int bid, int k) {
    ItemD d; d.init = nullptr; d.shift0 = nullptr;
    if (bid < 128) {
        const int it = bid, b = it >> 4, h = (it >> 1) & 7, half = it & 1;
        d.type = 0; d.tok0 = b * 2048; d.Tlen = 2048; d.h = h; d.r0 = 32 * half; d.nch = 128; d.fin = C.out + O_WKVP + (size_t)(b * 8 + h) * 4096;
    } else {
        const int j = bid - 128;
        if (k == 0) { const int it = j, b = it >> 4, h = (it >> 2) & 3, q = it & 3;
            d.type = 1; d.tok0 = b * 2048; d.Tlen = 2048; d.h = h; d.r0 = 32 * q; d.nch = 128; d.fin = C.out + O_GLAP + (size_t)(b * 4 + h) * 8192;
        } else if (k <= 16) { const int it = j + 128 * (k - 1), b = it >> 4, h = (it >> 1) & 7, half = it & 1;
            d.type = 0; d.tok0 = TP + 8 * b; d.Tlen = 8; d.h = h; d.r0 = 32 * half; d.nch = 1; d.init = C.in[I_SWKV] + (size_t)(b * 8 + h) * 4096; d.fin = C.out + O_WKVS + (size_t)(b * 8 + h) * 4096;
            d.shift0 = C.in[I_SSH] + (size_t)b * PRW;
        } else { const int it = j + 128 * (k - 17), b = it >> 4, h = (it >> 2) & 3, q = it & 3;
            d.type = 1; d.tok0 = TP + 8 * b; d.Tlen = 8; d.h = h; d.r0 = 32 * q; d.nch = 1; d.init = C.in[I_SGLA] + (size_t)(b * 4 + h) * 8192; d.fin = C.out + O_GLAS + (size_t)(b * 4 + h) * 8192;
        }
    }
    return d;
}
__device__ __forceinline__ void chunk_to_item(int g, int& k, int& c) { if (g < 128) { k = 0; c = g; } else { k = 1 + (g - 128); c = 0; } }

struct LReg { v2u a0, a1, a2, p0, p1, p2, aa; f32x4 w; };
__device__ __forceinline__ void ld_issue(LReg& L, const ScanCtx& C, int bid, int g, int tl) {
    int k, c; chunk_to_item(g, k, c); const ItemD d = scan_item(C, bid, k);
    const int tk = tl >> 4, jq = tl & 15, step = 16 * c + tk;
    L.a0 = L.a1 = L.a2 = L.p0 = L.p1 = L.p2 = L.aa = (v2u){0u, 0u}; L.w = (f32x4){0.f, 0.f, 0.f, 0.f};
    if (step < d.Tlen) {
        const int tok = d.tok0 + step; const bf16* prow = C.P + (size_t)tok * NMIX;
        if (d.type == 0) {
            const bf16* b0 = prow + d.h * 64 + 4 * jq;
            L.a0 = *(const v2u*)b0; L.a1 = *(const v2u*)(b0 + 512); L.a2 = *(const v2u*)(b0 + 1024);
            if (step > 0) { L.p0 = *(const v2u*)(b0 - NMIX); L.p1 = *(const v2u*)(b0 - NMIX + 512); L.p2 = *(const v2u*)(b0 - NMIX + 1024); }
            L.aa = *(const v2u*)(C.abuf + (size_t)tok * 512 + d.h * 64 + 4 * jq);
            L.w = *(const f32x4*)(C.wdec + (size_t)tok * 512 + d.h * 64 + 4 * jq);
        } else {
            L.a0 = *(const v2u*)(prow + GQ + d.h * 64 + 4 * jq); L.a1 = *(const v2u*)(prow + GK + d.h * 64 + 4 * jq);
            if (jq < 8) L.a2 = *(const v2u*)(prow + GV + d.h * 128 + d.r0 + 4 * jq);
            L.w = *(const f32x4*)(C.ebuf + (size_t)tok * 256 + d.h * 64 + 4 * jq);
        }
    }
}
__device__ __forceinline__ void ld_process(const LReg& L, const ScanCtx& C, int bid, int g, int tl, LAS float* ldsf) {
    int k, c; chunk_to_item(g, k, c); const ItemD d = scan_item(C, bid, k);
    const int tk = tl >> 4, jq = tl & 15, step = 16 * c + tk;
    LAS float* slot = ldsf + (g & 1) * SLOT_FLOATS;
    if (step < d.Tlen) {
        if (d.type == 0) {
            const int col = d.h * 64 + 4 * jq;
            const f32x4 r = unpk4(L.a0), kx = unpk4(L.a1), v = unpk4(L.a2);
            f32x4 pr, pk, pv;
            if (step > 0) { pr = unpk4(L.p0); pk = unpk4(L.p1); pv = unpk4(L.p2); }
            else if (d.shift0) { pr = *(const f32x4*)(d.shift0 + col); pk = *(const f32x4*)(d.shift0 + 512 + col); pv = *(const f32x4*)(d.shift0 + 1024 + col); }
            else { pr = pk = pv = (f32x4){0.f, 0.f, 0.f, 0.f}; }
            const float* mu = C.in[I_MU];
            const f32x4 mur = *(const f32x4*)(mu + col), muk = *(const f32x4*)(mu + 512 + col), muv = *(const f32x4*)(mu + 1024 + col);
            const f32x4 kkc = *(const f32x4*)(C.in[I_KK] + col), kac = *(const f32x4*)(C.in[I_KA] + col);
            const f32x4 zr = r + (pr - r) * mur, zk = kx + (pk - kx) * muk, zv = v + (pv - v) * muv;
            const f32x4 kkr = zk * kkc;
            const float ss = ar16((kkr.x * kkr.x + kkr.y * kkr.y) + (kkr.z * kkr.z + kkr.w * kkr.w));
            const float inv = rsqrtf(fmaxf(ss, 1e-24f));
            const f32x4 kk = kkr * inv, a = unpk4(L.aa);
            const f32x4 kmod = zk * (1.0f + (a - 1.0f) * kac), bb = kk * a;
            LAS float* sp = slot + tk * SS_R + 4 * jq;
            *(LAS f32x4*)(sp) = kk; *(LAS f32x4*)(sp + 64) = L.w; *(LAS f32x4*)(sp + 128) = bb; *(LAS f32x4*)(sp + 192) = kmod; *(LAS f32x4*)(sp + 256) = zr;
            if (4 * jq >= d.r0 && 4 * jq < d.r0 + 32) *(LAS f32x4*)(slot + tk * SS_R + 320 + 4 * jq - d.r0) = zv;
        } else {
            const f32x4 q = unpk4(L.a0) * 0.125f, kx = unpk4(L.a1);
            LAS float* sp = slot + tk * SS_G + 4 * jq;
            *(LAS f32x4*)(sp) = L.w; *(LAS f32x4*)(sp + 64) = kx; *(LAS f32x4*)(sp + 128) = q;
            if (jq < 8) *(LAS f32x4*)(slot + tk * SS_G + 192 + 4 * jq) = unpk4(L.a2);
        }
    }
}
__device__ __forceinline__ void flush_y(const ScanCtx& C, int bid, int g, int tl, const LAS float* ldsf) {
    int k, c; chunk_to_item(g, k, c); const ItemD d = scan_item(C, bid, k);
    const int tk = tl >> 4, x = tl & 15, step = 16 * c + tk;
    if (step < d.Tlen) {
        const int tok = d.tok0 + step;
        const f32x2 v = *(const LAS f32x2*)(ldsf + YB_OFF_FLOATS + (g & 1) * 512 + tk * 32 + 2 * x);
        float* dst = (d.type == 0) ? (C.yr + (size_t)tok * 512 + d.h * 64 + d.r0 + 2 * x) : (C.og + (size_t)tok * 512 + d.h * 128 + d.r0 + 2 * x);
        *(f32x2*)dst = v;
    }
}

__device__ __forceinline__ void phase_scan(const ScanCtx& C, LAS unsigned char* lds, int tid) {
    const int bid = blockIdx.x, wave = __builtin_amdgcn_readfirstlane(tid >> 6), lane = tid & 63;
    LAS float* ldsf = (LAS float*)lds;
    const int total = (bid < 128) ? 128 : 160;
    const bool loader = wave >= 4;
    const int tl = tid - 256;
    const int rp = lane >> 4, jq = lane & 15, lr0 = 8 * (wave & 3) + 2 * rp;
    f32x4 S0 = {0.f, 0.f, 0.f, 0.f}, S1 = {0.f, 0.f, 0.f, 0.f}, N0 = S0, N1 = S0;
    LReg LA, LB;
    if (loader) { ld_issue(LA, C, bid, 0, tl); ld_issue(LB, C, bid, 1, tl); ld_process(LA, C, bid, 0, tl, ldsf); LA = LB; }
    __syncthreads();
    for (int g = 0; g < total; ++g) {
        if (loader) {
            if (g + 2 < total) ld_issue(LB, C, bid, g + 2, tl);
            if (g + 1 < total) ld_process(LA, C, bid, g + 1, tl, ldsf);
            if (g >= 1) flush_y(C, bid, g - 1, tl, ldsf);
            LA = LB;
        } else {
            int k, c; chunk_to_item(g, k, c); const ItemD d = scan_item(C, bid, k);
            const bool last = (c == d.nch - 1);
            const int nsteps = min(16, d.Tlen - 16 * c);
            if (last && g + 1 < total) {
                const ItemD dn = scan_item(C, bid, k + 1);
                if (dn.init) {
                    if (dn.type == 0) { const float* p = dn.init + (size_t)(dn.r0 + lr0) * 64 + 4 * jq; N0 = *(const f32x4*)p; N1 = *(const f32x4*)(p + 64); }
                    else { const float* p = dn.init + (size_t)(4 * jq) * 128 + dn.r0 + lr0;
#pragma unroll
                        for (int e = 0; e < 4; ++e) { const f32x2 t = *(const f32x2*)(p + e * 128); N0[e] = t.x; N1[e] = t.y; } }
                } else { N0 = N1 = (f32x4){0.f, 0.f, 0.f, 0.f}; }
            }
            const LAS float* slot = ldsf + (g & 1) * SLOT_FLOATS;
            LAS float* yb = ldsf + YB_OFF_FLOATS + (g & 1) * 512;
            if (d.type == 0) {
#pragma unroll 2
                for (int s = 0; s < nsteps; ++s) {
                    const LAS float* sp = slot + s * SS_R + 4 * jq;
                    const f32x4 kk = *(const LAS f32x4*)sp, w = *(const LAS f32x4*)(sp + 64), bb = *(const LAS f32x4*)(sp + 128), kx = *(const LAS f32x4*)(sp + 192), r = *(const LAS f32x4*)(sp + 256);
                    const f32x2 v = *(const LAS f32x2*)(slot + s * SS_R + 320 + lr0);
                    const f32x4 t0 = S0 * kk, t1 = S1 * kk;
                    const float d0 = ar16((t0.x + t0.y) + (t0.z + t0.w)), d1 = ar16((t1.x + t1.y) + (t1.z + t1.w));
                    S0 = S0 * w + (kx * v.x - bb * d0); S1 = S1 * w + (kx * v.y - bb * d1);
                    const f32x4 u0 = S0 * r, u1 = S1 * r;
                    const float y0 = ar16((u0.x + u0.y) + (u0.z + u0.w)), y1 = ar16((u1.x + u1.y) + (u1.z + u1.w));
                    if (jq == 0) *(LAS f32x2*)(yb + s * 32 + lr0) = (f32x2){y0, y1};
                }
            } else {
#pragma unroll 2
                for (int s = 0; s < nsteps; ++s) {
                    const LAS float* sp = slot + s * SS_G + 4 * jq;
                    const f32x4 e = *(const LAS f32x4*)sp, kx = *(const LAS f32x4*)(sp + 64), q = *(const LAS f32x4*)(sp + 128);
                    const f32x2 v = *(const LAS f32x2*)(slot + s * SS_G + 192 + lr0);
                    S0 = S0 * e + kx * v.x; S1 = S1 * e + kx * v.y;
                    const f32x4 u0 = S0 * q, u1 = S1 * q;
                    const float y0 = ar16((u0.x + u0.y) + (u0.z + u0.w)), y1 = ar16((u1.x + u1.y) + (u1.z + u1.w));
                    if (jq == 0) *(LAS f32x2*)(yb + s * 32 + lr0) = (f32x2){y0, y1};
                }
            }
            if (last) {
                if (d.type == 0) { float* p = d.fin + (size_t)(d.r0 + lr0) * 64 + 4 * jq; *(f32x4*)p = S0; *(f32x4*)(p + 64) = S1; }
                else { float* p = d.fin + (size_t)(4 * jq) * 128 + d.r0 + lr0;
#pragma unroll
                    for (int e = 0; e < 4; ++e) *(f32x2*)(p + e * 128) = (f32x2){S0[e], S1[e]}; }
                S0 = N0; S1 = N1;
            }
        }
        __syncthreads();
    }
    if (loader) flush_y(C, bid, total - 1, tl, ldsf);
    __syncthreads();
}

__device__ __forceinline__ void phase_post(int gw, int NGW, int lane, const float* const* in, float* out, const bf16* P, const float* yr, const float* og, const bf16* abuf, const bf16* gbuf, bf16* A2) {
    const int c0 = 8 * lane;
    float mur[8], muk[8], muv[8], ka[8], rk[8], gng[8], gnb[8], gnorm[8];
#pragma unroll
    for (int j = 0; j < 8; ++j) { mur[j] = in[I_MU][c0 + j]; muk[j] = in[I_MU][512 + c0 + j]; muv[j] = in[I_MU][1024 + c0 + j]; ka[j] = in[I_KA][c0 + j]; rk[j] = in[I_RK][c0 + j];
        gng[j] = in[I_GNG][c0 + j]; gnb[j] = in[I_GNB][c0 + j]; gnorm[j] = in[I_GNORM][(c0 + j) & 127]; }
    for (int tok = gw; tok < TT; tok += NGW) {
        const bf16* prow = P + (size_t)tok * NMIX;
        const bool first = tok_first(tok);
        float r[8], kx[8], v[8], pr[8], pk[8], pv[8];
        { const v4u a = *(const v4u*)(prow + c0), b = *(const v4u*)(prow + 512 + c0), c = *(const v4u*)(prow + 1024 + c0);
          r[0] = bflo(a.x); r[1] = bfhi(a.x); r[2] = bflo(a.y); r[3] = bfhi(a.y); r[4] = bflo(a.z); r[5] = bfhi(a.z); r[6] = bflo(a.w); r[7] = bfhi(a.w);
          kx[0] = bflo(b.x); kx[1] = bfhi(b.x); kx[2] = bflo(b.y); kx[3] = bfhi(b.y); kx[4] = bflo(b.z); kx[5] = bfhi(b.z); kx[6] = bflo(b.w); kx[7] = bfhi(b.w);
          v[0] = bflo(c.x); v[1] = bfhi(c.x); v[2] = bflo(c.y); v[3] = bfhi(c.y); v[4] = bflo(c.z); v[5] = bfhi(c.z); v[6] = bflo(c.w); v[7] = bfhi(c.w); }
        if (!first) { const v4u a = *(const v4u*)(prow - NMIX + c0), b = *(const v4u*)(prow - NMIX + 512 + c0), c = *(const v4u*)(prow - NMIX + 1024 + c0);
          pr[0] = bflo(a.x); pr[1] = bfhi(a.x); pr[2] = bflo(a.y); pr[3] = bfhi(a.y); pr[4] = bflo(a.z); pr[5] = bfhi(a.z); pr[6] = bflo(a.w); pr[7] = bfhi(a.w);
          pk[0] = bflo(b.x); pk[1] = bfhi(b.x); pk[2] = bflo(b.y); pk[3] = bfhi(b.y); pk[4] = bflo(b.z); pk[5] = bfhi(b.z); pk[6] = bflo(b.w); pk[7] = bfhi(b.w);
          pv[0] = bflo(c.x); pv[1] = bfhi(c.x); pv[2] = bflo(c.y); pv[3] = bfhi(c.y); pv[4] = bflo(c.z); pv[5] = bfhi(c.z); pv[6] = bflo(c.w); pv[7] = bfhi(c.w); }
        else if (tok >= TP) { const float* s = in[I_SSH] + (size_t)((tok - TP) >> 3) * PRW + c0;
#pragma unroll
          for (int j = 0; j < 8; ++j) { pr[j] = s[j]; pk[j] = s[512 + j]; pv[j] = s[1024 + j]; } }
        else {
#pragma unroll
          for (int j = 0; j < 8; ++j) { pr[j] = 0.f; pk[j] = 0.f; pv[j] = 0.f; } }
        const v4u av = *(const v4u*)(abuf + (size_t)tok * 512 + c0), gv = *(const v4u*)(gbuf + (size_t)tok * 512 + c0);
        const float a8[8] = {bflo(av.x), bfhi(av.x), bflo(av.y), bfhi(av.y), bflo(av.z), bfhi(av.z), bflo(av.w), bfhi(av.w)};
        const float g8[8] = {bflo(gv.x), bfhi(gv.x), bflo(gv.y), bfhi(gv.y), bflo(gv.z), bfhi(gv.z), bflo(gv.w), bfhi(gv.w)};
        const f32x4 y0 = *(const f32x4*)(yr + (size_t)tok * 512 + c0), y1 = *(const f32x4*)(yr + (size_t)tok * 512 + c0 + 4);
        const float y8[8] = {y0.x, y0.y, y0.z, y0.w, y1.x, y1.y, y1.z, y1.w};
        float dot = 0.f, sy = 0.f;
#pragma unroll
        for (int j = 0; j < 8; ++j) { r[j] = r[j] + (pr[j] - r[j]) * mur[j]; kx[j] = kx[j] + (pk[j] - kx[j]) * muk[j]; v[j] = v[j] + (pv[j] - v[j]) * muv[j];
            const float km = kx[j] * (1.0f + (a8[j] - 1.0f) * ka[j]); dot += r[j] * km * rk[j]; sy += y8[j]; }
        dot = ar8(dot); const float mean = ar8(sy) * (1.0f / 64.0f);
        float sv = 0.f;
#pragma unroll
        for (int j = 0; j < 8; ++j) { const float dd = y8[j] - mean; sv += dd * dd; }
        const float rstd = rsqrtf(ar8(sv) * (1.0f / 64.0f) + 64e-5f);
        float o[8];
#pragma unroll
        for (int j = 0; j < 8; ++j) o[j] = ((y8[j] - mean) * rstd * gng[j] + gnb[j] + dot * v[j]) * g8[j];
        { v4u w; w.x = pk2(o[0], o[1]); w.y = pk2(o[2], o[3]); w.z = pk2(o[4], o[5]); w.w = pk2(o[6], o[7]); *(v4u*)(A2 + (size_t)tok * D + c0) = w; }
        const f32x4 q0 = *(const f32x4*)(og + (size_t)tok * 512 + c0), q1 = *(const f32x4*)(og + (size_t)tok * 512 + c0 + 4);
        const float o8[8] = {q0.x, q0.y, q0.z, q0.w, q1.x, q1.y, q1.z, q1.w};
        float so = 0.f;
#pragma unroll
        for (int j = 0; j < 8; ++j) so += o8[j] * o8[j];
        const float rs = rsqrtf(ar16(so) * (1.0f / 128.0f) + 1e-6f);
        const v4u zv = *(const v4u*)(prow + GGZ + c0);
        const float z8[8] = {bflo(zv.x), bfhi(zv.x), bflo(zv.y), bfhi(zv.y), bflo(zv.z), bfhi(zv.z), bflo(zv.w), bfhi(zv.w)};
#pragma unroll
        for (int j = 0; j < 8; ++j) o[j] = o8[j] * rs * gnorm[j] * (z8[j] * sigmoidf_(z8[j]));
        { v4u w; w.x = pk2(o[0], o[1]); w.y = pk2(o[2], o[3]); w.z = pk2(o[4], o[5]); w.w = pk2(o[6], o[7]); *(v4u*)(A2 + (size_t)tok * D + 512 + c0) = w; }
        if (tok_last(tok)) { const int seq = tok < TP ? (tok >> 11) : 8 + ((tok - TP) >> 3);
            float* dst = (seq < 8) ? out + O_SHP + (size_t)seq * PRW : out + O_SHS + (size_t)(seq - 8) * PRW;
            for (int cc = lane; cc < PRW; cc += 64) dst[cc] = __builtin_bit_cast(float, ((unsigned)prow[cc]) << 16); }
    }
}

__device__ __forceinline__ void sincos_d(double x, double& s, double& c) {
    const double TWO_PI = 6.283185307179586476925;
    const double kq = rint(x / TWO_PI); const double r = x - kq * TWO_PI;
    const double t = r * 0.125, t2 = t * t;
    double sn = t * (1.0 + t2 * (-1.0 / 6 + t2 * (1.0 / 120 + t2 * (-1.0 / 5040 + t2 * (1.0 / 362880 + t2 * (-1.0 / 39916800 + t2 * (1.0 / 6227020800.0)))))));
    double cs = 1.0 + t2 * (-0.5 + t2 * (1.0 / 24 + t2 * (-1.0 / 720 + t2 * (1.0 / 40320 + t2 * (-1.0 / 3628800 + t2 * (1.0 / 479001600.0 + t2 * (-1.0 / 87178291200.0)))))));
#pragma unroll
    for (int i = 0; i < 3; ++i) { const double s2 = 2.0 * sn * cs, c2 = cs * cs - sn * sn; sn = s2; cs = c2; }
    s = sn; c = cs;
}
__device__ __forceinline__ void s5_tables(int gtid, int gthreads, const float* const* in, f32x2* Lam, bf16* Bop, bf16* Cop) {
    for (int idx = gtid; idx < 64 * 64; idx += gthreads) {
        const int g = idx >> 6, p = idx & 63;
        const double lr = (double)in[I_LAMRE][idx], li = (double)in[I_LAMIM][idx], dt = exp((double)in[I_LOGDT][g]);
        const double mag = exp(lr * dt); double sn, cs; sincos_d(li * dt, sn, cs);
        const double abr = mag * cs, abi = mag * sn, den = lr * lr + li * li;
        const double fr = ((abr - 1.0) * lr + abi * li) / den, fi = (abi * lr - (abr - 1.0) * li) / den;
        Lam[idx] = (f32x2){(float)abr, (float)abi};
        const float* bre = in[I_BRE] + (size_t)idx * 16; const float* bim = in[I_BIM] + (size_t)idx * 16;
#pragma unroll 4
        for (int c = 0; c < 16; ++c) { const double br = bre[c], bi = bim[c];
            Bop[((size_t)g * 128 + p) * 16 + c] = (bf16)f2bf((float)(fr * br - fi * bi)); Bop[((size_t)g * 128 + 64 + p) * 16 + c] = (bf16)f2bf((float)(fr * bi + fi * br)); }
        const int n = p & 31, q = p >> 5;
        for (int ch = 0; ch < 16; ++ch) { const float cr = in[I_CRE][((size_t)g * 16 + ch) * 64 + p], ci = in[I_CIM][((size_t)g * 16 + ch) * 64 + p];
            Cop[((size_t)g * 32 + ch) * 128 + 4 * n + q] = (bf16)f2bf(cr); Cop[((size_t)g * 32 + ch) * 128 + 4 * n + 2 + q] = (bf16)f2bf(-ci);
            Cop[((size_t)g * 32 + 16 + ch) * 128 + 4 * n + q] = 0; Cop[((size_t)g * 32 + 16 + ch) * 128 + 4 * n + 2 + q] = 0; }
    }
}
__device__ __forceinline__ float gelu_tanh(float x) { return x / (1.0f + __expf(-1.5957691216057308f * (x + 0.044715f * x * x * x))); }
constexpr int XS_PITCH = 272;
struct S5Ctx { const bf16* U; bf16* YG; const bf16* Bop; const bf16* Cop; const f32x2* Lam; const float* dskip; };
template <bool FULLOUT>
__device__ __forceinline__ void s5_chunk(const S5Ctx& C, int g, int tokA, int tokB, int nvalid, int lane, const bf16x8 (&Bf)[4], const bf16x8 (&Cf)[8],
                                         f32x2 a0, f32x2 a1, float (&st)[4], float (&cap)[4], LAS unsigned char* xs) {
    const int m = lane & 31, kh = lane >> 5, tau = 4 * (m >> 3) + (m & 3), bsel = (m >> 2) & 1;
    const int tokrow = (bsel ? tokB : tokA) + tau;
    v4u au = {0u, 0u, 0u, 0u};
    if (tau < nvalid) au = *(const v4u*)(C.U + (size_t)tokrow * D + g * 16 + 8 * kh);
    const bf16x8 Af = __builtin_bit_cast(bf16x8, au);
    f32x16 e[4];
#pragma unroll
    for (int nt = 0; nt < 4; ++nt) {
#pragma unroll
        for (int r = 0; r < 16; ++r) e[nt][r] = 0.f;
        e[nt] = __builtin_amdgcn_mfma_f32_32x32x16_bf16(Af, Bf[nt], e[nt], 0, 0, 0);
    }
    float re0 = st[0], im0 = st[1], re1 = st[2], im1 = st[3];
#pragma unroll
    for (int r = 0; r < 16; ++r) {
        const float nr0 = a0.x * re0 - a0.y * im0 + e[0][r], ni0 = a0.x * im0 + a0.y * re0 + e[2][r];
        const float nr1 = a1.x * re1 - a1.y * im1 + e[1][r], ni1 = a1.x * im1 + a1.y * re1 + e[3][r];
        re0 = nr0; im0 = ni0; re1 = nr1; im1 = ni1;
        e[0][r] = re0; e[2][r] = im0; e[1][r] = re1; e[3][r] = im1;
        if (r == 7) { cap[0] = re0; cap[1] = im0; cap[2] = re1; cap[3] = im1; }
    }
    st[0] = re0; st[1] = im0; st[2] = re1; st[3] = im1;
    if (FULLOUT) {
        const int n = lane & 31, hh = lane >> 5;
#pragma unroll
        for (int r = 0; r < 16; ++r) { const int mm = 8 * (r >> 2) + 4 * hh + (r & 3);
            *(LAS v2u*)(xs + mm * XS_PITCH + n * 8) = (v2u){pk2(e[0][r], e[1][r]), pk2(e[2][r], e[3][r])}; }
        LDS_WAIT(); asm volatile("" ::: "memory");
        f32x16 y;
#pragma unroll
        for (int r = 0; r < 16; ++r) y[r] = 0.f;
#pragma unroll
        for (int ks = 0; ks < 8; ++ks) { const bf16x8 xf = *(const LAS bf16x8*)(xs + m * XS_PITCH + 32 * ks + 16 * kh); y = __builtin_amdgcn_mfma_f32_32x32x16_bf16(Cf[ks], xf, y, 0, 0, 0); }
        LDS_WAIT(); asm volatile("" ::: "memory");
        if (tau < nvalid) {
            const int hh2 = lane >> 5;
#pragma unroll
            for (int half = 0; half < 2; ++half) {
                const int ch = 8 * half + 4 * hh2;
                const v2u uu = *(const v2u*)(C.U + (size_t)tokrow * D + g * 16 + ch); const f32x4 u4 = unpk4(uu);
                const f32x4 d4 = *(const f32x4*)(C.dskip + g * 16 + ch);
                float o[4];
#pragma unroll
                for (int j = 0; j < 4; ++j) o[j] = gelu_tanh(y[4 * half + j] + d4[j] * u4[j]);
                *(v2u*)(C.YG + (size_t)tokrow * D + g * 16 + ch) = (v2u){pk2(o[0], o[1]), pk2(o[2], o[3])};
            }
        }
    }
}
__device__ __forceinline__ void s5_load_frags(const S5Ctx& C, int g, int lane, bf16x8 (&Bf)[4], bf16x8 (&Cf)[8], f32x2& a0, f32x2& a1) {
    const int n = lane & 31, kh = lane >> 5;
#pragma unroll
    for (int nt = 0; nt < 4; ++nt) Bf[nt] = *(const bf16x8*)(C.Bop + ((size_t)g * 128 + 32 * nt + n) * 16 + 8 * kh);
#pragma unroll
    for (int ks = 0; ks < 8; ++ks) Cf[ks] = *(const bf16x8*)(C.Cop + ((size_t)g * 32 + n) * 128 + 16 * ks + 8 * kh);
    a0 = C.Lam[g * 64 + n]; a1 = C.Lam[g * 64 + n + 32];
}
__device__ __forceinline__ void phase_s5(const S5Ctx& C, const float* const* in, float* out, LAS unsigned char* lds, int tid, int vcu, int G) {
    const int wave = __builtin_amdgcn_readfirstlane(tid >> 6), lane = tid & 63, n = lane & 31, hh = lane >> 5;
    LAS unsigned char* xs = lds + wave * (32 * XS_PITCH);
    LAS f32x4* ebuf = (LAS f32x4*)(lds + 8 * 32 * XS_PITCH);
    bf16x8 Bf[4], Cf[8]; f32x2 a0, a1; float st[4], cap[4];
    for (int u = vcu * NWAVES + wave; u < 64 * 64; u += G * NWAVES) {
        const int bp = u >> 6, g = u & 63, b = 2 * bp + hh;
        s5_load_frags(C, g, lane, Bf, Cf, a0, a1);
        const size_t sb = ((size_t)b * 64 + g) * 64 + n;
        st[0] = in[I_SRE][sb]; st[1] = in[I_SIM][sb]; st[2] = in[I_SRE][sb + 32]; st[3] = in[I_SIM][sb + 32];
        s5_chunk<true>(C, g, TP + 16 * bp, TP + 16 * bp + 8, 8, lane, Bf, Cf, a0, a1, st, cap, xs);
        out[O_RES + sb] = cap[0]; out[O_IMS + sb] = cap[1]; out[O_RES + sb + 32] = cap[2]; out[O_IMS + sb + 32] = cap[3];
    }
    for (int u = vcu; u < 4 * 64; u += G) {
        const int bp = u >> 6, g = u & 63, b = 2 * bp + hh;
        s5_load_frags(C, g, lane, Bf, Cf, a0, a1);
        const int tokA = (2 * bp) * 2048 + 256 * wave, tokB = tokA + 2048;
        st[0] = st[1] = st[2] = st[3] = 0.f;
        for (int c = 0; c < 16; ++c) s5_chunk<false>(C, g, tokA + 16 * c, tokB + 16 * c, 16, lane, Bf, Cf, a0, a1, st, cap, xs);
        ebuf[wave * 64 + lane] = (f32x4){st[0], st[1], st[2], st[3]};
        f32x2 p0 = a0, p1 = a1;
#pragma unroll
        for (int i = 0; i < 8; ++i) { p0 = (f32x2){p0.x * p0.x - p0.y * p0.y, 2.f * p0.x * p0.y}; p1 = (f32x2){p1.x * p1.x - p1.y * p1.y, 2.f * p1.x * p1.y}; }
        __syncthreads();
        st[0] = st[1] = st[2] = st[3] = 0.f;
        for (int v = 0; v < wave; ++v) { const f32x4 ev = ebuf[v * 64 + lane];
            const float r0 = p0.x * st[0] - p0.y * st[1] + ev.x, i0 = p0.x * st[1] + p0.y * st[0] + ev.y, r1 = p1.x * st[2] - p1.y * st[3] + ev.z, i1 = p1.x * st[3] + p1.y * st[2] + ev.w;
            st[0] = r0; st[1] = i0; st[2] = r1; st[3] = i1; }
        for (int c = 0; c < 16; ++c) s5_chunk<true>(C, g, tokA + 16 * c, tokB + 16 * c, 16, lane, Bf, Cf, a0, a1, st, cap, xs);
        if (wave == 7) { const size_t sb = ((size_t)b * 64 + g) * 64 + n;
            out[O_REP + sb] = st[0]; out[O_IMP + sb] = st[1]; out[O_REP + sb + 32] = st[2]; out[O_IMP + sb + 32] = st[3]; }
        __syncthreads();
    }
}

struct Args { const float* in[N_IN]; float* out; unsigned char* ws; int ph_lo, ph_hi, use_bar, pad; };
#ifndef MK_N_LAUNCHES
#define MK_N_LAUNCHES 1
#endif

__global__ void __launch_bounds__(NWAVES * 64, 2) mega_fwd(Args args) {
    extern __shared__ __attribute__((aligned(16))) unsigned char lds_raw[];
    LAS unsigned char* lds = (LAS unsigned char*)lds_raw;
    volatile LAS unsigned* MISC = (volatile LAS unsigned*)(lds + MISC_OFF);
    const int tid = threadIdx.x, lane = tid & 63, wave = __builtin_amdgcn_readfirstlane(tid >> 6);
    const int G = gridDim.x, bx = blockIdx.x, vcu = (G % 8 == 0) ? (bx % 8) * (G / 8) + bx / 8 : bx;
    const int gw = vcu * NWAVES + wave, NGW = G * NWAVES;
    const float* const* in = args.in; float* out = args.out; unsigned char* ws = args.ws;
    for (int u = tid; u < (LDS_BYTES - LDSCTL_OFF) / 4; u += NWAVES * 64) ((LAS unsigned*)(lds + LDSCTL_OFF))[u] = 0u;
    __syncthreads();
    unsigned* ctl = (unsigned*)(ws + WS_CTL);
    XcdBarrier bar; bar.bar = ctl + CW_BAR; bar.x = 0; bar.st = nullptr;
    if (args.use_bar) bar = xcd_barrier_post(ctl + CW_BAR, MISC + 8);
    const int lo = args.ph_lo, hi = args.ph_hi;
#define IN_PH(k) (lo <= (k) && (k) < hi)
#define SEAM(k) do { if (IN_PH(k) && IN_PH((k) + 1)) xcd_barrier(bar); } while (0)
    unsigned char* slotw = ws + WS_SLOTW;
    float* RM = (float*)(ws + WS_RM); bf16* RH = (bf16*)(ws + WS_RH);
    bf16* P = (bf16*)(ws + WS_R2); bf16* gbuf = (bf16*)(ws + WS_R2 + 119 * MiB); bf16* HID = (bf16*)(ws + WS_R2); bf16* UB = (bf16*)(ws + WS_R2);
    float* yr = RM; float* og = RM + (size_t)TT * 512;
    float* wdec = out; bf16* abuf = (bf16*)((unsigned char*)out + 34 * MiB); float* ebuf = (float*)((unsigned char*)out + 51 * MiB);
    float* xres = out + O_Y;
    LAS float* scr = (LAS float*)(lds + wave * 16384);

    if (IN_PH(0)) {
        transpose_matrix(in[I_WMIXIN], 1024, NMIX_REAL, NMIX, (bf16*)(slotw + SW_W1T), 0, scr, gw, NGW, lane);
        transpose_matrix(in[I_WMIXOUT], 1024, 1024, 1024, (bf16*)(slotw + SW_W2T), 0, scr, gw, NGW, lane);
        transpose_matrix(in[I_W2], 64, 512, 512, (bf16*)(slotw + SW_LW2), 0, scr, gw, NGW, lane);
        transpose_matrix(in[I_A2], 64, 512, 512, (bf16*)(slotw + SW_LA2), 0, scr, gw, NGW, lane);
        transpose_matrix(in[I_G2], 128, 512, 512, (bf16*)(slotw + SW_LG2), 0, scr, gw, NGW, lane);
        { bf16* wa2T = (bf16*)(slotw + SW_LWA2); for (int i = bx * (NWAVES * 64) + tid; i < 256 * 16; i += G * NWAVES * 64) { const int n = i >> 4, k = i & 15; wa2T[i] = (bf16)f2bf(in[I_WA2][k * 256 + n]); } }
        rowfix_rows<false, false, true>(gw, NGW, lane, in[I_XP], in[I_XS], nullptr, nullptr, nullptr, in[I_NMPRE], RH);
    }
    SEAM(0);
    if (IN_PH(1)) { pg8::Gemm g{RH, (const bf16*)(slotw + SW_W1T), TT, NMIX, 1024}; pg8::StaticOrder S; S.init(TT, NMIX, G, bx);
        pg8::EpiBf16<0> E{P, NMIX}; pg8::gemm_phase<pg8::EpiBf16<0>, pg8::StaticOrder, true, true>(lds, g, S, E); }
    SEAM(1);
    if (IN_PH(2)) phase_prep(gw, NGW, lane, in, P, (const bf16*)(slotw + SW_LW2), (const bf16*)(slotw + SW_LA2), (const bf16*)(slotw + SW_LG2), (const bf16*)(slotw + SW_LWA2), wdec, abuf, gbuf, ebuf);
    SEAM(2);
    if (IN_PH(3)) { ScanCtx C; C.in = in; C.out = out; C.P = P; C.wdec = wdec; C.abuf = abuf; C.ebuf = ebuf; C.yr = yr; C.og = og; phase_scan(C, lds, tid); }
    SEAM(3);
    if (IN_PH(4)) phase_post(gw, NGW, lane, in, out, P, yr, og, abuf, gbuf, RH);
    SEAM(4);
    if (IN_PH(5)) { pg8::Gemm g{RH, (const bf16*)(slotw + SW_W2T), TT, 1024, 1024}; pg8::StaticOrder S; S.init(TT, 1024, G, bx);
        pg8::EpiF32 E{RM, 1024}; pg8::gemm_phase<pg8::EpiF32, pg8::StaticOrder, true, true>(lds, g, S, E); }
    SEAM(5);
#define FFN_WEIGHTS(layer) do { \
        transpose_matrix(in[I_WUP] + (size_t)(layer) * 1024 * 4096, 1024, 4096, 4096, (bf16*)(slotw + SW_UP), 0, scr, gw, NGW, lane); \
        transpose_matrix(in[I_WDN] + (size_t)(layer) * 4096 * 1024, 4096, 1024, 1024, (bf16*)(slotw + SW_DN), 0, scr, gw, NGW, lane); } while (0)
#define FFN_UP() do { pg8::Gemm g{RH, (const bf16*)(slotw + SW_UP), TT, 4096, 1024}; pg8::StaticOrder S; S.init(TT, 4096, G, bx); \
        pg8::EpiBf16<3> E{HID, 4096}; pg8::gemm_phase<pg8::EpiBf16<3>, pg8::StaticOrder, true, true>(lds, g, S, E); } while (0)
#define FFN_DOWN() do { pg8::Gemm g{HID, (const bf16*)(slotw + SW_DN), TT, 1024, 4096}; pg8::StaticOrder S; S.init(TT, 1024, G, bx); \
        pg8::EpiF32 E{RM, 1024}; pg8::gemm_phase<pg8::EpiF32, pg8::StaticOrder, true, true>(lds, g, S, E); } while (0)
    if (IN_PH(6)) { FFN_WEIGHTS(0); rowfix_rows<true, true, true>(gw, NGW, lane, in[I_XP], in[I_XS], RM, in[I_NMPOST], xres, in[I_NFPRE], RH); }
    SEAM(6);
    if (IN_PH(7)) FFN_UP();
    SEAM(7);
    if (IN_PH(8)) FFN_DOWN();
    SEAM(8);
    if (IN_PH(9)) {
        transpose_matrix(in[I_S5WIN], 1024, 1024, 1024, (bf16*)(slotw + SW_S5IN), 0, scr, gw, NGW, lane);
        transpose_matrix(in[I_S5WOUT], 1024, 2048, 2048, (bf16*)(slotw + SW_S5OUT), 1, scr, gw, NGW, lane);
        s5_tables(bx * (NWAVES * 64) + tid, G * NWAVES * 64, in, (f32x2*)(slotw + SW_LAM), (bf16*)(slotw + SW_BOP), (bf16*)(slotw + SW_COP));
        rowfix_rows<true, true, true>(gw, NGW, lane, xres, xres + (size_t)TP * D, RM, in[I_NFPOST], xres, in[I_NMPRE] + 1024, RH);
    }
    SEAM(9);
    if (IN_PH(10)) { pg8::Gemm g{RH, (const bf16*)(slotw + SW_S5IN), TT, 1024, 1024}; pg8::StaticOrder S; S.init(TT, 1024, G, bx);
        pg8::EpiBf16<0> E{UB, 1024}; pg8::gemm_phase<pg8::EpiBf16<0>, pg8::StaticOrder, true, true>(lds, g, S, E); }
    SEAM(10);
    if (IN_PH(11)) { S5Ctx C; C.U = UB; C.YG = RH; C.Bop = (const bf16*)(slotw + SW_BOP); C.Cop = (const bf16*)(slotw + SW_COP); C.Lam = (const f32x2*)(slotw + SW_LAM); C.dskip = in[I_S5D];
        phase_s5(C, in, out, lds, tid, vcu, G); }
    SEAM(11);
    if (IN_PH(12)) { pg8::Gemm g{RH, (const bf16*)(slotw + SW_S5OUT), TT, 2048, 1024}; pg8::StaticOrder S; S.init(TT, 2048, G, bx);
        pg8::EpiGlu E{RM, 1024}; pg8::gemm_phase<pg8::EpiGlu, pg8::StaticOrder, true, true>(lds, g, S, E); }
    SEAM(12);
    if (IN_PH(13)) { FFN_WEIGHTS(1); rowfix_rows<true, true, true>(gw, NGW, lane, xres, xres + (size_t)TP * D, RM, in[I_NMPOST] + 1024, xres, in[I_NFPRE] + 1024, RH); }
    SEAM(13);
    if (IN_PH(14)) FFN_UP();
    SEAM(14);
    if (IN_PH(15)) FFN_DOWN();
    SEAM(15);
    if (IN_PH(16)) rowfix_rows<true, true, false>(gw, NGW, lane, xres, xres + (size_t)TP * D, RM, in[I_NFPOST] + 1024, xres, nullptr, nullptr);
}

extern "C" void kernel_launch(void* const* d_in, const int* in_sizes, int n_in, void* d_out, int out_size, void* d_ws, size_t ws_size, hipStream_t stream) {
    static int grid = 0;
    if (grid == 0) {
        if (n_in != N_IN || out_size != (int)O_END || ws_size < WS_END) { fprintf(stderr, "kernel_launch: unexpected problem shape (n_in %d, out %d, ws %zu); nothing launched\n", n_in, out_size, ws_size); grid = -1; return; }
        int dev = 0, cus = 0, per_cu = 0;
        if (hipGetDevice(&dev) != hipSuccess || hipDeviceGetAttribute(&cus, hipDeviceAttributeMultiprocessorCount, dev) != hipSuccess) { grid = -1; return; }
        if (hipFuncSetAttribute((const void*)mega_fwd, hipFuncAttributeMaxDynamicSharedMemorySize, LDS_BYTES) != hipSuccess) { fprintf(stderr, "kernel_launch: hipFuncSetAttribute failed\n"); grid = -1; return; }
        if (hipOccupancyMaxActiveBlocksPerMultiprocessor(&per_cu, (const void*)mega_fwd, NWAVES * 64, LDS_BYTES) != hipSuccess || per_cu < 1) { fprintf(stderr, "kernel_launch: occupancy query reports %d blocks per CU\n", per_cu); per_cu = 0; }
        (void)hipGetLastError();
        if (cus < 256 || per_cu < 1) { fprintf(stderr, "kernel_launch: needs 256 CUs with one resident workgroup each (cus %d, per_cu %d); nothing launched\n", cus, per_cu); grid = -1; return; }
        grid = 256;
    }
    if (grid < 0) return;
    if (hipMemsetAsync((char*)d_ws + WS_CTL, 0, CTL_ZERO_BYTES, stream) != hipSuccess) return;
    Args a{};
    for (int i = 0; i < N_IN; ++i) a.in[i] = (const float*)d_in[i];
    a.out = (float*)d_out; a.ws = (unsigned char*)d_ws;
#if MK_N_LAUNCHES == 1
    a.ph_lo = 0; a.ph_hi = N_PHASES; a.use_bar = 1;
    { void* kargs[] = {&a}; hipError_t e = hipLaunchCooperativeKernel((const void*)mega_fwd, dim3(grid), dim3(NWAVES * 64), kargs, LDS_BYTES, stream);
      if (e != hipSuccess) fprintf(stderr, "kernel_launch: cooperative launch failed: %s\n", hipGetErrorString(e)); }
#else
    for (int li = 0; li < N_PHASES; ++li) { a.ph_lo = li; a.ph_hi = li + 1; a.use_bar = 0;
        hipLaunchKernelGGL(mega_fwd, dim3(grid), dim3(NWAVES * 64), LDS_BYTES, stream, a); }
#endif
}
```

```cpp
#include <hip/hip_runtime.h>
#include <cstdio>
#include <cstdint>
#define MK_N_LAUNCHES 1
#define PROBE_MASK 0
namespace pg8 {
#define PG8_LAS __attribute__((address_space(3)))
typedef unsigned short bf16_t;
typedef short bf16x8 __attribute__((ext_vector_type(8)));
typedef float f32x4 __attribute__((ext_vector_type(4)));
typedef unsigned u32x4 __attribute__((ext_vector_type(4)));
constexpr int BM = 256, BK = 64, HALF = 128, HTB = HALF * BK * 2  , STAGE_BYTES = 8 * HTB, NXCD = 8, WGM = 8;

__host__ __device__ __forceinline__ int lds_byte(int r, int c) { const int st = (r >> 4) * 2 + (c >> 5), rr = r & 15, cc = c & 31, ob = rr * 64 + cc * 2; return st * 1024 + (ob ^ (((ob >> 9) & 1) << 5)); }
__host__ __device__ __forceinline__ void stage_rc(int b, int& R, int& C) { const int st = b / 1024, sb = b % 1024, swz = sb ^ (((sb >> 9) & 1) << 5); R = (st >> 1) * 16 + swz / 64; C = (st & 1) * 32 + (swz % 64) / 2; }
__host__ __device__ __forceinline__ int perm32(int rho) { const int n = rho >> 4, i = rho & 15; return 8 * (i >> 2) + 4 * n + (i & 3); }

struct Unit { int pm, pn, k0, nt, slab; };
struct Gemm { const bf16_t* A; const bf16_t* Bt; int M, N, K; };

struct StaticOrder {
    int nM, nN, nwg, G, c, ntk;
    __host__ __device__ void init(int M, int N, int G_, int c_, int K_) { nM = M / BM; nN = N / BM; nwg = nM * nN; G = G_; c = c_; ntk = K_ / BK; }
    __host__ __device__ bool next(int i, Unit& u) const {
        const long L = (long)i * G + c; if (L >= nwg) return false;
        int wgid = (int)L; { const int q = nwg / NXCD, r = nwg % NXCD, xcd = wgid % NXCD, off = wgid / NXCD; wgid = (xcd < r ? xcd * (q + 1) : r * (q + 1) + (xcd - r) * q) + off; }
        const int nig = WGM * nN, gid = wgid / nig, fm = gid * WGM, gsz = (nM - fm) < WGM ? (nM - fm) : WGM;
        u.pm = fm + ((wgid % nig) % gsz); u.pn = (wgid % nig) / gsz; u.k0 = 0; u.nt = ntk; u.slab = -1; return true;
    }
    __device__ __forceinline__ void a_ready(const Unit&) const {}
    __device__ __forceinline__ void done(const Unit&) const {}
};
struct SplitOrder {
    StaticOrder P; int nwp, nsl, nts, nNs, nMs, pm0, nsub;
    __host__ __device__ void init(int Mp, int Ms, int N, int G_, int c_, int K_, int nsl_) { P.init(Mp, N, G_, c_, K_); nwp = P.nwg; nsl = nsl_; nts = (K_ / BK) / nsl_; nNs = N / BM; nMs = Ms / BM; pm0 = Mp / BM; nsub = nMs * nNs * nsl_; }
    __host__ __device__ bool next(int i, Unit& u) const {
        const long L = (long)i * P.G + P.c;
        if (L < nwp) return P.next(i, u);
        const int s = (int)(L - nwp); if (s >= nsub) return false;
        const int sl = s % nsl, t = s / nsl;
        u.pm = pm0 + (t % nMs); u.pn = t / nMs; u.k0 = sl * nts * BK; u.nt = nts; u.slab = sl; return true;
    }
    __device__ __forceinline__ void a_ready(const Unit&) const {}
    __device__ __forceinline__ void done(const Unit&) const {}
};

__device__ __forceinline__ unsigned cvt_pk_bf16(float lo, float hi) { unsigned r; asm volatile("v_cvt_pk_bf16_f32 %0, %1, %2" : "=v"(r) : "v"(lo), "v"(hi)); return r; }
typedef float f32x2 __attribute__((ext_vector_type(2)));
template <int ACT> struct EpiBf16 {
    static constexpr bool PERM = true, AFTER_DRAIN = false;
    bf16_t* O; int ldc;
    __device__ __forceinline__ void operator()(const f32x4 (&acc)[2][2][4][2], const Unit& u, int wr, int wc, int fr, int fq) const {
        const int row0 = u.pm * BM + wr * 64 + fr; const int col0 = u.pn * BM + wc * 32 + 8 * fq;
#pragma unroll
        for (int ai = 0; ai < 2; ++ai)
#pragma unroll
            for (int m = 0; m < 4; ++m) { bf16_t* rowp = O + (size_t)(row0 + ai * HALF + m * 16) * ldc + col0;
#pragma unroll
                for (int bj = 0; bj < 2; ++bj) { f32x4 v0 = acc[ai][bj][m][0], v1 = acc[ai][bj][m][1];
                    if (ACT == 3) {
#pragma unroll
                        for (int j = 0; j < 4; ++j) { const float a = fmaxf(v0[j], 0.f), b = fmaxf(v1[j], 0.f); v0[j] = a * a; v1[j] = b * b; } }
                    u32x4 w; w.x = cvt_pk_bf16(v0[0], v0[1]); w.y = cvt_pk_bf16(v0[2], v0[3]); w.z = cvt_pk_bf16(v1[0], v1[1]); w.w = cvt_pk_bf16(v1[2], v1[3]);
                    *(u32x4*)(rowp + bj * HALF) = w; } }
    }
};
struct EpiF32 {
    static constexpr bool PERM = false, AFTER_DRAIN = false;
    bf16_t* C; int ldc; float* S; int slab_row0, slab_rows;
    __device__ __forceinline__ void operator()(const f32x4 (&acc)[2][2][4][2], const Unit& u, int wr, int wc, int fr, int fq) const {
        const int row0 = u.pm * BM + wr * 64 + fr, col0 = u.pn * BM + wc * 32 + 4 * fq;
        if (u.slab >= 0) {
            float* base = S + ((ptrdiff_t)u.slab * slab_rows - slab_row0) * (ptrdiff_t)ldc;
#pragma unroll
            for (int ai = 0; ai < 2; ++ai)
#pragma unroll
                for (int m = 0; m < 4; ++m) { float* rowp = base + (size_t)(row0 + ai * HALF + m * 16) * ldc + col0;
#pragma unroll
                    for (int bj = 0; bj < 2; ++bj)
#pragma unroll
                        for (int n = 0; n < 2; ++n) *(f32x4*)(rowp + bj * HALF + n * 16) = acc[ai][bj][m][n]; }
        } else {
            typedef unsigned u32x2 __attribute__((ext_vector_type(2)));
#pragma unroll
            for (int ai = 0; ai < 2; ++ai)
#pragma unroll
                for (int m = 0; m < 4; ++m) { bf16_t* rowp = C + (size_t)(row0 + ai * HALF + m * 16) * ldc + col0;
#pragma unroll
                    for (int bj = 0; bj < 2; ++bj)
#pragma unroll
                        for (int n = 0; n < 2; ++n) { const f32x4 v = acc[ai][bj][m][n]; u32x2 w; w.x = cvt_pk_bf16(v[0], v[1]); w.y = cvt_pk_bf16(v[2], v[3]); *(u32x2*)(rowp + bj * HALF + n * 16) = w; } }
        }
    }
};

struct EpiBf16S {
    static constexpr bool PERM = true, AFTER_DRAIN = false;
    bf16_t* O; int ldc; float* S; int slab_row0, slab_rows;
    __device__ __forceinline__ void operator()(const f32x4 (&acc)[2][2][4][2], const Unit& u, int wr, int wc, int fr, int fq) const {
        const int row0 = u.pm * BM + wr * 64 + fr; const int col0 = u.pn * BM + wc * 32 + 8 * fq;
        if (u.slab >= 0) {
            float* base = S + ((ptrdiff_t)u.slab * slab_rows - slab_row0) * (ptrdiff_t)ldc;
#pragma unroll
            for (int ai = 0; ai < 2; ++ai)
#pragma unroll
                for (int m = 0; m < 4; ++m) { float* rowp = base + (size_t)(row0 + ai * HALF + m * 16) * ldc + col0;
#pragma unroll
                    for (int bj = 0; bj < 2; ++bj) { *(f32x4*)(rowp + bj * HALF) = acc[ai][bj][m][0]; *(f32x4*)(rowp + bj * HALF + 4) = acc[ai][bj][m][1]; } }
        } else {
#pragma unroll
            for (int ai = 0; ai < 2; ++ai)
#pragma unroll
                for (int m = 0; m < 4; ++m) { bf16_t* rowp = O + (size_t)(row0 + ai * HALF + m * 16) * ldc + col0;
#pragma unroll
                    for (int bj = 0; bj < 2; ++bj) { const f32x4 v0 = acc[ai][bj][m][0], v1 = acc[ai][bj][m][1];
                        u32x4 w; w.x = cvt_pk_bf16(v0[0], v0[1]); w.y = cvt_pk_bf16(v0[2], v0[3]); w.z = cvt_pk_bf16(v1[0], v1[1]); w.w = cvt_pk_bf16(v1[2], v1[3]);
                        *(u32x4*)(rowp + bj * HALF) = w; } }
        }
    }
};
struct EpiGlu {
    static constexpr bool PERM = false, AFTER_DRAIN = false;
    bf16_t* C; int ldc;
    __device__ __forceinline__ void operator()(const f32x4 (&acc)[2][2][4][2], const Unit& u, int wr, int wc, int fr, int fq) const {
        const int row0 = u.pm * BM + wr * 64 + fr, col0 = u.pn * HALF + wc * 32 + 4 * fq;
#pragma unroll
        for (int ai = 0; ai < 2; ++ai)
#pragma unroll
            for (int m = 0; m < 4; ++m) { bf16_t* rowp = C + (size_t)(row0 + ai * HALF + m * 16) * ldc + col0;
#pragma unroll
                for (int n = 0; n < 2; ++n) { const f32x4 v = acc[ai][0][m][n], g = acc[ai][1][m][n]; f32x4 o;
#pragma unroll
                    for (int j = 0; j < 4; ++j) o[j] = v[j] * __builtin_amdgcn_rcpf(1.0f + __expf(-g[j]));
                    typedef unsigned u32x2 __attribute__((ext_vector_type(2))); u32x2 w; w.x = cvt_pk_bf16(o[0], o[1]); w.y = cvt_pk_bf16(o[2], o[3]); *(u32x2*)(rowp + n * 16) = w; } }
    }
};

template <class Epi, class Sched, bool ALIGN_EPI = false, bool SP2 = false>
__device__ __forceinline__ void gemm_phase(PG8_LAS unsigned char* lds, const Gemm g, const Sched& S, const Epi& E, const int tid  ) {
    const int wid = __builtin_amdgcn_readfirstlane(tid >> 6), lane = tid & 63, wr = wid >> 2, wc = wid & 3, fr = lane & 15, fq = lane >> 4;
    const int K = g.K;
    unsigned voffA[2], voffB[2];
#pragma unroll
    for (int i = 0; i < 2; ++i) { int R, C; stage_rc(tid * 16 + i * 8192, R, C); const int Rb = Epi::PERM ? ((R & ~31) + perm32(R & 31)) : R;
        voffA[i] = (unsigned)(R * K + C) * 2u; voffB[i] = (unsigned)(Rb * K + C) * 2u; }
    const size_t kstep = (size_t)(BK * 2);
    const size_t hstep = (size_t)HALF * K * 2;
    const size_t tstep = 2 * hstep;
    const unsigned ldsw = (unsigned)wid * 1024u;
    const int aoff = lds_byte(wr * 64 + fr, fq * 8), boff = lds_byte(wc * 32 + fr, fq * 8);
#define PG8_SA(b, h) (((b) * 2 + (h)) * HTB)
#define PG8_SB(b, h) ((4 + (b) * 2 + (h)) * HTB)
#define PG8_STAGE(bufoff, gbase, voff) do { _Pragma("unroll") for (int _i = 0; _i < 2; ++_i) \
        __builtin_amdgcn_global_load_lds((const unsigned*)((const char*)(gbase) + (voff)[_i]), (PG8_LAS unsigned*)(lds + (bufoff) + ldsw + _i * 8192), 16, 0, 0); } while (0)
#define PG8_LDA(dst, b, h) do { _Pragma("unroll") for (int m = 0; m < 4; ++m) _Pragma("unroll") for (int k = 0; k < 2; ++k) dst[m][k] = *(const PG8_LAS bf16x8*)(lds + PG8_SA(b, h) + aoff + m * 2048 + k * 1024); } while (0)
#define PG8_LDB(dst, b, h) do { _Pragma("unroll") for (int n = 0; n < 2; ++n) _Pragma("unroll") for (int k = 0; k < 2; ++k) dst[n][k] = *(const PG8_LAS bf16x8*)(lds + PG8_SB(b, h) + boff + n * 2048 + k * 1024); } while (0)
#define PG8_MMA(ai, bj, At, Bt) do { __builtin_amdgcn_s_setprio(1); _Pragma("unroll") for (int m = 0; m < 4; ++m) _Pragma("unroll") for (int n = 0; n < 2; ++n) _Pragma("unroll") for (int k = 0; k < 2; ++k) \
        acc[ai][bj][m][n] = __builtin_amdgcn_mfma_f32_16x16x32_bf16(Bt[n][k], At[m][k], acc[ai][bj][m][n], 0, 0, 0); __builtin_amdgcn_s_setprio(0); } while (0)
#define PG8_WAIT_V(n) asm volatile("s_waitcnt vmcnt(" #n ")" ::: "memory")
#define PG8_WAIT_L(n) asm volatile("s_waitcnt lgkmcnt(" #n ")" ::: "memory")
#define PG8_BAR __builtin_amdgcn_s_barrier()
#define PG8_SCHED __builtin_amdgcn_sched_barrier(0)
    Unit cur, nxt; int ui = 0;
    if (!S.next(0, cur)) return;
    int nt = cur.nt;
    f32x4 acc[2][2][4][2];
#pragma unroll
    for (int a = 0; a < 2; ++a)
#pragma unroll
        for (int b = 0; b < 2; ++b)
#pragma unroll
            for (int m = 0; m < 4; ++m)
#pragma unroll
                for (int n = 0; n < 2; ++n) acc[a][b][m][n] = (f32x4){0.f, 0.f, 0.f, 0.f};
    bf16x8 At[4][2], B0[2][2], B1[2][2];
    const char* cA = (const char*)g.A + (size_t)cur.pm * tstep + (size_t)cur.k0 * 2; const char* cB = (const char*)g.Bt + (size_t)cur.pn * tstep + (size_t)cur.k0 * 2;
    S.a_ready(cur);
    if constexpr (SP2) {
        PG8_STAGE(PG8_SB(0, 0), cB, voffB); PG8_STAGE(PG8_SB(0, 1), cB + hstep, voffB); PG8_STAGE(PG8_SA(0, 0), cA, voffA); PG8_STAGE(PG8_SA(0, 1), cA + hstep, voffA);
        if (wr == 1) PG8_BAR;
        PG8_WAIT_V(2); PG8_BAR;
        PG8_STAGE(PG8_SB(1, 0), cB + kstep, voffB); PG8_STAGE(PG8_SA(1, 0), cA + kstep, voffA); PG8_STAGE(PG8_SB(1, 1), cB + hstep + kstep, voffB);
        PG8_WAIT_V(6); PG8_BAR;
    } else {
        PG8_STAGE(PG8_SB(0, 0), cB, voffB); PG8_STAGE(PG8_SA(0, 0), cA, voffA); PG8_STAGE(PG8_SB(0, 1), cB + hstep, voffB); PG8_STAGE(PG8_SA(0, 1), cA + hstep, voffA);
        if (wr == 1) PG8_BAR;
        PG8_WAIT_V(4); PG8_BAR;
        PG8_STAGE(PG8_SB(1, 0), cB + kstep, voffB); PG8_STAGE(PG8_SA(1, 0), cA + kstep, voffA); PG8_STAGE(PG8_SB(1, 1), cB + hstep + kstep, voffB);
        PG8_WAIT_V(6); PG8_BAR;
    }
    for (;;) {
        const bool has_next = S.next(ui + 1, nxt);
        const char* nA = has_next ? (const char*)g.A + (size_t)nxt.pm * tstep + (size_t)nxt.k0 * 2 : cA; const char* nB = has_next ? (const char*)g.Bt + (size_t)nxt.pn * tstep + (size_t)nxt.k0 * 2 : cB;
        for (int t = 0; t < nt; t += 2) {
            const bool last = (t == nt - 2);
            const char* a1 = cA + (size_t)(t + 1) * kstep;
            const char* a2 = last ? nA : cA + (size_t)(t + 2) * kstep; const char* b2 = last ? nB : cB + (size_t)(t + 2) * kstep;
            const char* a3 = a2 + kstep; const char* b3 = b2 + kstep;
            if (last && has_next) S.a_ready(nxt);
            if constexpr (SP2) {
            PG8_LDB(B0, 0, 0); PG8_LDB(B1, 0, 1); PG8_SCHED; PG8_LDA(At, 0, 0); PG8_STAGE(PG8_SA(1, 1), a1 + hstep, voffA);
            PG8_WAIT_V(8); PG8_WAIT_L(0); PG8_BAR; PG8_MMA(0, 0, At, B0); PG8_MMA(0, 1, At, B1); PG8_BAR; PG8_SCHED;
            PG8_LDA(At, 0, 1); PG8_STAGE(PG8_SB(0, 0), b2, voffB); PG8_STAGE(PG8_SB(0, 1), b2 + hstep, voffB); PG8_STAGE(PG8_SA(0, 0), a2, voffA);
            PG8_WAIT_V(8); PG8_WAIT_L(0); PG8_BAR; PG8_MMA(1, 0, At, B0); PG8_MMA(1, 1, At, B1); PG8_BAR; PG8_SCHED;
            PG8_LDB(B0, 1, 0); PG8_LDB(B1, 1, 1); PG8_SCHED; PG8_LDA(At, 1, 0); PG8_STAGE(PG8_SA(0, 1), a2 + hstep, voffA);
            PG8_WAIT_V(8); PG8_WAIT_L(0); PG8_BAR; PG8_MMA(0, 0, At, B0); PG8_MMA(0, 1, At, B1); PG8_BAR; PG8_SCHED;
            PG8_LDA(At, 1, 1); PG8_STAGE(PG8_SB(1, 0), b3, voffB); PG8_STAGE(PG8_SB(1, 1), b3 + hstep, voffB); PG8_STAGE(PG8_SA(1, 0), a3, voffA);
            PG8_WAIT_V(8); PG8_WAIT_L(0); PG8_BAR; PG8_MMA(1, 0, At, B0); PG8_MMA(1, 1, At, B1); PG8_BAR; PG8_SCHED;
            } else {
            PG8_LDB(B0, 0, 0); PG8_SCHED; PG8_LDA(At, 0, 0); PG8_STAGE(PG8_SA(1, 1), a1 + hstep, voffA);
            PG8_WAIT_L(8); PG8_BAR; PG8_WAIT_L(0); PG8_MMA(0, 0, At, B0); PG8_BAR; PG8_SCHED;
            PG8_LDB(B1, 0, 1); PG8_STAGE(PG8_SB(0, 0), b2, voffB);
            PG8_BAR; PG8_WAIT_L(0); PG8_MMA(0, 1, At, B1); PG8_BAR;
            PG8_LDA(At, 0, 1); PG8_STAGE(PG8_SA(0, 0), a2, voffA);
            PG8_BAR; PG8_WAIT_L(0); PG8_MMA(1, 0, At, B0); PG8_BAR; PG8_SCHED;
            PG8_STAGE(PG8_SB(0, 1), b2 + hstep, voffB);
            PG8_WAIT_V(6); PG8_BAR; PG8_MMA(1, 1, At, B1); PG8_BAR;
            PG8_LDB(B0, 1, 0); PG8_SCHED; PG8_LDA(At, 1, 0); PG8_STAGE(PG8_SA(0, 1), a2 + hstep, voffA);
            PG8_WAIT_L(8); PG8_BAR; PG8_WAIT_L(0); PG8_MMA(0, 0, At, B0); PG8_BAR; PG8_SCHED;
            PG8_LDB(B1, 1, 1); PG8_STAGE(PG8_SB(1, 0), b3, voffB);
            PG8_BAR; PG8_WAIT_L(0); PG8_MMA(0, 1, At, B1); PG8_BAR;
            PG8_LDA(At, 1, 1); PG8_STAGE(PG8_SA(1, 0), a3, voffA);
            PG8_BAR; PG8_WAIT_L(0); PG8_MMA(1, 0, At, B0); PG8_BAR; PG8_SCHED;
            PG8_STAGE(PG8_SB(1, 1), b3 + hstep, voffB);
            PG8_WAIT_V(6); PG8_BAR; PG8_MMA(1, 1, At, B1); PG8_BAR;
            }
        }
        if constexpr (ALIGN_EPI) { if (wr == 0) PG8_BAR; }
        if constexpr (!Epi::AFTER_DRAIN) { E(acc, cur, wr, wc, fr, fq); S.done(cur); }
        if (!has_next) break;
#pragma unroll
        for (int a = 0; a < 2; ++a)
#pragma unroll
            for (int b = 0; b < 2; ++b)
#pragma unroll
                for (int m = 0; m < 4; ++m)
#pragma unroll
                    for (int n = 0; n < 2; ++n) acc[a][b][m][n] = (f32x4){0.f, 0.f, 0.f, 0.f};
        cur = nxt; cA = nA; cB = nB; ++ui; nt = cur.nt;
        if constexpr (ALIGN_EPI) { if (wr == 1) PG8_BAR; }
    }
    PG8_WAIT_V(0);
    if constexpr (!ALIGN_EPI) { if (wr == 0) PG8_BAR; }
    PG8_BAR;
    if constexpr (Epi::AFTER_DRAIN) { E.fused(acc, cur, wr, wc, fr, fq, lds, wid, lane); S.done(cur); }
#undef PG8_SA
#undef PG8_SB
#undef PG8_STAGE
#undef PG8_LDA
#undef PG8_LDB
#undef PG8_MMA
#undef PG8_WAIT_V
#undef PG8_WAIT_L
#undef PG8_BAR
#undef PG8_SCHED
}
}

#define GAS __attribute__((address_space(1)))
#define LAS __attribute__((address_space(3)))
typedef unsigned short bf16;
typedef unsigned v4u __attribute__((ext_vector_type(4)));
typedef unsigned v2u __attribute__((ext_vector_type(2)));
typedef float f32x4 __attribute__((ext_vector_type(4)));
typedef float f32x2 __attribute__((ext_vector_type(2)));
typedef float f32x16 __attribute__((ext_vector_type(16)));
typedef short bf16x8 __attribute__((ext_vector_type(8)));
#define LDS_WAIT() asm volatile("s_waitcnt lgkmcnt(0)" ::: "memory")
#define LDS_BARRIER() do { asm volatile("s_waitcnt lgkmcnt(0)" ::: "memory"); __builtin_amdgcn_s_barrier(); asm volatile("" ::: "memory"); } while (0)

constexpr int NWAVES = 8;
constexpr int TP = 16384, TS = 1024, TT = 17408, D = 1024, FF = 4096;
constexpr int NMIX = 3584, NMIX_REAL = 3344, PRW = 1792, GB = 1792;
constexpr int GQ = GB, GK = GB + 256, GV = GB + 512, GXA = GB + 1024, GGZ = GB + 1040;
enum { I_XP = 0, I_XS, I_SSH, I_SWKV, I_SGLA, I_SRE, I_SIM, I_NMPRE, I_NMPOST, I_NFPRE, I_NFPOST, I_WMIXIN, I_WMIXOUT, I_MU, I_W0, I_W2, I_A0, I_A2, I_G2,
       I_KK, I_KA, I_RK, I_GNG, I_GNB, I_WA2, I_BA, I_GNORM, I_S5WIN, I_LAMRE, I_LAMIM, I_LOGDT, I_BRE, I_BIM, I_CRE, I_CIM, I_S5D, I_S5WOUT, I_WUP, I_WDN, N_IN };
constexpr size_t O_Y = 0, O_SHP = 17825792, O_SHS = 17840128, O_WKVP = 18069504, O_WKVS = 18331648, O_GLAP = 22525952, O_GLAS = 22788096,
                 O_REP = 26982400, O_RES = 27015168, O_IMP = 27539456, O_IMS = 27572224, O_END = 28096512;
constexpr size_t KiB = 1024, MiB = 1024 * 1024;
constexpr size_t WS_CTL = 0, CTL_ZERO_BYTES = 64 * KiB;
constexpr size_t WS_SLOTW = 256 * KiB;
constexpr size_t WS_RM = WS_SLOTW + 16 * MiB;
constexpr size_t WS_RH = WS_RM + 68 * MiB;
constexpr size_t WS_R2 = WS_RH + 34 * MiB;
constexpr size_t WS_END = WS_R2 + 136 * MiB;
static_assert(WS_END <= 256 * MiB, "ws map");
constexpr size_t SW_W1T = 0, SW_W2T = 7 * MiB, SW_LW2 = 9 * MiB, SW_LA2 = 9 * MiB + 64 * KiB, SW_LG2 = 9 * MiB + 128 * KiB, SW_LWA2 = 9 * MiB + 256 * KiB;
constexpr size_t SW_UP = 0, SW_DN = 8 * MiB;
constexpr size_t SW_S5IN = 0, SW_S5OUT = 2 * MiB, SW_BOP = 6 * MiB, SW_COP = 6 * MiB + 256 * KiB, SW_LAM = 6 * MiB + 768 * KiB;
constexpr int CW_BAR = 4096;
constexpr int RING_BYTES = 131072, LDSCTL_OFF = RING_BYTES, MISC_OFF = LDSCTL_OFF + 320, LDS_BYTES = 147456;
constexpr int N_PHASES = 20;

typedef __bf16 bf16x2_t __attribute__((ext_vector_type(2)));
__device__ __forceinline__ unsigned pk2h_raw(float lo, float hi) { const f32x2 v = {lo, hi}; const bf16x2_t b = __builtin_convertvector(v, bf16x2_t); return __builtin_bit_cast(unsigned, b); }
__device__ __forceinline__ unsigned pk2h(float lo, float hi) { unsigned r = pk2h_raw(lo, hi); asm("s_nop 1" : "+v"(r)); return r; }
#ifndef FENCE_PREP
#define FENCE_PREP 0
#endif
#ifndef FENCE_OPS
#define FENCE_OPS 0
#endif
#ifndef FENCE_RING
#define FENCE_RING 0
#endif
#define cvt_fence2(a, b) asm("s_nop 1" : "+v"(a), "+v"(b))
#define cvt_fence3(a, b, c) asm("s_nop 1" : "+v"(a), "+v"(b), "+v"(c))
#define cvt_fence4(a, b, c, d) asm("s_nop 1" : "+v"(a), "+v"(b), "+v"(c), "+v"(d))
#define cvt_fence8(w) asm("s_nop 1" : "+v"((w)[0]), "+v"((w)[1]), "+v"((w)[2]), "+v"((w)[3]), "+v"((w)[4]), "+v"((w)[5]), "+v"((w)[6]), "+v"((w)[7]))
__device__ __forceinline__ unsigned f2bf(float f) { unsigned u = __builtin_bit_cast(unsigned, f); return (u + 0x7fffu + ((u >> 16) & 1u)) >> 16; }
__device__ __forceinline__ unsigned pk2(float lo, float hi) { return f2bf(lo) | (f2bf(hi) << 16); }
__device__ __forceinline__ unsigned pk2i(float lo, float hi) { return pk2(lo, hi); }
__device__ __forceinline__ float bflo(unsigned u) { return __builtin_bit_cast(float, u << 16); }
__device__ __forceinline__ float bfhi(unsigned u) { return __builtin_bit_cast(float, u & 0xffff0000u); }
__device__ __forceinline__ f32x4 unpk4(v2u v) { return (f32x4){bflo(v.x), bfhi(v.x), bflo(v.y), bfhi(v.y)}; }
__device__ __forceinline__ float wave_sum(float v) {
#pragma unroll
    for (int o = 1; o < 64; o <<= 1) v += __shfl_xor(v, o);
    return v;
}
__device__ __forceinline__ float ar8(float x) {
    x += __builtin_amdgcn_update_dpp(0.f, x, 0xB1, 0xF, 0xF, true);
    x += __builtin_amdgcn_update_dpp(0.f, x, 0x4E, 0xF, 0xF, true);
    x += __builtin_amdgcn_update_dpp(0.f, x, 0x141, 0xF, 0xF, true);
    return x;
}
__device__ __forceinline__ float ar16(float x) { x = ar8(x); x += __builtin_amdgcn_update_dpp(0.f, x, 0x140, 0xF, 0xF, true); return x; }
__device__ __forceinline__ float dpp_xor1(float x) { return __builtin_amdgcn_update_dpp(0.f, x, 0xB1, 0xF, 0xF, true); }
__device__ __forceinline__ bool tok_first(int tok) { return tok < TP ? (tok & 2047) == 0 : (tok & 7) == 0; }
__device__ __forceinline__ bool tok_last(int tok) { return tok < TP ? (tok & 2047) == 2047 : (tok & 7) == 7; }
__device__ __forceinline__ float frcp(float v) { return __builtin_amdgcn_rcpf(v); }
__device__ __forceinline__ float sigmoidf_(float v) { return frcp(1.0f + __expf(-v)); }

#define XB_TMO      128
#define XB_XCNT(j)  (256  + 64 * (j))
#define XB_XSUB(j)  (1280 + 64 * (j))
#define XB_XGEN(j)  (2304 + 64 * (j))
#define XB_TOP      3328
#define XB_TOPGEN   3392
#define XCD_BAR_WORDS 3456
#define XB_SPIN_CAP (1u << 18)

__device__ __forceinline__ unsigned xb_ld(unsigned* p)              { return __hip_atomic_load(p, __ATOMIC_RELAXED, __HIP_MEMORY_SCOPE_AGENT); }
__device__ __forceinline__ unsigned xb_add(unsigned* p, unsigned v) { return __hip_atomic_fetch_add(p, v, __ATOMIC_RELAXED, __HIP_MEMORY_SCOPE_AGENT); }
__device__ __forceinline__ unsigned xb_xcc_id() { return (unsigned)__builtin_amdgcn_s_getreg((3 << 11) | 20) & 0xFu; }
#define XB_SPIN(cond, bar) do { unsigned _sp = 0; while (cond) { __builtin_amdgcn_s_sleep(1); \
    if ((++_sp & 255u) == 0u) { if (xb_ld(&(bar)[XB_TMO])) break; if (_sp > XB_SPIN_CAP) { atomicAdd(&(bar)[XB_TMO], 1u); break; } } } } while (0)

__device__ __forceinline__ bool xb_thread0(int wave) { return (__builtin_amdgcn_mbcnt_hi(~0u, __builtin_amdgcn_mbcnt_lo(~0u, 0u)) == 0u) && (wave == 0); }
struct XcdBarrier {
    unsigned* bar; unsigned x; int wave;
    volatile LAS unsigned* st;
};

__device__ __forceinline__ XcdBarrier xcd_barrier_post(unsigned* bar, volatile LAS unsigned* st, int wave) {
    XcdBarrier b; b.bar = bar; b.x = xb_xcc_id(); b.st = st; b.wave = wave;
    if (xb_thread0(wave)) (void)xb_add(&bar[XB_XCNT(b.x)], 1u);
    return b;
}
__device__ __forceinline__ void xcd_barrier_complete(unsigned* bar, unsigned x, unsigned& nloc, unsigned& nx) {
    const unsigned G = gridDim.x * gridDim.y * gridDim.z;
    unsigned sum, cnt, mine, sp = 0u;
    for (;;) {
        sum = 0u; cnt = 0u; mine = 0u;
#pragma unroll
        for (unsigned j = 0; j < 16; ++j) { const unsigned c = xb_ld(&bar[XB_XCNT(j)]); sum += c; cnt += (c > 0u) ? 1u : 0u; mine = (j == x) ? c : mine; }
        if (sum == G) break;
        __builtin_amdgcn_s_sleep(1);
        if ((++sp & 255u) == 0u) { if (xb_ld(&bar[XB_TMO])) break; if (sp > XB_SPIN_CAP) { atomicAdd(&bar[XB_TMO], 1u); break; } }
    }
    nloc = mine > 0u ? mine : 1u; nx = cnt > 0u ? cnt : 1u;
}

__device__ __forceinline__ void xcd_barrier(const XcdBarrier& b) {
    asm volatile("s_waitcnt vmcnt(0)" ::: "memory");
    __syncthreads();
    if (xb_thread0(b.wave)) {
        unsigned* bar = b.bar;
        __builtin_amdgcn_s_waitcnt(0);
        unsigned nloc = b.st[0], nx = b.st[1];
        if (nloc == 0u) { xcd_barrier_complete(bar, b.x, nloc, nx); b.st[0] = nloc; b.st[1] = nx; }
        const unsigned old = xb_add(&bar[XB_XSUB(b.x)], 1u);
        const unsigned gen = old / nloc;
        if (old + 1u == (gen + 1u) * nloc) {
            __builtin_amdgcn_fence(__ATOMIC_RELEASE, "agent");
            asm volatile("s_waitcnt vmcnt(0)" ::: "memory");
            const unsigned og = xb_add(&bar[XB_TOP], 1u);
            const unsigned tg = og / nx;
            if (og + 1u == (tg + 1u) * nx) xb_add(&bar[XB_TOPGEN], 1u);
            else XB_SPIN(xb_ld(&bar[XB_TOPGEN]) == tg, bar);
            __builtin_amdgcn_fence(__ATOMIC_ACQUIRE, "agent");
            xb_add(&bar[XB_XGEN(b.x)], 1u);
            asm volatile("s_waitcnt vmcnt(0)" ::: "memory");
        } else {
            XB_SPIN(xb_ld(&bar[XB_XGEN(b.x)]) == gen, bar);
            __builtin_amdgcn_fence(__ATOMIC_ACQUIRE, "agent");
            asm volatile("s_waitcnt vmcnt(0)" ::: "memory");
        }
    }
    __syncthreads();
}

__device__ __forceinline__ void transpose_item(const float* W, int K, int Nsrc, bf16* WT, int mode, LAS float* scr, int item, int nblk, int lane) {
    const int kb = item / nblk, nb = item % nblk, k0 = 64 * kb, n0 = 32 * nb;
    const int kr = lane >> 3, c4 = 4 * (lane & 7); const bool okc = (n0 + c4 < Nsrc);
    f32x4 v[8];
#pragma unroll
    for (int i = 0; i < 8; ++i) v[i] = okc ? *(const f32x4*)(W + (size_t)(k0 + 8 * i + kr) * Nsrc + n0 + c4) : (f32x4){0.f, 0.f, 0.f, 0.f};
#pragma unroll
    for (int i = 0; i < 8; ++i) { LAS float* d = scr + (8 * i + kr) * 33 + c4; d[0] = v[i].x; d[1] = v[i].y; d[2] = v[i].z; d[3] = v[i].w; }
    LDS_WAIT(); asm volatile("" ::: "memory");
    int rb = n0;
    if (mode == 1) { const int c = n0; rb = (c < 1024) ? (256 * (c >> 7) + (c & 127)) : (256 * ((c - 1024) >> 7) + 128 + ((c - 1024) & 127)); }
    const int c8 = lane & 7;
#pragma unroll
    for (int j = 0; j < 4; ++j) { const int n = (lane >> 3) + 8 * j; const LAS float* s = scr + (8 * c8) * 33 + n;
        v4u o; o.x = pk2h_raw(s[0 * 33], s[1 * 33]); o.y = pk2h_raw(s[2 * 33], s[3 * 33]); o.z = pk2h_raw(s[4 * 33], s[5 * 33]); o.w = pk2h_raw(s[6 * 33], s[7 * 33]); cvt_fence4(o.x, o.y, o.z, o.w);
        *(v4u*)(WT + (size_t)(rb + n) * K + k0 + 8 * c8) = o; }
    LDS_WAIT(); asm volatile("" ::: "memory");
}
__device__ __forceinline__ void transpose_matrix(const float* W, int K, int Nsrc, int Ncover, bf16* WT, int mode, LAS float* scr, int gw, int NGW, int lane) {
    const int nblk = Ncover / 32, nitems = (K / 64) * nblk;
    for (int it = gw; it < nitems; it += NGW) transpose_item(W, K, Nsrc, WT, mode, scr, it, nblk, lane);
}

struct RowRaw { f32x4 xf[4]; v2u xh[4]; v2u mh[4]; };
template <bool HAS_M, int XIN>
__device__ __forceinline__ void rowfix_load(RowRaw& R, int row, int lane, const float* xp, const float* xs, const bf16* xb, const bf16* m) {
    if (XIN == 0) { const float* xr = row < TP ? xp + (size_t)row * D : xs + (size_t)(row - TP) * D;
#pragma unroll
        for (int j = 0; j < 4; ++j) R.xf[j] = ((const f32x4*)xr)[lane + 64 * j];
    } else {
#pragma unroll
        for (int j = 0; j < 4; ++j) R.xh[j] = ((const v2u*)(xb + (size_t)row * D))[lane + 64 * j];
    }
    if (HAS_M) {
#pragma unroll
        for (int j = 0; j < 4; ++j) R.mh[j] = ((const v2u*)(m + (size_t)row * D))[lane + 64 * j];
    }
}
template <bool HAS_M, int XIN, int XOUT, bool WRITE_H, int NSLAB>
__device__ __forceinline__ void rowfix_finish(const RowRaw& R, int row, int lane, bf16* xb, const float* slabs, const f32x4 (&gp)[4], float* xout, const f32x4 (&gq)[4], bf16* h) {
    f32x4 v[4];
#pragma unroll
    for (int j = 0; j < 4; ++j) v[j] = (XIN == 0) ? R.xf[j] : unpk4(R.xh[j]);
    if (HAS_M) {
        f32x4 mm[4]; float s = 0.f;
        if (NSLAB > 0) {
#pragma unroll
            for (int j = 0; j < 4; ++j) mm[j] = (f32x4){0.f, 0.f, 0.f, 0.f};
#pragma unroll
            for (int sl = 0; sl < NSLAB; ++sl) {
                const f32x4* sp = (const f32x4*)(slabs + ((size_t)sl * 1024 + (row - TP)) * D);
#pragma unroll
                for (int j = 0; j < 4; ++j) mm[j] = mm[j] + sp[lane + 64 * j];
            }
        } else {
#pragma unroll
            for (int j = 0; j < 4; ++j) mm[j] = unpk4(R.mh[j]);
        }
#pragma unroll
        for (int j = 0; j < 4; ++j) s += (mm[j].x * mm[j].x + mm[j].y * mm[j].y) + (mm[j].z * mm[j].z + mm[j].w * mm[j].w);
        const float rs = rsqrtf(wave_sum(s) * (1.0f / D) + 1e-6f);
#pragma unroll
        for (int j = 0; j < 4; ++j) v[j] = v[j] + (mm[j] * rs) * gp[j];
    }
    if (XOUT == 2) {
#pragma unroll
        for (int j = 0; j < 4; ++j) ((f32x4*)(xout + (size_t)row * D))[lane + 64 * j] = v[j];
    }
    if (XOUT == 1) {
        unsigned long long* x8 = (unsigned long long*)(xb + (size_t)row * D) + lane; unsigned xw[8];
#pragma unroll
        for (int j = 0; j < 4; ++j) { xw[2 * j] = pk2h_raw(v[j].x, v[j].y); xw[2 * j + 1] = pk2h_raw(v[j].z, v[j].w); }
        cvt_fence8(xw);
#pragma unroll
        for (int j = 0; j < 4; ++j) x8[64 * j] = (unsigned long long)xw[2 * j] | ((unsigned long long)xw[2 * j + 1] << 32);
    }
    if (WRITE_H) {
        float s2 = 0.f;
#pragma unroll
        for (int j = 0; j < 4; ++j) s2 += (v[j].x * v[j].x + v[j].y * v[j].y) + (v[j].z * v[j].z + v[j].w * v[j].w);
        const float rs2 = rsqrtf(wave_sum(s2) * (1.0f / D) + 1e-6f);
        unsigned long long* o8 = (unsigned long long*)(h + (size_t)row * D) + lane; unsigned hw[8];
#pragma unroll
        for (int j = 0; j < 4; ++j) { const f32x4 o = (v[j] * rs2) * gq[j]; hw[2 * j] = pk2h_raw(o.x, o.y); hw[2 * j + 1] = pk2h_raw(o.z, o.w); }
        cvt_fence8(hw);
#pragma unroll
        for (int j = 0; j < 4; ++j) o8[64 * j] = (unsigned long long)hw[2 * j] | ((unsigned long long)hw[2 * j + 1] << 32);
    }
}
template <bool HAS_M, int XIN, int XOUT, bool WRITE_H, int NSLAB>
__device__ __forceinline__ void rowfix_rows(int vcu, int wave, int lane, const float* xp, const float* xs, bf16* xb, const bf16* m, const float* slabs, const float* gpost, float* xout, const float* gpre, bf16* h) {
    f32x4 gp[4], gq[4];
#pragma unroll
    for (int j = 0; j < 4; ++j) { gp[j] = HAS_M ? ((const f32x4*)gpost)[lane + 64 * j] : (f32x4){0.f, 0.f, 0.f, 0.f}; gq[j] = WRITE_H ? ((const f32x4*)gpre)[lane + 64 * j] : (f32x4){0.f, 0.f, 0.f, 0.f}; }
    if (wave < 4) { const int row = TP + 4 * vcu + wave; RowRaw R; rowfix_load<HAS_M && NSLAB == 0, XIN>(R, row, lane, xp, xs, xb, m); rowfix_finish<HAS_M, XIN, XOUT, WRITE_H, NSLAB>(R, row, lane, xb, slabs, gp, xout, gq, h); }
    asm volatile("s_waitcnt vmcnt(0)" ::: "memory");
    __syncthreads();
    for (int i = wave; i < 64; i += 2 * NWAVES) { const int ia = i, ib = i + NWAVES;
        const int rowA = 2048 * ((ia >> 1) & 7) + 2 * (4 * vcu + (ia >> 4)) + (ia & 1), rowB = 2048 * ((ib >> 1) & 7) + 2 * (4 * vcu + (ib >> 4)) + (ib & 1);
        RowRaw RA, RB; rowfix_load<HAS_M, XIN>(RA, rowA, lane, xp, xs, xb, m); rowfix_load<HAS_M, XIN>(RB, rowB, lane, xp, xs, xb, m);
        __builtin_amdgcn_sched_barrier(0);
        rowfix_finish<HAS_M, XIN, XOUT, WRITE_H, 0>(RA, rowA, lane, xb, slabs, gp, xout, gq, h);
        rowfix_finish<HAS_M, XIN, XOUT, WRITE_H, 0>(RB, rowB, lane, xb, slabs, gp, xout, gq, h); }
}

template <int K, int ACT  , bool SHIFT>
__device__ __forceinline__ void prep_afrags(bf16x8 (&A)[K / 16], const bf16* P, int tok, int colbase, const float* mu, const float* shift_state, int kh) {
    constexpr int KS = K / 16, GS = KS < 4 ? KS : 4;
    const bf16* prow = P + (size_t)tok * NMIX + colbase + 8 * kh;
    const bool first = tok_first(tok), sample_tile = tok >= TP;
#pragma unroll
    for (int g0 = 0; g0 < KS; g0 += GS) {
        v4u c[GS], p[GS]; f32x4 m0[GS], m1[GS], s0[GS], s1[GS];
#pragma unroll
        for (int ks = 0; ks < GS; ++ks) c[ks] = *(const v4u*)(prow + 16 * (g0 + ks));
        if (SHIFT) {
            const bf16* pp = first ? prow : prow - NMIX;
#pragma unroll
            for (int ks = 0; ks < GS; ++ks) p[ks] = *(const v4u*)(pp + 16 * (g0 + ks));
#pragma unroll
            for (int ks = 0; ks < GS; ++ks) { const float* mp = mu + colbase + 8 * kh + 16 * (g0 + ks); m0[ks] = *(const f32x4*)mp; m1[ks] = *(const f32x4*)(mp + 4); }
            if (__builtin_amdgcn_readfirstlane((int)sample_tile)) {
                const float* sp = shift_state + (size_t)((tok - TP) >> 3) * PRW + colbase + 8 * kh;
#pragma unroll
                for (int ks = 0; ks < GS; ++ks) { s0[ks] = *(const f32x4*)(sp + 16 * (g0 + ks)); s1[ks] = *(const f32x4*)(sp + 16 * (g0 + ks) + 4); }
            } else {
#pragma unroll
                for (int ks = 0; ks < GS; ++ks) { s0[ks] = (f32x4){0.f, 0.f, 0.f, 0.f}; s1[ks] = (f32x4){0.f, 0.f, 0.f, 0.f}; }
            }
        }
#pragma unroll
        for (int ks = 0; ks < GS; ++ks) {
            float x[8] = {bflo(c[ks].x), bfhi(c[ks].x), bflo(c[ks].y), bfhi(c[ks].y), bflo(c[ks].z), bfhi(c[ks].z), bflo(c[ks].w), bfhi(c[ks].w)};
            if (SHIFT) {
                const float pq[8] = {bflo(p[ks].x), bfhi(p[ks].x), bflo(p[ks].y), bfhi(p[ks].y), bflo(p[ks].z), bfhi(p[ks].z), bflo(p[ks].w), bfhi(p[ks].w)};
                const float sv[8] = {s0[ks].x, s0[ks].y, s0[ks].z, s0[ks].w, s1[ks].x, s1[ks].y, s1[ks].z, s1[ks].w};
                const float mv[8] = {m0[ks].x, m0[ks].y, m0[ks].z, m0[ks].w, m1[ks].x, m1[ks].y, m1[ks].z, m1[ks].w};
#pragma unroll
                for (int j = 0; j < 8; ++j) { const float pv = first ? sv[j] : pq[j]; x[j] = x[j] + (pv - x[j]) * mv[j]; }
            }
#pragma unroll
            for (int j = 0; j < 8; ++j) { if (ACT == 1) x[j] = 1.0f - 2.0f * frcp(1.0f + __expf(2.0f * x[j])); if (ACT == 2) x[j] = sigmoidf_(x[j]); }
            v4u o; o.x = pk2i(x[0], x[1]); o.y = pk2i(x[2], x[3]); o.z = pk2i(x[4], x[5]); o.w = pk2i(x[6], x[7]);
            A[g0 + ks] = __builtin_bit_cast(bf16x8, o);
        }
    }
}
template <int K>
__device__ __forceinline__ void prep_ldb(bf16x8 (&B)[K / 16], const bf16* WT, int n0, int lane) {
    const bf16* brow = WT + (size_t)(n0 + (lane & 31)) * K + 8 * (lane >> 5);
#pragma unroll
    for (int ks = 0; ks < K / 16; ++ks) B[ks] = *(const bf16x8*)(brow + 16 * ks);
}
template <int K>
__device__ __forceinline__ f32x16 prep_mma(const bf16x8 (&A)[K / 16], const bf16x8 (&B)[K / 16]) {
    f32x16 acc;
#pragma unroll
    for (int r = 0; r < 16; ++r) acc[r] = 0.f;
#pragma unroll
    for (int ks = 0; ks < K / 16; ++ks) acc = __builtin_amdgcn_mfma_f32_32x32x16_bf16(A[ks], B[ks], acc, 0, 0, 0);
    return acc;
}
#define PREP_LDSET(KK, WT, BIASP, BS, BB, ntv) do { const int ntl_ = (ntv) < nt1 ? (ntv) : nt1 - 1; BS = (BIASP)[32 * ntl_ + n]; prep_ldb<KK>(BB, WT, 32 * ntl_, lane); } while (0)
#define PREP_NT_LOOP(KK, WT, BIASP, AFRAGS_EARLY, AFRAGS_LATE, EPI) do { bf16x8 B0[(KK) / 16], B1[(KK) / 16], B2[(KK) / 16], B3[(KK) / 16]; float bs0, bs1, bs2, bs3; \
        AFRAGS_EARLY; \
        PREP_LDSET(KK, WT, BIASP, bs0, B0, nt0); PREP_LDSET(KK, WT, BIASP, bs1, B1, nt0 + 1); PREP_LDSET(KK, WT, BIASP, bs2, B2, nt0 + 2); \
        AFRAGS_LATE; \
        for (int nt_ = nt0; nt_ < nt1; nt_ += 4) { \
            PREP_LDSET(KK, WT, BIASP, bs3, B3, nt_ + 3); { const f32x16 acc = prep_mma<KK>(A, B0); const int nt = nt_; const float bias = bs0; EPI } \
            PREP_LDSET(KK, WT, BIASP, bs0, B0, nt_ + 4); { const f32x16 acc = prep_mma<KK>(A, B1); const int nt = nt_ + 1; const float bias = bs1; EPI } \
            PREP_LDSET(KK, WT, BIASP, bs1, B1, nt_ + 5); { const f32x16 acc = prep_mma<KK>(A, B2); const int nt = nt_ + 2; const float bias = bs2; EPI } \
            PREP_LDSET(KK, WT, BIASP, bs2, B2, nt_ + 6); { const f32x16 acc = prep_mma<KK>(A, B3); const int nt = nt_ + 3; const float bias = bs3; EPI } \
        } } while (0)
template <int VAR  , int JSEL = -1, int WPB = NWAVES, int T0 = 0, int NT = TT / 32>
__device__ __forceinline__ void phase_prep(int gw, int NGW, int lane, const float* const* in, const bf16* P, const bf16* w2T, const bf16* a2T, const bf16* g2T, const bf16* wa2T,
                                           float* wdec, bf16* abuf, bf16* gbuf, float* ebuf) {
    constexpr int NU = NT * (JSEL < 0 ? 8 : 4);
    const int nfull = NU / NGW, nrem = NU - nfull * NGW, nwg = NGW / WPB, vcu_ = gw / WPB, wv_ = gw % WPB, nextra = (nrem - vcu_ + nwg - 1) / nwg;
    for (int k = 0; k < nfull + nextra; ++k) {
        int u;
        if (k < nfull) u = gw + k * NGW;
        else { const int e = k - nfull; if (wv_ != ((e + vcu_) & (WPB - 1))) continue; u = nfull * NGW + vcu_ + e * nwg; }
        unsigned z_ = 0u; asm volatile("" : "+v"(z_));
        const int lane_ = (int)__builtin_amdgcn_mbcnt_hi(~0u, __builtin_amdgcn_mbcnt_lo(~0u, z_)); (void)lane;
        const int n = lane_ & 31, hh = lane_ >> 5, kh = hh;
#define lane lane_
        const int tile = T0 + (JSEL < 0 ? (u >> 3) : (u >> 2)), job = JSEL < 0 ? ((u >> 1) & 3) : (2 * JSEL + ((u >> 1) & 1)), hf = u & 1, tok0 = tile * 32, tok = tok0 + (lane & 31);
        const int nt0 = (job == 3) ? 4 * hf : 8 * hf, nt1 = nt0 + ((job == 3) ? 4 : 8);
        if (job == 0) {
            bf16x8 A[4];
            PREP_NT_LOOP(64, w2T, in[I_W0], (void)0, (prep_afrags<64, 1, true>(A, P, tok, 1536, in[I_MU], in[I_SSH], kh)), {
                _Pragma("unroll") for (int r = 0; r < 16; ++r) { const int mm = 8 * (r >> 2) + 4 * hh + (r & 3); const float v = bias + acc[r];
                    const float sg = (VAR & 2) ? v : frcp(1.0f + __expf(-v)); const float wv = (VAR & 2) ? sg * 0.5f : __expf(-0.6065306597126334f * sg); if (!(VAR & 1) || wv == 1234.5f) wdec[(size_t)(tok0 + mm) * 512 + 32 * nt + n] = wv; } });
        } else if (job == 1) {
            bf16x8 A[4];
            PREP_NT_LOOP(64, a2T, in[I_A0], (void)0, (prep_afrags<64, 0, true>(A, P, tok, 1600, in[I_MU], in[I_SSH], kh)), {
                unsigned pkv[8];
                _Pragma("unroll") for (int q = 0; q < 8; ++q) { const float e0 = (VAR & 2) ? bias + acc[2 * q] : sigmoidf_(bias + acc[2 * q]); const float e1 = (VAR & 2) ? bias + acc[2 * q + 1] : sigmoidf_(bias + acc[2 * q + 1]); const bool odd = lane & 1;
                    const float rcv = dpp_xor1(odd ? e0 : e1);
                    pkv[q] = odd ? pk2h_raw(rcv, e1) : pk2h_raw(e0, rcv); }
                if (FENCE_PREP) cvt_fence8(pkv);
                _Pragma("unroll") for (int q = 0; q < 8; ++q) { if (!(VAR & 1) || pkv[q] == 0x12345u) *(unsigned*)(abuf + (size_t)(tok0 + 8 * (q >> 1) + 4 * hh + 2 * (q & 1) + (lane & 1)) * 512 + 32 * nt + (n & ~1)) = pkv[q]; } });
        } else if (job == 2) {
            bf16x8 A[8];
            PREP_NT_LOOP(128, g2T, in[I_A0], (prep_afrags<128, 2, true>(A, P, tok, 1664, in[I_MU], in[I_SSH], kh)), (void)0, { (void)bias;
                unsigned pkv[8];
                _Pragma("unroll") for (int q = 0; q < 8; ++q) { const float e0 = acc[2 * q]; const float e1 = acc[2 * q + 1]; const bool odd = lane & 1;
                    const float rcv = dpp_xor1(odd ? e0 : e1);
                    pkv[q] = odd ? pk2h_raw(rcv, e1) : pk2h_raw(e0, rcv); }
                if (FENCE_PREP) cvt_fence8(pkv);
                _Pragma("unroll") for (int q = 0; q < 8; ++q) { if (!(VAR & 1) || pkv[q] == 0x12345u) *(unsigned*)(gbuf + (size_t)(tok0 + 8 * (q >> 1) + 4 * hh + 2 * (q & 1) + (lane & 1)) * 512 + 32 * nt + (n & ~1)) = pkv[q]; } });
        } else {
            bf16x8 A[1];
            PREP_NT_LOOP(16, wa2T, in[I_BA], (void)0, (prep_afrags<16, 0, false>(A, P, tok, GXA, nullptr, nullptr, kh)), {
                _Pragma("unroll") for (int r = 0; r < 16; ++r) { const int mm = 8 * (r >> 2) + 4 * hh + (r & 3); const float v = bias + acc[r];
                    const float ls = (VAR & 2) ? v : fminf(v, 0.f) - __logf(1.0f + __expf(-fabsf(v))); const float ev = (VAR & 2) ? ls * 0.0625f : __expf(ls * 0.0625f); if (!(VAR & 1) || ev == 1234.5f) ebuf[(size_t)(tok0 + mm) * 256 + 32 * nt + n] = ev; } });
        }
    }
}
#undef lane
#undef PREP_NT_LOOP
#undef PREP_LDSET
constexpr int SS_R = 340, SS_G = 212;
constexpr int LDS_SR = 0, LDS_SG = 2 * 16 * SS_R * 4, LDS_YR = LDS_SG + 2 * 16 * SS_G * 4, LDS_YG = LDS_YR + 2 * 256 * 4, LDS_CT = LDS_YG + 2 * 256 * 4  ,
              LDS_SH = LDS_CT + 5 * 512 * 4  , LDS_SCAN_END = LDS_SH + 24 * 192 * 4;
static_assert(LDS_SCAN_END <= RING_BYTES, "scan LDS");
struct SItem { int tok0, h, r0, kidx; const float* init; float* fin; };
struct ScanCtx { const float* const* in; float* out; const bf16* P; const float* wdec; const bf16* abuf; const float* ebuf; bf16* yr; bf16* og; int sb, nsb; };

template <int TYPE>
__device__ __forceinline__ SItem scan_item(const ScanCtx& C, int i, int half) {
    int k = 2 * i + half, it = C.sb + C.nsb * k;
    if (it >= 4096) { k = 2 * i; it = C.sb + C.nsb * k; }
    SItem d; d.kidx = k; const int b = it >> 5; d.tok0 = TP + 8 * b;
    if (TYPE == 0) { const int h = (it >> 2) & 7; d.h = h; d.r0 = 16 * (it & 3); d.init = C.in[I_SWKV] + (size_t)(b * 8 + h) * 4096; d.fin = C.out + O_WKVS + (size_t)(b * 8 + h) * 4096; }
    else { const int h = (it >> 3) & 3; d.h = h; d.r0 = 16 * (it & 7); d.init = C.in[I_SGLA] + (size_t)(b * 4 + h) * 8192; d.fin = C.out + O_GLAS + (size_t)(b * 4 + h) * 8192; }
    return d;
}
struct LRegR { v2u a0, a1, a2, p0, p1, p2, aa; f32x4 w; };
struct LRegG { v2u a0, a1, a2; f32x4 w; };
__device__ __forceinline__ void ld_issue_r(LRegR& L, const ScanCtx& C, int i, int tg) {
    const int tk = tg >> 4, jq = tg & 15; const SItem d = scan_item<0>(C, i, tk >> 3);
    const int tok = d.tok0 + (tk & 7), col = d.h * 64 + 4 * jq; const bf16* b0 = C.P + (size_t)tok * NMIX + col;
    L.a0 = *(const v2u*)b0; L.a1 = *(const v2u*)(b0 + 512); L.a2 = *(const v2u*)(b0 + 1024);
    L.p0 = *(const v2u*)(b0 - NMIX); L.p1 = *(const v2u*)(b0 - NMIX + 512); L.p2 = *(const v2u*)(b0 - NMIX + 1024);
    L.aa = *(const v2u*)(C.abuf + (size_t)tok * 512 + col);
    L.w = *(const f32x4*)(C.wdec + (size_t)tok * 512 + col);
}
__device__ __forceinline__ void ld_process_r(const LRegR& L, const ScanCtx& C, int i, int tg, LAS float* slots, const LAS float* ct, const LAS float* sh) {
    const int tk = tg >> 4, jq = tg & 15, step = tk & 7; const SItem d = scan_item<0>(C, i, tk >> 3);
    LAS float* slot = slots + (i & 1) * (16 * SS_R);
    const f32x4 r = unpk4(L.a0), kx = unpk4(L.a1), v = unpk4(L.a2);
    const int col = d.h * 64 + 4 * jq;
    f32x4 pr = unpk4(L.p0), pk = unpk4(L.p1), pv = unpk4(L.p2);
    { const LAS float* sp0 = sh + d.kidx * 192 + 4 * jq; const f32x4 s0 = *(const LAS f32x4*)sp0, s1 = *(const LAS f32x4*)(sp0 + 64), s2 = *(const LAS f32x4*)(sp0 + 128);
      if (step == 0) { pr = s0; pk = s1; pv = s2; } }
    const f32x4 mur = *(const LAS f32x4*)(ct + col), muk = *(const LAS f32x4*)(ct + 512 + col), muv = *(const LAS f32x4*)(ct + 1024 + col), kkc = *(const LAS f32x4*)(ct + 1536 + col), kac = *(const LAS f32x4*)(ct + 2048 + col);
    const f32x4 zr = r + (pr - r) * mur, zk = kx + (pk - kx) * muk, zv = v + (pv - v) * muv;
    const f32x4 kkr = zk * kkc;
    const float ss = ar16((kkr.x * kkr.x + kkr.y * kkr.y) + (kkr.z * kkr.z + kkr.w * kkr.w));
    const float inv = rsqrtf(fmaxf(ss, 1e-24f));
    const f32x4 kk = kkr * inv, a = unpk4(L.aa);
    const f32x4 kmod = zk * (1.0f + (a - 1.0f) * kac), bb = kk * a, wr = L.w * zr;
    const f32x4 q1 = kmod * zr, q2 = bb * zr;
    const float c1 = ar16((q1.x + q1.y) + (q1.z + q1.w)), c2 = ar16((q2.x + q2.y) + (q2.z + q2.w));
    LAS float* sp = slot + tk * SS_R + 4 * jq;
    *(LAS f32x4*)(sp) = kk; *(LAS f32x4*)(sp + 64) = L.w; *(LAS f32x4*)(sp + 128) = bb; *(LAS f32x4*)(sp + 192) = kmod; *(LAS f32x4*)(sp + 256) = wr;
    if (4 * jq >= d.r0 && 4 * jq < d.r0 + 16) *(LAS f32x4*)(slot + tk * SS_R + 320 + 4 * jq - d.r0) = zv;
    if (jq == 0) *(LAS f32x2*)(slot + tk * SS_R + 336) = (f32x2){c1, c2};
}
__device__ __forceinline__ void ld_issue_g(LRegG& L, const ScanCtx& C, int i, int tg) {
    const int tk = tg >> 4, jq = tg & 15; const SItem d = scan_item<1>(C, i, tk >> 3);
    const int tok = d.tok0 + (tk & 7); const bf16* prow = C.P + (size_t)tok * NMIX;
    L.a0 = *(const v2u*)(prow + GQ + d.h * 64 + 4 * jq); L.a1 = *(const v2u*)(prow + GK + d.h * 64 + 4 * jq);
    L.a2 = *(const v2u*)(prow + GV + d.h * 128 + d.r0 + 4 * (jq & 3));
    L.w = *(const f32x4*)(C.ebuf + (size_t)tok * 256 + d.h * 64 + 4 * jq);
}
__device__ __forceinline__ void ld_process_g(const LRegG& L, int i, int tg, LAS float* slots) {
    const int tk = tg >> 4, jq = tg & 15;
    LAS float* slot = slots + (i & 1) * (16 * SS_G);
    const f32x4 q = unpk4(L.a0) * 0.125f, kx = unpk4(L.a1), eq = L.w * q, kq = kx * q;
    const float cc = ar16((kq.x + kq.y) + (kq.z + kq.w));
    LAS float* sp = slot + tk * SS_G + 4 * jq;
    *(LAS f32x4*)(sp) = L.w; *(LAS f32x4*)(sp + 64) = kx; *(LAS f32x4*)(sp + 128) = eq;
    if (jq < 4) *(LAS f32x4*)(slot + tk * SS_G + 192 + 4 * jq) = unpk4(L.a2);
    if (jq == 0) slot[tk * SS_G + 208] = cc;
}
template <int TYPE>
__device__ __forceinline__ void flush_y(const ScanCtx& C, int i, int tg, const LAS float* ybuf) {
    const int tk = tg >> 4, row = tg & 15; const SItem d = scan_item<TYPE>(C, i, tk >> 3);
    const int tok = d.tok0 + (tk & 7);
    const float v = ybuf[(i & 1) * 256 + tk * 16 + row];
    if (TYPE == 0) C.yr[(size_t)tok * 512 + d.h * 64 + d.r0 + row] = (bf16)f2bf(v);
    else C.og[(size_t)tok * 512 + d.h * 128 + d.r0 + row] = (bf16)f2bf(v);
}
struct OpR { f32x4 kk, w, bb, kx, wr; float v; f32x2 cc; };
__device__ __forceinline__ OpR ldop_r(const LAS float* slot, int s, int jq, int lr) {
    OpR o; const LAS float* sp = slot + s * SS_R + 4 * jq;
    o.kk = *(const LAS f32x4*)sp; o.w = *(const LAS f32x4*)(sp + 64); o.bb = *(const LAS f32x4*)(sp + 128); o.kx = *(const LAS f32x4*)(sp + 192); o.wr = *(const LAS f32x4*)(sp + 256);
    o.v = slot[s * SS_R + 320 + lr]; o.cc = *(const LAS f32x2*)(slot + s * SS_R + 336); return o;
}
__device__ __forceinline__ float rwkv_step1(f32x4& S, const OpR& o) {
    const f32x4 t = S * o.kk, u = S * o.wr;
    const f32x4 Pp = S * o.w + o.kx * o.v;
    const float d = ar16((t.x + t.y) + (t.z + t.w)), e = ar16((u.x + u.y) + (u.z + u.w));
    S = Pp - o.bb * d;
    return e + o.v * o.cc.x - d * o.cc.y;
}
__device__ __forceinline__ void rwkv_steps2(const LAS float* slot, LAS float* yb, int jq, int lr, f32x4& SA, f32x4& SB) {
    float yk = 0.f;
    OpR ca = ldop_r(slot, 0, jq, lr), cb = ldop_r(slot, 8, jq, lr);
#pragma unroll
    for (int s = 0; s < 8; ++s) {
        OpR na = ca, nb = cb;
        if (s + 1 < 8) na = ldop_r(slot, s + 1, jq, lr);
        __builtin_amdgcn_sched_barrier(0);
        const float ya = rwkv_step1(SA, ca);
        __builtin_amdgcn_sched_barrier(0);
        if (s + 1 < 8) nb = ldop_r(slot, s + 9, jq, lr);
        __builtin_amdgcn_sched_barrier(0);
        const float yb_ = rwkv_step1(SB, cb);
        yk = (jq == s) ? ya : ((jq == s + 8) ? yb_ : yk);
        ca = na; cb = nb;
    }
    yb[jq * 16 + lr] = yk;
}
struct OpG { f32x4 e, kx, eq; float v, cc; };
__device__ __forceinline__ OpG ldop_g(const LAS float* slot, int s, int jq, int lr) {
    OpG o; const LAS float* sp = slot + s * SS_G + 4 * jq;
    o.e = *(const LAS f32x4*)sp; o.kx = *(const LAS f32x4*)(sp + 64); o.eq = *(const LAS f32x4*)(sp + 128);
    o.v = slot[s * SS_G + 192 + lr]; o.cc = slot[s * SS_G + 208]; return o;
}
__device__ __forceinline__ float gla_step1(f32x4& S, const OpG& o) {
    const f32x4 u = S * o.eq;
    S = S * o.e + o.kx * o.v;
    return ar16((u.x + u.y) + (u.z + u.w)) + o.v * o.cc;
}
__device__ __forceinline__ void gla_steps2(const LAS float* slot, LAS float* yb, int jq, int lr, f32x4& SA, f32x4& SB) {
    float yk = 0.f;
    OpG ca = ldop_g(slot, 0, jq, lr), cb = ldop_g(slot, 8, jq, lr);
#pragma unroll
    for (int s = 0; s < 8; ++s) {
        OpG na = ca, nb = cb;
        if (s + 1 < 8) na = ldop_g(slot, s + 1, jq, lr);
        __builtin_amdgcn_sched_barrier(0);
        const float ya = gla_step1(SA, ca);
        __builtin_amdgcn_sched_barrier(0);
        if (s + 1 < 8) nb = ldop_g(slot, s + 9, jq, lr);
        __builtin_amdgcn_sched_barrier(0);
        const float yb_ = gla_step1(SB, cb);
        yk = (jq == s) ? ya : ((jq == s + 8) ? yb_ : yk);
        ca = na; cb = nb;
    }
    yb[jq * 16 + lr] = yk;
}
__device__ __forceinline__ f32x4 gla_state_ld(const float* p) { f32x4 S; S.x = p[0]; S.y = p[128]; S.z = p[256]; S.w = p[384]; return S; }
__device__ __forceinline__ void gla_state_st(float* p, const f32x4& S) { p[0] = S.x; p[128] = S.y; p[256] = S.z; p[384] = S.w; }

template <int VAR>
__device__ __forceinline__ void phase_scan(const ScanCtx& C, LAS unsigned char* lds, int tid) {
    const int wave = __builtin_amdgcn_readfirstlane(tid >> 6), lane = tid & 63;
    const int tg = tid & 255, rp = lane >> 4, jq = lane & 15, lr = 4 * (wave & 3) + rp;
    const int nk = (4096 - C.sb + C.nsb - 1) / C.nsb;
    const int ni = (nk + 1) >> 1;
    LAS float* ct = (LAS float*)(lds + LDS_CT); LAS float* sh = (LAS float*)(lds + LDS_SH);
    for (int i = tid; i < 5 * 512; i += NWAVES * 64) { const int w5 = i >> 9, cc = i & 511; ct[i] = (w5 < 3) ? C.in[I_MU][w5 * 512 + cc] : (w5 == 3 ? C.in[I_KK][cc] : C.in[I_KA][cc]); }
    for (int i = tid; i < nk * 192; i += NWAVES * 64) { const int kk_ = i / 192, rem = i % 192, w3 = rem >> 6, j = rem & 63; const int it = C.sb + C.nsb * kk_, b = it >> 5, h = (it >> 2) & 7;
        sh[i] = C.in[I_SSH][(size_t)b * PRW + w3 * 512 + h * 64 + j]; }
    __syncthreads();
    if (wave < 4) {
        LAS float* slots = (LAS float*)(lds + LDS_SR); LAS float* ybuf = (LAS float*)(lds + LDS_YR);
        LRegR L0, L1; f32x4 SA, SB;
        ld_issue_r(L0, C, 0, tg); ld_issue_r(L1, C, ni > 1 ? 1 : 0, tg);
        { const SItem dA = scan_item<0>(C, 0, 0), dB = scan_item<0>(C, 0, 1); SA = *(const f32x4*)(dA.init + (size_t)(dA.r0 + lr) * 64 + 4 * jq); SB = *(const f32x4*)(dB.init + (size_t)(dB.r0 + lr) * 64 + 4 * jq); }
        ld_process_r(L0, C, 0, tg, slots, ct, sh);
        LDS_BARRIER();
#define SCAN_BODY_R(i_, LI, LP) do { const int i = (i_), inx = i + 1 < ni ? i + 1 : ni - 1, iis = i + 2 < ni ? i + 2 : ni - 1; \
            const SItem nA = scan_item<0>(C, inx, 0), nB = scan_item<0>(C, inx, 1); \
            const f32x4 NA = *(const f32x4*)(nA.init + (size_t)(nA.r0 + lr) * 64 + 4 * jq), NB = *(const f32x4*)(nB.init + (size_t)(nB.r0 + lr) * 64 + 4 * jq); \
            ld_issue_r(LI, C, iis, tg); \
            if (i > 0) flush_y<0>(C, i - 1, tg, ybuf); \
            rwkv_steps2(slots + (i & 1) * (16 * SS_R), ybuf + (i & 1) * 256, jq, lr, SA, SB); \
            { const SItem dA = scan_item<0>(C, i, 0), dB = scan_item<0>(C, i, 1); *(f32x4*)(dA.fin + (size_t)(dA.r0 + lr) * 64 + 4 * jq) = SA; *(f32x4*)(dB.fin + (size_t)(dB.r0 + lr) * 64 + 4 * jq) = SB; } \
            SA = NA; SB = NB; \
            if (i + 1 < ni) ld_process_r(LP, C, i + 1, tg, slots, ct, sh); \
            LDS_BARRIER(); } while (0)
        for (int i2 = 0; i2 < ni; i2 += 2) { SCAN_BODY_R(i2, L0, L1); if (i2 + 1 < ni) SCAN_BODY_R(i2 + 1, L1, L0); }
#undef SCAN_BODY_R
        flush_y<0>(C, ni - 1, tg, ybuf);
    } else {
        LAS float* slots = (LAS float*)(lds + LDS_SG); LAS float* ybuf = (LAS float*)(lds + LDS_YG);
        LRegG L0, L1; f32x4 SA, SB;
        ld_issue_g(L0, C, 0, tg); ld_issue_g(L1, C, ni > 1 ? 1 : 0, tg);
        { const SItem dA = scan_item<1>(C, 0, 0), dB = scan_item<1>(C, 0, 1); SA = gla_state_ld(dA.init + (size_t)(4 * jq) * 128 + dA.r0 + lr); SB = gla_state_ld(dB.init + (size_t)(4 * jq) * 128 + dB.r0 + lr); }
        ld_process_g(L0, 0, tg, slots);
        LDS_BARRIER();
#define SCAN_BODY_G(i_, LI, LP) do { const int i = (i_), inx = i + 1 < ni ? i + 1 : ni - 1, iis = i + 2 < ni ? i + 2 : ni - 1; \
            const SItem nA = scan_item<1>(C, inx, 0), nB = scan_item<1>(C, inx, 1); \
            const f32x4 NA = gla_state_ld(nA.init + (size_t)(4 * jq) * 128 + nA.r0 + lr), NB = gla_state_ld(nB.init + (size_t)(4 * jq) * 128 + nB.r0 + lr); \
            ld_issue_g(LI, C, iis, tg); \
            if (i > 0) flush_y<1>(C, i - 1, tg, ybuf); \
            gla_steps2(slots + (i & 1) * (16 * SS_G), ybuf + (i & 1) * 256, jq, lr, SA, SB); \
            { const SItem dA = scan_item<1>(C, i, 0), dB = scan_item<1>(C, i, 1); gla_state_st(dA.fin + (size_t)(4 * jq) * 128 + dA.r0 + lr, SA); gla_state_st(dB.fin + (size_t)(4 * jq) * 128 + dB.r0 + lr, SB); } \
            SA = NA; SB = NB; \
            if (i + 1 < ni) ld_process_g(LP, i + 1, tg, slots); \
            LDS_BARRIER(); } while (0)
        for (int i2 = 0; i2 < ni; i2 += 2) { SCAN_BODY_G(i2, L0, L1); if (i2 + 1 < ni) SCAN_BODY_G(i2 + 1, L1, L0); }
#undef SCAN_BODY_G
        flush_y<1>(C, ni - 1, tg, ybuf);
    }
    __syncthreads();
}

template <bool DO_R, bool DO_G>
__device__ __forceinline__ void phase_post(int gw, int NGW, int lane, const float* const* in, float* out, const bf16* P, const bf16* yr, const bf16* og, const bf16* abuf, const bf16* gbuf, bf16* A2) {
    const int c0 = 8 * lane;
    float mur[8], muk[8], muv[8], ka[8], rk[8], gng[8], gnb[8], gnorm[8];
#pragma unroll
    for (int j = 0; j < 8; ++j) { mur[j] = in[I_MU][c0 + j]; muk[j] = in[I_MU][512 + c0 + j]; muv[j] = in[I_MU][1024 + c0 + j]; ka[j] = in[I_KA][c0 + j]; rk[j] = in[I_RK][c0 + j];
        gng[j] = in[I_GNG][c0 + j]; gnb[j] = in[I_GNB][c0 + j]; gnorm[j] = in[I_GNORM][(c0 + j) & 127]; }
    for (int tok = gw; tok < TT; tok += NGW) {
        const bf16* prow = P + (size_t)tok * NMIX;
        const bool first = tok_first(tok);
        if (DO_R) {
        float r[8], kx[8], v[8], pr[8], pk[8], pv[8];
        { const v4u a = *(const v4u*)(prow + c0), b = *(const v4u*)(prow + 512 + c0), c = *(const v4u*)(prow + 1024 + c0);
          r[0] = bflo(a.x); r[1] = bfhi(a.x); r[2] = bflo(a.y); r[3] = bfhi(a.y); r[4] = bflo(a.z); r[5] = bfhi(a.z); r[6] = bflo(a.w); r[7] = bfhi(a.w);
          kx[0] = bflo(b.x); kx[1] = bfhi(b.x); kx[2] = bflo(b.y); kx[3] = bfhi(b.y); kx[4] = bflo(b.z); kx[5] = bfhi(b.z); kx[6] = bflo(b.w); kx[7] = bfhi(b.w);
          v[0] = bflo(c.x); v[1] = bfhi(c.x); v[2] = bflo(c.y); v[3] = bfhi(c.y); v[4] = bflo(c.z); v[5] = bfhi(c.z); v[6] = bflo(c.w); v[7] = bfhi(c.w); }
        if (!first) { const v4u a = *(const v4u*)(prow - NMIX + c0), b = *(const v4u*)(prow - NMIX + 512 + c0), c = *(const v4u*)(prow - NMIX + 1024 + c0);
          pr[0] = bflo(a.x); pr[1] = bfhi(a.x); pr[2] = bflo(a.y); pr[3] = bfhi(a.y); pr[4] = bflo(a.z); pr[5] = bfhi(a.z); pr[6] = bflo(a.w); pr[7] = bfhi(a.w);
          pk[0] = bflo(b.x); pk[1] = bfhi(b.x); pk[2] = bflo(b.y); pk[3] = bfhi(b.y); pk[4] = bflo(b.z); pk[5] = bfhi(b.z); pk[6] = bflo(b.w); pk[7] = bfhi(b.w);
          pv[0] = bflo(c.x); pv[1] = bfhi(c.x); pv[2] = bflo(c.y); pv[3] = bfhi(c.y); pv[4] = bflo(c.z); pv[5] = bfhi(c.z); pv[6] = bflo(c.w); pv[7] = bfhi(c.w); }
        else if (tok >= TP) { const float* s = in[I_SSH] + (size_t)((tok - TP) >> 3) * PRW + c0;
#pragma unroll
          for (int j = 0; j < 8; ++j) { pr[j] = s[j]; pk[j] = s[512 + j]; pv[j] = s[1024 + j]; } }
        else {
#pragma unroll
          for (int j = 0; j < 8; ++j) { pr[j] = 0.f; pk[j] = 0.f; pv[j] = 0.f; } }
        const v4u av = *(const v4u*)(abuf + (size_t)tok * 512 + c0), gv = *(const v4u*)(gbuf + (size_t)tok * 512 + c0);
        const float a8[8] = {bflo(av.x), bfhi(av.x), bflo(av.y), bfhi(av.y), bflo(av.z), bfhi(av.z), bflo(av.w), bfhi(av.w)};
        const float g8[8] = {bflo(gv.x), bfhi(gv.x), bflo(gv.y), bfhi(gv.y), bflo(gv.z), bfhi(gv.z), bflo(gv.w), bfhi(gv.w)};
        const v4u yv = *(const v4u*)(yr + (size_t)tok * 512 + c0);
        const float y8[8] = {bflo(yv.x), bfhi(yv.x), bflo(yv.y), bfhi(yv.y), bflo(yv.z), bfhi(yv.z), bflo(yv.w), bfhi(yv.w)};
        float dot = 0.f, sy = 0.f;
#pragma unroll
        for (int j = 0; j < 8; ++j) { r[j] = r[j] + (pr[j] - r[j]) * mur[j]; kx[j] = kx[j] + (pk[j] - kx[j]) * muk[j]; v[j] = v[j] + (pv[j] - v[j]) * muv[j];
            const float km = kx[j] * (1.0f + (a8[j] - 1.0f) * ka[j]); dot += r[j] * km * rk[j]; sy += y8[j]; }
        dot = ar8(dot); const float mean = ar8(sy) * (1.0f / 64.0f);
        float sv = 0.f;
#pragma unroll
        for (int j = 0; j < 8; ++j) { const float dd = y8[j] - mean; sv += dd * dd; }
        const float rstd = rsqrtf(ar8(sv) * (1.0f / 64.0f) + 64e-5f);
        float o[8];
#pragma unroll
        for (int j = 0; j < 8; ++j) o[j] = ((y8[j] - mean) * rstd * gng[j] + gnb[j] + dot * v[j]) * g8[j];
        { v4u w; w.x = pk2h_raw(o[0], o[1]); w.y = pk2h_raw(o[2], o[3]); w.z = pk2h_raw(o[4], o[5]); w.w = pk2h_raw(o[6], o[7]); cvt_fence4(w.x, w.y, w.z, w.w); *(v4u*)(A2 + (size_t)tok * D + c0) = w; }
        }
        if (DO_G) {
        const v4u ov = *(const v4u*)(og + (size_t)tok * 512 + c0);
        const float o8[8] = {bflo(ov.x), bfhi(ov.x), bflo(ov.y), bfhi(ov.y), bflo(ov.z), bfhi(ov.z), bflo(ov.w), bfhi(ov.w)};
        float so = 0.f;
#pragma unroll
        for (int j = 0; j < 8; ++j) so += o8[j] * o8[j];
        const float rs = rsqrtf(ar16(so) * (1.0f / 128.0f) + 1e-6f);
        const v4u zv = *(const v4u*)(prow + GGZ + c0);
        const float z8[8] = {bflo(zv.x), bfhi(zv.x), bflo(zv.y), bfhi(zv.y), bflo(zv.z), bfhi(zv.z), bflo(zv.w), bfhi(zv.w)};
        float o[8];
#pragma unroll
        for (int j = 0; j < 8; ++j) o[j] = o8[j] * rs * gnorm[j] * (z8[j] * sigmoidf_(z8[j]));
        { v4u w; w.x = pk2h_raw(o[0], o[1]); w.y = pk2h_raw(o[2], o[3]); w.z = pk2h_raw(o[4], o[5]); w.w = pk2h_raw(o[6], o[7]); cvt_fence4(w.x, w.y, w.z, w.w); *(v4u*)(A2 + (size_t)tok * D + 512 + c0) = w; }
        }
        if (DO_R && tok_last(tok)) { const int seq = tok < TP ? (tok >> 11) : 8 + ((tok - TP) >> 3);
            float* dst = (seq < 8) ? out + O_SHP + (size_t)seq * PRW : out + O_SHS + (size_t)(seq - 8) * PRW;
            for (int cc = lane; cc < PRW; cc += 64) dst[cc] = __builtin_bit_cast(float, ((unsigned)prow[cc]) << 16); }
    }
}


__device__ __forceinline__ void sincos_d(double x, double& s, double& c) {
    const double TWO_PI = 6.283185307179586476925;
    const double kq = rint(x / TWO_PI); const double r = x - kq * TWO_PI;
    const double t = r * 0.125, t2 = t * t;
    double sn = t * (1.0 + t2 * (-1.0 / 6 + t2 * (1.0 / 120 + t2 * (-1.0 / 5040 + t2 * (1.0 / 362880 + t2 * (-1.0 / 39916800 + t2 * (1.0 / 6227020800.0)))))));
    double cs = 1.0 + t2 * (-0.5 + t2 * (1.0 / 24 + t2 * (-1.0 / 720 + t2 * (1.0 / 40320 + t2 * (-1.0 / 3628800 + t2 * (1.0 / 479001600.0 + t2 * (-1.0 / 87178291200.0)))))));
#pragma unroll
    for (int i = 0; i < 3; ++i) { const double s2 = 2.0 * sn * cs, c2 = cs * cs - sn * sn; sn = s2; cs = c2; }
    s = sn; c = cs;
}
__device__ __forceinline__ void s5_tables(int gtid, int gthreads, const float* const* in, f32x2* Lam, bf16* Bop, bf16* Cop) {
    for (int idx = gtid; idx < 64 * 64; idx += gthreads) {
        const int g = idx >> 6, p = idx & 63;
        const double lr = (double)in[I_LAMRE][idx], li = (double)in[I_LAMIM][idx], dt = exp((double)in[I_LOGDT][g]);
        const double mag = exp(lr * dt); double sn, cs; sincos_d(li * dt, sn, cs);
        const double abr = mag * cs, abi = mag * sn, den = lr * lr + li * li;
        const double fr = ((abr - 1.0) * lr + abi * li) / den, fi = (abi * lr - (abr - 1.0) * li) / den;
        Lam[idx] = (f32x2){(float)abr, (float)abi};
        const float* bre = in[I_BRE] + (size_t)idx * 16; const float* bim = in[I_BIM] + (size_t)idx * 16;
#pragma unroll 4
        for (int c = 0; c < 16; ++c) { const double br = bre[c], bi = bim[c];
            Bop[((size_t)g * 128 + p) * 16 + c] = (bf16)f2bf((float)(fr * br - fi * bi)); Bop[((size_t)g * 128 + 64 + p) * 16 + c] = (bf16)f2bf((float)(fr * bi + fi * br)); }
        const int n = p & 31, q = p >> 5;
        for (int ch = 0; ch < 16; ++ch) { const float cr = in[I_CRE][((size_t)g * 16 + ch) * 64 + p], ci = in[I_CIM][((size_t)g * 16 + ch) * 64 + p];
            Cop[((size_t)g * 32 + ch) * 128 + 4 * n + q] = (bf16)f2bf(cr); Cop[((size_t)g * 32 + ch) * 128 + 4 * n + 2 + q] = (bf16)f2bf(-ci);
            Cop[((size_t)g * 32 + 16 + ch) * 128 + 4 * n + q] = 0; Cop[((size_t)g * 32 + 16 + ch) * 128 + 4 * n + 2 + q] = 0; }
    }
}
__device__ __forceinline__ float sfma(float a, float b, float c) { float d; asm("v_fma_f32 %0, %1, %2, %3" : "=v"(d) : "v"(a), "v"(b), "v"(c)); return d; }
__device__ __forceinline__ float gelu_tanh(float x) { return x * __builtin_amdgcn_rcpf(1.0f + __expf(-1.5957691216057308f * (x + 0.044715f * x * x * x))); }
constexpr int XS_PITCH = 272;
struct S5Ctx { const bf16* U; bf16* YG; const bf16* Bop; const bf16* Cop; const f32x2* Lam; const float* dskip; const float* Us; };
struct S5In { v4u au; v2u u0, u1; };
template <bool FULLOUT>
__device__ __forceinline__ S5In s5_fetch(const S5Ctx& C, int g, int tokA, int tokB, int nvalid, int lane) {
    const int m = lane & 31, kh = lane >> 5, tau = 4 * (m >> 3) + (m & 3), bsel = (m >> 2) & 1;
    const int tokrow = (bsel ? tokB : tokA) + tau;
    S5In I; I.au = (v4u){0u, 0u, 0u, 0u}; I.u0 = I.u1 = (v2u){0u, 0u};
    if (tau < nvalid) {
        if (tokrow >= TP) {
            const float* sp = C.Us + (size_t)(tokrow - TP) * D + g * 16; f32x4 s4[4];
#pragma unroll
            for (int q = 0; q < 4; ++q) s4[q] = *(const f32x4*)(sp + 4 * q);
#pragma unroll
            for (int sl = 1; sl < 4; ++sl) {
#pragma unroll
                for (int q = 0; q < 4; ++q) s4[q] = s4[q] + *(const f32x4*)(sp + (size_t)sl * 1024 * D + 4 * q); }
            unsigned w[8];
#pragma unroll
            for (int q = 0; q < 4; ++q) { w[2 * q] = pk2(s4[q].x, s4[q].y); w[2 * q + 1] = pk2(s4[q].z, s4[q].w); }
            I.au = kh ? (v4u){w[4], w[5], w[6], w[7]} : (v4u){w[0], w[1], w[2], w[3]};
            if (FULLOUT) { I.u0 = kh ? (v2u){w[2], w[3]} : (v2u){w[0], w[1]}; I.u1 = kh ? (v2u){w[6], w[7]} : (v2u){w[4], w[5]}; }
        } else { const bf16* up = C.U + (size_t)tokrow * D + g * 16; I.au = *(const v4u*)(up + 8 * kh); if (FULLOUT) { I.u0 = *(const v2u*)(up + 4 * kh); I.u1 = *(const v2u*)(up + 8 + 4 * kh); } }
    }
    return I;
}
template <bool FULLOUT>
__device__ __forceinline__ S5In s5_fetch_p(const S5Ctx& C, int g, int tokA, int tokB, int lane) {
    const int m = lane & 31, kh = lane >> 5, tau = 4 * (m >> 3) + (m & 3), bsel = (m >> 2) & 1;
    const bf16* up = C.U + (size_t)((bsel ? tokB : tokA) + tau) * D + g * 16;
    S5In I; I.au = *(const v4u*)(up + 8 * kh); I.u0 = I.u1 = (v2u){0u, 0u};
    return I;
}
__device__ __forceinline__ void s5_skip_from_au(S5In& I, int kh) {
    const unsigned s0 = kh ? I.au.x : I.au.z, s1 = kh ? I.au.y : I.au.w;
    const unsigned r0 = (unsigned)__shfl_xor((int)s0, 32), r1 = (unsigned)__shfl_xor((int)s1, 32);
    I.u0 = kh ? (v2u){r0, r1} : (v2u){I.au.x, I.au.y}; I.u1 = kh ? (v2u){I.au.z, I.au.w} : (v2u){r0, r1};
}
template <bool FULLOUT>
__device__ __forceinline__ void s5_chunk(const S5Ctx& C, const S5In& I, int g, int tokA, int tokB, int nvalid, int lane, const bf16x8 (&Bf)[4], const bf16x8 (&Cf)[8],
                                         f32x2 a0, f32x2 a1, const f32x4 (&dsk)[2], float (&st)[4], float (&cap)[4], LAS unsigned char* xs) {
    const int m = lane & 31, kh = lane >> 5, tau = 4 * (m >> 3) + (m & 3), bsel = (m >> 2) & 1;
    const int tokrow = (bsel ? tokB : tokA) + tau;
    const bf16x8 Af = __builtin_bit_cast(bf16x8, I.au);
    f32x16 e[4];
#pragma unroll
    for (int nt = 0; nt < 4; ++nt) {
#pragma unroll
        for (int r = 0; r < 16; ++r) e[nt][r] = 0.f;
        e[nt] = __builtin_amdgcn_mfma_f32_32x32x16_bf16(Af, Bf[nt], e[nt], 0, 0, 0);
    }
    float re0 = st[0], im0 = st[1], re1 = st[2], im1 = st[3];
    asm volatile("s_nop 15\n\ts_nop 15\n\ts_nop 15" : "+v"(e[0]), "+v"(e[1]), "+v"(e[2]), "+v"(e[3]));
    const float na0y = -a0.y, na1y = -a1.y;
#pragma unroll
    for (int r = 0; r < 16; ++r) {
        const float t0 = sfma(na0y, im0, e[0][r]), u0 = sfma(a0.y, re0, e[2][r]), t1 = sfma(na1y, im1, e[1][r]), u1 = sfma(a1.y, re1, e[3][r]);
        const float nr0 = sfma(a0.x, re0, t0), ni0 = sfma(a0.x, im0, u0), nr1 = sfma(a1.x, re1, t1), ni1 = sfma(a1.x, im1, u1);
        re0 = nr0; im0 = ni0; re1 = nr1; im1 = ni1;
        e[0][r] = re0; e[2][r] = im0; e[1][r] = re1; e[3][r] = im1;
        if (r == 7) { cap[0] = re0; cap[1] = im0; cap[2] = re1; cap[3] = im1; }
    }
    st[0] = re0; st[1] = im0; st[2] = re1; st[3] = im1;
    if (FULLOUT) {
        const int n = lane & 31, hh = lane >> 5;
        { v2u xw[16];
#pragma unroll
          for (int r = 0; r < 16; ++r) xw[r] = (v2u){pk2h_raw(e[0][r], e[1][r]), pk2h_raw(e[2][r], e[3][r])};
          __builtin_amdgcn_sched_barrier(0);
          LAS unsigned char* xb = xs + (4 * hh) * XS_PITCH + n * 8;
#pragma unroll
          for (int r = 0; r < 16; ++r) *(LAS v2u*)(xb + (8 * (r >> 2) + (r & 3)) * XS_PITCH) = xw[r]; }
        LDS_WAIT(); asm volatile("" ::: "memory");
        f32x16 y;
#pragma unroll
        for (int r = 0; r < 16; ++r) y[r] = 0.f;
#pragma unroll
        for (int ks = 0; ks < 8; ++ks) { const bf16x8 xf = *(const LAS bf16x8*)(xs + m * XS_PITCH + 32 * ks + 16 * kh); y = __builtin_amdgcn_mfma_f32_32x32x16_bf16(Cf[ks], xf, y, 0, 0, 0); }
        LDS_WAIT(); asm volatile("" ::: "memory");
        if (tau < nvalid) {
            const int hh2 = lane >> 5;
#pragma unroll
            for (int half = 0; half < 2; ++half) {
                const int ch = 8 * half + 4 * hh2;
                const f32x4 u4 = unpk4(half ? I.u1 : I.u0);
                const f32x4 d4 = dsk[half];
                float o[4];
#pragma unroll
                for (int j = 0; j < 4; ++j) o[j] = gelu_tanh(y[4 * half + j] + d4[j] * u4[j]);
                *(v2u*)(C.YG + (size_t)tokrow * D + g * 16 + ch) = (v2u){pk2h(o[0], o[1]), pk2h(o[2], o[3])};
            }
        }
    }
}
__device__ __forceinline__ void s5_load_frags(const S5Ctx& C, int g, int lane, bf16x8 (&Bf)[4], bf16x8 (&Cf)[8], f32x2& a0, f32x2& a1, f32x4 (&dsk)[2]) {
    const int n = lane & 31, kh = lane >> 5;
#pragma unroll
    for (int nt = 0; nt < 4; ++nt) Bf[nt] = *(const bf16x8*)(C.Bop + ((size_t)g * 128 + 32 * nt + n) * 16 + 8 * kh);
#pragma unroll
    for (int ks = 0; ks < 8; ++ks) Cf[ks] = *(const bf16x8*)(C.Cop + ((size_t)g * 32 + n) * 128 + 16 * ks + 8 * kh);
    a0 = C.Lam[g * 64 + n]; a1 = C.Lam[g * 64 + n + 32];
    dsk[0] = *(const f32x4*)(C.dskip + g * 16 + 4 * kh); dsk[1] = *(const f32x4*)(C.dskip + g * 16 + 8 + 4 * kh);
}
template <int VAR = 0>
__device__ __forceinline__ void phase_s5(const S5Ctx& C, const float* const* in, float* out, LAS unsigned char* lds, int tid, int vcu, int G) {
    const int wave = __builtin_amdgcn_readfirstlane(tid >> 6), lane = tid & 63, n = lane & 31, hh = lane >> 5;
    LAS unsigned char* xs = lds + wave * (32 * XS_PITCH);
    LAS f32x4* ebuf = (LAS f32x4*)(lds + 8 * 32 * XS_PITCH);
    bf16x8 Bf[4], Cf[8]; f32x2 a0, a1; f32x4 dsk[2]; float st[4], cap[4];
    if (!(VAR & 1)) for (int u = vcu * NWAVES + wave; u < 64 * 64; u += G * NWAVES) {
        const int bp = u >> 6, g = u & 63, b = 2 * bp + hh;
        s5_load_frags(C, g, lane, Bf, Cf, a0, a1, dsk);
        const size_t sb = ((size_t)b * 64 + g) * 64 + n;
        st[0] = in[I_SRE][sb]; st[1] = in[I_SIM][sb]; st[2] = in[I_SRE][sb + 32]; st[3] = in[I_SIM][sb + 32];
        { const S5In I = s5_fetch<true>(C, g, TP + 16 * bp, TP + 16 * bp + 8, 8, lane); s5_chunk<true>(C, I, g, TP + 16 * bp, TP + 16 * bp + 8, 8, lane, Bf, Cf, a0, a1, dsk, st, cap, xs); }
        out[O_RES + sb] = cap[0]; out[O_IMS + sb] = cap[1]; out[O_RES + sb + 32] = cap[2]; out[O_IMS + sb + 32] = cap[3];
    }
    if (!(VAR & 2)) for (int u = vcu; u < 4 * 64; u += G) {
        int lane_ = lane; asm volatile("" : "+v"(lane_));
        const int lane = lane_, n = lane & 31, hh = lane >> 5;
        const int bp = u >> 6, g = u & 63, b = 2 * bp + hh;
        s5_load_frags(C, g, lane, Bf, Cf, a0, a1, dsk);
        const int tokA = (2 * bp) * 2048 + 256 * wave, tokB = tokA + 2048;
        st[0] = st[1] = st[2] = st[3] = 0.f;
#define S5_PASS(FO) do { S5In I0 = s5_fetch_p<FO>(C, g, tokA, tokB, lane), I1 = s5_fetch_p<FO>(C, g, tokA + 16, tokB + 16, lane), I2 = s5_fetch_p<FO>(C, g, tokA + 32, tokB + 32, lane), I3; \
          for (int c = 0; c < 16; c += 4) { const int c4 = c + 4 < 16 ? c + 4 : 15, c5 = c + 5 < 16 ? c + 5 : 15, c6 = c + 6 < 16 ? c + 6 : 15; \
              I3 = s5_fetch_p<FO>(C, g, tokA + 16 * (c + 3), tokB + 16 * (c + 3), lane); if (FO) s5_skip_from_au(I0, lane >> 5); s5_chunk<FO>(C, I0, g, tokA + 16 * c, tokB + 16 * c, 16, lane, Bf, Cf, a0, a1, dsk, st, cap, xs); \
              I0 = s5_fetch_p<FO>(C, g, tokA + 16 * c4, tokB + 16 * c4, lane); if (FO) s5_skip_from_au(I1, lane >> 5); s5_chunk<FO>(C, I1, g, tokA + 16 * (c + 1), tokB + 16 * (c + 1), 16, lane, Bf, Cf, a0, a1, dsk, st, cap, xs); \
              I1 = s5_fetch_p<FO>(C, g, tokA + 16 * c5, tokB + 16 * c5, lane); if (FO) s5_skip_from_au(I2, lane >> 5); s5_chunk<FO>(C, I2, g, tokA + 16 * (c + 2), tokB + 16 * (c + 2), 16, lane, Bf, Cf, a0, a1, dsk, st, cap, xs); \
              I2 = s5_fetch_p<FO>(C, g, tokA + 16 * c6, tokB + 16 * c6, lane); if (FO) s5_skip_from_au(I3, lane >> 5); s5_chunk<FO>(C, I3, g, tokA + 16 * (c + 3), tokB + 16 * (c + 3), 16, lane, Bf, Cf, a0, a1, dsk, st, cap, xs); } } while (0)
        S5_PASS(false);
        ebuf[wave * 64 + lane] = (f32x4){st[0], st[1], st[2], st[3]};
        f32x2 p0 = a0, p1 = a1;
#pragma unroll
        for (int i = 0; i < 8; ++i) { p0 = (f32x2){p0.x * p0.x - p0.y * p0.y, 2.f * p0.x * p0.y}; p1 = (f32x2){p1.x * p1.x - p1.y * p1.y, 2.f * p1.x * p1.y}; }
        __syncthreads();
        st[0] = st[1] = st[2] = st[3] = 0.f;
        for (int v = 0; v < wave; ++v) { const f32x4 ev = ebuf[v * 64 + lane];
            const float r0 = p0.x * st[0] - p0.y * st[1] + ev.x, i0 = p0.x * st[1] + p0.y * st[0] + ev.y, r1 = p1.x * st[2] - p1.y * st[3] + ev.z, i1 = p1.x * st[3] + p1.y * st[2] + ev.w;
            st[0] = r0; st[1] = i0; st[2] = r1; st[3] = i1; }
        S5_PASS(true);
#undef S5_PASS
        if (wave == 7) { const size_t sb = ((size_t)b * 64 + g) * 64 + n;
            out[O_REP + sb] = st[0]; out[O_IMP + sb] = st[1]; out[O_REP + sb + 32] = st[2]; out[O_IMP + sb + 32] = st[3]; }
        __syncthreads();
    }
}

constexpr int GOP_STRIDE = 11264;
constexpr int GOP_QE = 0, GOP_AE = 4096, GOP_KE = 6144, GOP_GAM = 10240;
constexpr int GVT_STRIDE = 8192;
constexpr int IMG_PITCH = 144;

__device__ __forceinline__ unsigned char* gop_ptr(unsigned char* gopA, unsigned char* gopB, int bh) { return bh < 24 ? gopA + (size_t)bh * (64 * GOP_STRIDE) : gopB + (size_t)(bh - 24) * (64 * GOP_STRIDE); }
__device__ __forceinline__ void phase_pre_gla(int gw, int NGW, int lane, LAS unsigned char* lds_wave, const bf16* P, const float* ebuf, unsigned char* gopA, unsigned char* gopB, unsigned char* gvt) {
    LAS unsigned char* imgQ = lds_wave; LAS unsigned char* imgK = lds_wave + 32 * IMG_PITCH;
    LAS unsigned char* stg = lds_wave + 64 * IMG_PITCH;
    LAS unsigned char* vst = lds_wave;
    LAS unsigned char* vti = lds_wave + 8192;
    LAS unsigned char* rke = lds_wave + 64 * IMG_PITCH;
    LAS unsigned char* rae = rke + 4096;
    for (int u = gw; u < 8 * 4 * 64; u += NGW) {
        const int b = u >> 8, h = (u >> 6) & 3, c = u & 63, tok0 = b * 2048 + 32 * c;
        unsigned char* op = gop_ptr(gopA, gopB, u >> 6) + (size_t)(u & 63) * GOP_STRIDE; unsigned char* vt = gvt + (size_t)u * GVT_STRIDE;
        v4u rq[4], rk[4], re[8], rv[8];
#pragma unroll
        for (int i = 0; i < 4; ++i) { const int p = lane + 64 * i, t = p >> 3, c8 = p & 7; const bf16* prow = P + (size_t)(tok0 + t) * NMIX + h * 64 + 8 * c8; rq[i] = *(const v4u*)(prow + GQ); rk[i] = *(const v4u*)(prow + GK); }
#pragma unroll
        for (int i = 0; i < 8; ++i) { const int p = lane + 64 * i, t = p >> 4, c4 = p & 15; re[i] = *(const v4u*)(ebuf + (size_t)(tok0 + t) * 256 + h * 64 + 4 * c4); }
#pragma unroll
        for (int i = 0; i < 8; ++i) { const int p = lane + 64 * i, t = p >> 4, c8 = p & 15; rv[i] = *(const v4u*)(P + (size_t)(tok0 + t) * NMIX + GV + h * 128 + 8 * c8); }
        __builtin_amdgcn_sched_barrier(0);
#pragma unroll
        for (int i = 0; i < 4; ++i) { const int p = lane + 64 * i, t = p >> 3, c8 = p & 7; *(LAS v4u*)(imgQ + t * IMG_PITCH + 16 * c8) = rq[i]; *(LAS v4u*)(imgK + t * IMG_PITCH + 16 * c8) = rk[i]; }
        float g = 1.0f; float kin[32];
#pragma unroll
        for (int tb = 0; tb < 2; ++tb) {
#pragma unroll
            for (int i = 0; i < 4; ++i) { const int p = lane + 64 * i, t = p >> 4, c4 = p & 15; *(LAS v4u*)(stg + t * 256 + 16 * c4) = re[4 * tb + i]; }
            LDS_WAIT(); asm volatile("" ::: "memory");
            float e16[16]; unsigned qr[16], kr[16];
#pragma unroll
            for (int i = 0; i < 16; ++i) { const int t = 16 * tb + i; e16[i] = *(const LAS float*)(stg + i * 256 + 4 * lane); qr[i] = (unsigned)*(const LAS bf16*)(imgQ + t * IMG_PITCH + 2 * lane); kr[i] = (unsigned)*(const LAS bf16*)(imgK + t * IMG_PITCH + 2 * lane); }
            LDS_WAIT(); asm volatile("" ::: "memory");
#pragma unroll
            for (int i = 0; i < 16; ++i) { const int t = 16 * tb + i; g *= e16[i]; const float qg = bflo(qr[i]) * 0.125f * g, ki = bflo(kr[i]) * frcp(g); kin[t] = ki;
                *(LAS bf16*)(imgQ + t * IMG_PITCH + 2 * lane) = (bf16)f2bf(qg); *(LAS bf16*)(imgK + t * IMG_PITCH + 2 * lane) = (bf16)f2bf(ki); }
        }
        { v4u o[4];
#pragma unroll
          for (int i = 0; i < 4; ++i) { o[i].x = pk2h_raw(kin[8 * i] * g, kin[8 * i + 1] * g); o[i].y = pk2h_raw(kin[8 * i + 2] * g, kin[8 * i + 3] * g); o[i].z = pk2h_raw(kin[8 * i + 4] * g, kin[8 * i + 5] * g); o[i].w = pk2h_raw(kin[8 * i + 6] * g, kin[8 * i + 7] * g);
              cvt_fence4(o[i].x, o[i].y, o[i].z, o[i].w);
              *(LAS v4u*)(rke + lane * 64 + 16 * i) = o[i]; }
          *(float*)(op + GOP_GAM + 4 * lane) = g; }
        LDS_WAIT(); asm volatile("" ::: "memory");
        { const int m = lane & 31, kh = lane >> 5; f32x16 acc;
#pragma unroll
          for (int r = 0; r < 16; ++r) acc[r] = 0.f;
#pragma unroll
          for (int ks = 0; ks < 4; ++ks) { const bf16x8 a = *(const LAS bf16x8*)(imgQ + m * IMG_PITCH + 32 * ks + 16 * kh), bb = *(const LAS bf16x8*)(imgK + m * IMG_PITCH + 32 * ks + 16 * kh);
              acc = __builtin_amdgcn_mfma_f32_32x32x16_bf16(a, bb, acc, 0, 0, 0); }
#pragma unroll
          for (int r8 = 0; r8 < 16; r8 += 8) { unsigned pa[8];
#pragma unroll
              for (int i = 0; i < 8; ++i) { const int r = r8 + i, t = 8 * (r >> 2) + 4 * kh + (r & 3); const float v = (m <= t) ? acc[r] : 0.f; const float nb = dpp_xor1(v); pa[i] = pk2h_raw(v, nb); }
              cvt_fence8(pa);
              if (!(lane & 1)) {
#pragma unroll
                  for (int i = 0; i < 8; ++i) { const int r = r8 + i, t = 8 * (r >> 2) + 4 * kh + (r & 3); *(LAS unsigned*)(rae + t * 64 + 2 * m) = pa[i]; } } }
          LDS_WAIT(); asm volatile("" ::: "memory");
#pragma unroll
          for (int i = 0; i < 4; ++i) { const int pc = lane + 64 * i, t = pc >> 3, cc = pc & 7; *(v4u*)(op + GOP_QE + 16 * pc) = *(const LAS v4u*)(imgQ + t * IMG_PITCH + 16 * cc); }
#pragma unroll
          for (int i = 0; i < 2; ++i) { const int pc = lane + 64 * i; *(v4u*)(op + GOP_AE + 16 * pc) = *(const LAS v4u*)(rae + 16 * pc); }
#pragma unroll
          for (int i = 0; i < 4; ++i) { const int pc = lane + 64 * i; *(v4u*)(op + GOP_KE + 16 * pc) = *(const LAS v4u*)(rke + 16 * pc); }
        }
        LDS_WAIT(); asm volatile("" ::: "memory");
#pragma unroll
        for (int i = 0; i < 8; ++i) { const int p = lane + 64 * i, t = p >> 4, c8 = p & 15; *(LAS v4u*)(vst + t * 256 + 16 * c8) = rv[i]; }
        LDS_WAIT(); asm volatile("" ::: "memory");
#pragma unroll
        for (int pass = 0; pass < 2; ++pass) { const int dv = 64 * pass + lane; unsigned vraw[32];
#pragma unroll
            for (int t = 0; t < 32; ++t) vraw[t] = (unsigned)*(const LAS bf16*)(vst + t * 256 + 2 * dv);
#pragma unroll
            for (int i = 0; i < 4; ++i) *(LAS v4u*)(vti + dv * 64 + 16 * i) = (v4u){vraw[8 * i] | (vraw[8 * i + 1] << 16), vraw[8 * i + 2] | (vraw[8 * i + 3] << 16), vraw[8 * i + 4] | (vraw[8 * i + 5] << 16), vraw[8 * i + 6] | (vraw[8 * i + 7] << 16)}; }
        LDS_WAIT(); asm volatile("" ::: "memory");
#pragma unroll
        for (int i = 0; i < 8; ++i) { const int pc = lane + 64 * i; *(v4u*)(vt + 16 * pc) = *(const LAS v4u*)(vti + 16 * pc); }
        LDS_WAIT(); asm volatile("" ::: "memory");
    }
}

struct SeqOpsG { v2u qe[8]; v4u ae[2]; v4u ke[4]; v4u vt[2]; f32x4 gam[8]; };
__device__ __forceinline__ void seqg_load(SeqOpsG& L, const unsigned char* op, const unsigned char* vt, int nt, int lane) {
    const int m = lane & 31, h = lane >> 5;
#pragma unroll
    for (int ks = 0; ks < 4; ++ks) { L.qe[2 * ks] = *(const v2u*)(op + GOP_QE + m * 128 + 2 * (16 * ks + 4 * h)); L.qe[2 * ks + 1] = *(const v2u*)(op + GOP_QE + m * 128 + 2 * (16 * ks + 8 + 4 * h)); }
#pragma unroll
    for (int ks = 0; ks < 2; ++ks) { L.ae[ks] = *(const v4u*)(op + GOP_AE + m * 64 + 2 * (16 * ks + 8 * h)); L.vt[ks] = *(const v4u*)(vt + (32 * nt + m) * 64 + 2 * (16 * ks + 8 * h)); }
#pragma unroll
    for (int mt = 0; mt < 2; ++mt)
#pragma unroll
        for (int ks = 0; ks < 2; ++ks) L.ke[2 * mt + ks] = *(const v4u*)(op + GOP_KE + (32 * mt + m) * 64 + 2 * (16 * ks + 8 * h));
#pragma unroll
    for (int mt = 0; mt < 2; ++mt)
#pragma unroll
        for (int q = 0; q < 4; ++q) L.gam[4 * mt + q] = *(const f32x4*)(op + GOP_GAM + 4 * (32 * mt + 8 * q + 4 * h));
}
__device__ __forceinline__ void phase_seq_gla(int unit0, int ustride, int lane, const unsigned char* gop, const unsigned char* gvt, bf16* og, float* out) {
    for (int u = unit0; u < 8 * 4 * 4; u += ustride) {
        const int bh = u >> 2, nt = u & 3, b = bh >> 2, h = bh & 3, m = lane & 31, hh = lane >> 5;
        f32x16 H0, H1;
#pragma unroll
        for (int r = 0; r < 16; ++r) { H0[r] = 0.f; H1[r] = 0.f; }
        bf16x8 HB[4];
#pragma unroll
        for (int i = 0; i < 4; ++i) HB[i] = (bf16x8){0, 0, 0, 0, 0, 0, 0, 0};
        SeqOpsG cur, nxt;
        seqg_load(cur, gop + (size_t)(bh * 64) * GOP_STRIDE, gvt + (size_t)(bh * 64) * GVT_STRIDE, nt, lane);
        for (int c = 0; c < 64; ++c) {
            const int cn = (c + 1 < 64) ? c + 1 : c;
            seqg_load(nxt, gop + (size_t)(bh * 64 + cn) * GOP_STRIDE, gvt + (size_t)(bh * 64 + cn) * GVT_STRIDE, nt, lane);
            f32x16 O;
#pragma unroll
            for (int r = 0; r < 16; ++r) O[r] = 0.f;
#pragma unroll
            for (int ks = 0; ks < 4; ++ks) { const v4u a = {cur.qe[2 * ks].x, cur.qe[2 * ks].y, cur.qe[2 * ks + 1].x, cur.qe[2 * ks + 1].y}; O = __builtin_amdgcn_mfma_f32_32x32x16_bf16(__builtin_bit_cast(bf16x8, a), HB[ks], O, 0, 0, 0); }
#pragma unroll
            for (int ks = 0; ks < 2; ++ks) O = __builtin_amdgcn_mfma_f32_32x32x16_bf16(__builtin_bit_cast(bf16x8, cur.ae[ks]), __builtin_bit_cast(bf16x8, cur.vt[ks]), O, 0, 0, 0);
            const int tokc = b * 2048 + 32 * c;
#pragma unroll
            for (int r = 0; r < 16; ++r) { const int t = 8 * (r >> 2) + 4 * hh + (r & 3); const float v = O[r], nb = dpp_xor1(v);
                if (!(lane & 1)) *(unsigned*)(og + (size_t)(tokc + t) * 512 + h * 128 + 32 * nt + m) = pk2h(v, nb); }
#pragma unroll
            for (int r = 0; r < 16; ++r) { H0[r] *= cur.gam[r >> 2][r & 3]; H1[r] *= cur.gam[4 + (r >> 2)][r & 3]; }
#pragma unroll
            for (int ks = 0; ks < 2; ++ks) { H0 = __builtin_amdgcn_mfma_f32_32x32x16_bf16(__builtin_bit_cast(bf16x8, cur.ke[ks]), __builtin_bit_cast(bf16x8, cur.vt[ks]), H0, 0, 0, 0);
                H1 = __builtin_amdgcn_mfma_f32_32x32x16_bf16(__builtin_bit_cast(bf16x8, cur.ke[2 + ks]), __builtin_bit_cast(bf16x8, cur.vt[ks]), H1, 0, 0, 0); }
#pragma unroll
            for (int s2 = 0; s2 < 2; ++s2) { v4u p0, p1;
                p0.x = pk2h(H0[8 * s2], H0[8 * s2 + 1]); p0.y = pk2h(H0[8 * s2 + 2], H0[8 * s2 + 3]); p0.z = pk2h(H0[8 * s2 + 4], H0[8 * s2 + 5]); p0.w = pk2h(H0[8 * s2 + 6], H0[8 * s2 + 7]);
                p1.x = pk2h(H1[8 * s2], H1[8 * s2 + 1]); p1.y = pk2h(H1[8 * s2 + 2], H1[8 * s2 + 3]); p1.z = pk2h(H1[8 * s2 + 4], H1[8 * s2 + 5]); p1.w = pk2h(H1[8 * s2 + 6], H1[8 * s2 + 7]);
                HB[s2] = __builtin_bit_cast(bf16x8, p0); HB[2 + s2] = __builtin_bit_cast(bf16x8, p1); }
            cur = nxt;
        }
        float* st = out + O_GLAP + (size_t)bh * 8192;
#pragma unroll
        for (int r = 0; r < 16; ++r) { const int d = 8 * (r >> 2) + 4 * hh + (r & 3); st[(size_t)d * 128 + 32 * nt + m] = H0[r]; st[(size_t)(32 + d) * 128 + 32 * nt + m] = H1[r]; }
    }
}

constexpr int ROP_QE = 0, ROP_AE = 4096, ROP_KE = 6144, ROP_G = 10240, ROP_STRIDE = 18432;
constexpr int RVT_STRIDE = 4096;
constexpr int JT_PITCH = 80;
constexpr int PR_KKG = 0, PR_RG = 4608, PR_KI = 9216, PR_BI = 13824, PR_KKGT = 18432, PR_BIT = 23552, PR_GAM = 28672, PR_BYTES = 28928;
constexpr int PR_WAVES = 4;
static_assert(PR_WAVES * PR_BYTES <= LDSCTL_OFF, "pre_rwkv LDS");
struct RopMap { unsigned char *a, *b, *c; };
__device__ __forceinline__ unsigned char* rop_ptr(const RopMap& M, int bh) { return bh < 45 ? M.a + (size_t)bh * (64 * ROP_STRIDE) : M.b + (size_t)(bh - 45) * (64 * ROP_STRIDE); }
__device__ __forceinline__ unsigned char* rvt_ptr(const RopMap& M, int bh) { return bh < 50 ? M.b + (size_t)19 * (64 * ROP_STRIDE) + (size_t)bh * (64 * RVT_STRIDE) : M.c + (size_t)(bh - 50) * (64 * RVT_STRIDE); }

__device__ __forceinline__ bf16x8 acc_frag(const f32x16& x, int s) {
    v4u p; p.x = pk2h_raw(x[8 * s], x[8 * s + 1]); p.y = pk2h_raw(x[8 * s + 2], x[8 * s + 3]); p.z = pk2h_raw(x[8 * s + 4], x[8 * s + 5]); p.w = pk2h_raw(x[8 * s + 6], x[8 * s + 7]);
    asm("s_nop 1" : "+v"(p.x), "+v"(p.y), "+v"(p.z), "+v"(p.w));
    return __builtin_bit_cast(bf16x8, p);
}
__device__ __forceinline__ bf16x8 ld_perm(const LAS unsigned char* row, int ks, int h) {
    const v2u lo = *(const LAS v2u*)(row + 2 * (16 * ks + 4 * h)), hi = *(const LAS v2u*)(row + 2 * (16 * ks + 8 + 4 * h)); const v4u p = {lo.x, lo.y, hi.x, hi.y}; return __builtin_bit_cast(bf16x8, p);
}
__device__ __forceinline__ f32x16 zero16() { f32x16 z;
#pragma unroll
    for (int r = 0; r < 16; ++r) z[r] = 0.f;
    return z; }
#define MFMA32(a, b, c) __builtin_amdgcn_mfma_f32_32x32x16_bf16((a), (b), (c), 0, 0, 0)

__device__ __forceinline__ void phase_pre_rwkv(int vcu, int G, int wave, int lane_in, LAS unsigned char* lds, const float* const* in, const bf16* P, const float* wdec, const bf16* abuf, const RopMap& M) {
    if (wave >= PR_WAVES) return;
    LAS unsigned char* L = lds + wave * PR_BYTES;
    for (int u = vcu * PR_WAVES + wave; u < 64 * 64; u += G * PR_WAVES) {
        unsigned z_ = 0u; asm volatile("" : "+v"(z_)); const int lane = (int)__builtin_amdgcn_mbcnt_hi(~0u, __builtin_amdgcn_mbcnt_lo(~0u, z_)); (void)lane_in;
        const int m = lane & 31, hh = lane >> 5;
        const int bh = u >> 6, c = u & 63, b = bh >> 3, h = bh & 7, tok0 = b * 2048 + 32 * c, col = h * 64 + lane;
        unsigned char* op = rop_ptr(M, bh) + (size_t)c * ROP_STRIDE; unsigned char* vt = rvt_ptr(M, bh) + (size_t)c * RVT_STRIDE;
        {
            const int jg = lane & 7, tg = lane >> 3, cb = h * 64 + 8 * jg;
            float cmur[8], cmuk[8], cmuv[8], ckk[8], cka[8];
            { const float* p5[5] = {in[I_MU] + cb, in[I_MU] + 512 + cb, in[I_MU] + 1024 + cb, in[I_KK] + cb, in[I_KA] + cb};
              const f32x4 a0 = *(const f32x4*)p5[0], a1 = *(const f32x4*)(p5[0] + 4), b0 = *(const f32x4*)p5[1], b1 = *(const f32x4*)(p5[1] + 4), c0 = *(const f32x4*)p5[2], c1 = *(const f32x4*)(p5[2] + 4),
                          d0 = *(const f32x4*)p5[3], d1 = *(const f32x4*)(p5[3] + 4), e0 = *(const f32x4*)p5[4], e1 = *(const f32x4*)(p5[4] + 4);
#pragma unroll
              for (int e = 0; e < 4; ++e) { cmur[e] = a0[e]; cmur[4 + e] = a1[e]; cmuk[e] = b0[e]; cmuk[4 + e] = b1[e]; cmuv[e] = c0[e]; cmuv[4 + e] = c1[e]; ckk[e] = d0[e]; ckk[4 + e] = d1[e]; cka[e] = e0[e]; cka[4 + e] = e1[e]; } }
            v4u Lr[5], Lk[5], Lv[5], La[4]; f32x4 Lw[4][2];
            const int tfirst = tok0 + 4 * tg;
#pragma unroll
            for (int i = 0; i < 5; ++i) { const int tok = tfirst + i - 1; const bool ok = (i > 0) || (c > 0) || (tg > 0);
                if (ok) { const bf16* q = P + (size_t)tok * NMIX + cb; Lr[i] = *(const v4u*)q; Lk[i] = *(const v4u*)(q + 512); Lv[i] = *(const v4u*)(q + 1024); }
                else { Lr[i] = Lk[i] = Lv[i] = (v4u){0u, 0u, 0u, 0u}; } }
#pragma unroll
            for (int i = 0; i < 4; ++i) { const int tok = tfirst + i; La[i] = *(const v4u*)(abuf + (size_t)tok * 512 + cb); Lw[i][0] = *(const f32x4*)(wdec + (size_t)tok * 512 + cb); Lw[i][1] = *(const f32x4*)(wdec + (size_t)tok * 512 + cb + 4); }
            float lw[4][8];
#pragma unroll
            for (int e = 0; e < 8; ++e) { float acc = 1.0f;
#pragma unroll
                for (int i = 0; i < 4; ++i) { acc *= Lw[i][e >> 2][e & 3]; lw[i][e] = acc; } }
            float Pin[8], Eex[8];
#pragma unroll
            for (int e = 0; e < 8; ++e) { float p = lw[3][e];
#pragma unroll
                for (int dd = 1; dd < 8; dd <<= 1) { const float o = __shfl_up(p, 8 * dd); p = (tg >= dd) ? p * o : p; }
                Pin[e] = p; const float ex = __shfl_up(p, 8); Eex[e] = (tg >= 1) ? ex : 1.0f; }
            if (tg == 7) { *(LAS f32x4*)(L + PR_GAM + 4 * (8 * jg)) = (f32x4){Pin[0], Pin[1], Pin[2], Pin[3]}; *(LAS f32x4*)(L + PR_GAM + 4 * (8 * jg + 4)) = (f32x4){Pin[4], Pin[5], Pin[6], Pin[7]}; }
            unsigned kkgt[8], bit[8], vtt[8];
#pragma unroll
            for (int i = 0; i < 4; ++i) {
                float r8[8], k8[8], v8[8], pr8[8], pk8[8], pv8[8], a8[8];
                { const v4u x = Lr[i + 1], y = Lk[i + 1], z = Lv[i + 1], xp = Lr[i], yp = Lk[i], zp = Lv[i], aa = La[i];
                  const unsigned xr[4] = {x.x, x.y, x.z, x.w}, yr[4] = {y.x, y.y, y.z, y.w}, zr4[4] = {z.x, z.y, z.z, z.w}, xq[4] = {xp.x, xp.y, xp.z, xp.w}, yq[4] = {yp.x, yp.y, yp.z, yp.w}, zq[4] = {zp.x, zp.y, zp.z, zp.w}, aq[4] = {aa.x, aa.y, aa.z, aa.w};
#pragma unroll
                  for (int e = 0; e < 4; ++e) { r8[2 * e] = bflo(xr[e]); r8[2 * e + 1] = bfhi(xr[e]); k8[2 * e] = bflo(yr[e]); k8[2 * e + 1] = bfhi(yr[e]); v8[2 * e] = bflo(zr4[e]); v8[2 * e + 1] = bfhi(zr4[e]);
                      pr8[2 * e] = bflo(xq[e]); pr8[2 * e + 1] = bfhi(xq[e]); pk8[2 * e] = bflo(yq[e]); pk8[2 * e + 1] = bfhi(yq[e]); pv8[2 * e] = bflo(zq[e]); pv8[2 * e + 1] = bfhi(zq[e]); a8[2 * e] = bflo(aq[e]); a8[2 * e + 1] = bfhi(aq[e]); } }
                float zr[8], zk[8], zv[8], kkr[8]; float ss = 0.f;
#pragma unroll
                for (int e = 0; e < 8; ++e) { zr[e] = r8[e] + (pr8[e] - r8[e]) * cmur[e]; zk[e] = k8[e] + (pk8[e] - k8[e]) * cmuk[e]; zv[e] = v8[e] + (pv8[e] - v8[e]) * cmuv[e]; kkr[e] = zk[e] * ckk[e]; ss += kkr[e] * kkr[e]; }
                ss = ar8(ss); const float inv = rsqrtf(fmaxf(ss, 1e-24f));
                float okkg[8], org[8], oki[8], obi[8];
#pragma unroll
                for (int e = 0; e < 8; ++e) { const float kk = kkr[e] * inv, kmod = zk[e] * (1.0f + (a8[e] - 1.0f) * cka[e]), bb = kk * a8[e];
                    const float gp = Eex[e] * ((i == 0) ? 1.0f : lw[(i == 0) ? 0 : i - 1][e]), gt = Eex[e] * lw[i][e], ig = frcp(gt);
                    okkg[e] = kk * gp; org[e] = zr[e] * gt; oki[e] = kmod * ig; obi[e] = bb * ig; }
                const int t = 4 * tg + i;
                v4u w0, w1, w2, w3;
                w0.x = pk2h_raw(okkg[0], okkg[1]); w0.y = pk2h_raw(okkg[2], okkg[3]); w0.z = pk2h_raw(okkg[4], okkg[5]); w0.w = pk2h_raw(okkg[6], okkg[7]);
                w1.x = pk2h_raw(org[0], org[1]); w1.y = pk2h_raw(org[2], org[3]); w1.z = pk2h_raw(org[4], org[5]); w1.w = pk2h_raw(org[6], org[7]);
                w2.x = pk2h_raw(oki[0], oki[1]); w2.y = pk2h_raw(oki[2], oki[3]); w2.z = pk2h_raw(oki[4], oki[5]); w2.w = pk2h_raw(oki[6], oki[7]);
                w3.x = pk2h_raw(obi[0], obi[1]); w3.y = pk2h_raw(obi[2], obi[3]); w3.z = pk2h_raw(obi[4], obi[5]); w3.w = pk2h_raw(obi[6], obi[7]);
                unsigned pw0[8], pw1[8], pw2[8];
                if (i & 1) {
#pragma unroll
                    for (int e = 0; e < 8; ++e) { pw0[e] = pk2h_raw(__builtin_bit_cast(float, kkgt[e]), okkg[e]); pw1[e] = pk2h_raw(__builtin_bit_cast(float, bit[e]), obi[e]); pw2[e] = pk2h_raw(__builtin_bit_cast(float, vtt[e]), zv[e]); }
                } else {
#pragma unroll
                    for (int e = 0; e < 8; ++e) { kkgt[e] = __builtin_bit_cast(unsigned, okkg[e]); bit[e] = __builtin_bit_cast(unsigned, obi[e]); vtt[e] = __builtin_bit_cast(unsigned, zv[e]); }
                }
                __builtin_amdgcn_sched_barrier(0);
                *(LAS v4u*)(L + PR_KKG + t * IMG_PITCH + 16 * jg) = w0; *(LAS v4u*)(L + PR_RG + t * IMG_PITCH + 16 * jg) = w1; *(LAS v4u*)(L + PR_KI + t * IMG_PITCH + 16 * jg) = w2; *(LAS v4u*)(L + PR_BI + t * IMG_PITCH + 16 * jg) = w3;
                if (i & 1) { const int o2 = 2 * (4 * tg + i - 1);
#pragma unroll
                    for (int e = 0; e < 8; ++e) { *(LAS unsigned*)(L + PR_KKGT + (8 * jg + e) * JT_PITCH + o2) = pw0[e]; *(LAS unsigned*)(L + PR_BIT + (8 * jg + e) * JT_PITCH + o2) = pw1[e]; *(unsigned*)(vt + (8 * jg + e) * 64 + o2) = pw2[e]; } }
            }
        }
        LDS_WAIT(); asm volatile("" ::: "memory"); __builtin_amdgcn_sched_barrier(0);
        f32x16 Akv = zero16(), Akb = zero16(), Ark = zero16(), ArbT = zero16();
#pragma unroll
        for (int ks = 0; ks < 4; ++ks) {
            const int off = m * IMG_PITCH + 32 * ks + 16 * hh;
            const bf16x8 fkkg = *(const LAS bf16x8*)(L + PR_KKG + off), frg = *(const LAS bf16x8*)(L + PR_RG + off), fki = *(const LAS bf16x8*)(L + PR_KI + off), fbi = *(const LAS bf16x8*)(L + PR_BI + off);
            Akv = MFMA32(fkkg, fki, Akv); Akb = MFMA32(fkkg, fbi, Akb); Ark = MFMA32(frg, fki, Ark); ArbT = MFMA32(fbi, frg, ArbT);
        }
        const int mh = m - 4 * hh;
#pragma unroll
        for (int r = 0; r < 16; ++r) { const int rc = 8 * (r >> 2) + (r & 3);
            Akv[r] = (mh < rc) ? Akv[r] : 0.f; Akb[r] = (mh < rc) ? Akb[r] : 0.f; Ark[r] = (mh <= rc) ? Ark[r] : 0.f; ArbT[r] = (rc <= mh) ? ArbT[r] : 0.f; }
        LDS_WAIT(); asm volatile("" ::: "memory"); __builtin_amdgcn_sched_barrier(0);
        { LAS float* A = (LAS float*)(L + PR_KKG);
          { LAS float* Ab = A + (4 * hh) * 32 + m;
#pragma unroll
            for (int r = 0; r < 16; ++r) Ab[(8 * (r >> 2) + (r & 3)) * 32] = Akb[r]; }
          LDS_WAIT(); asm volatile("" ::: "memory"); __builtin_amdgcn_sched_barrier(0);
          float T[32];
#pragma unroll
          for (int t = 0; t < 32; ++t) { float acc4[4] = {(t == m) ? 1.0f : 0.f, 0.f, 0.f, 0.f};
              int dep = 0; if (t > 0) asm volatile("v_and_b32 %0, 0, %1" : "=v"(dep) : "v"(T[t - 1]));
              const LAS float* Ar = A + t * 32 + dep;
#pragma unroll
              for (int s4 = 0; s4 < 8; ++s4) { if (4 * s4 >= t) continue; const f32x4 a4 = *(const LAS f32x4*)(Ar + 4 * s4);
#pragma unroll
                  for (int e = 0; e < 4; ++e) if (4 * s4 + e < t) acc4[e] -= a4[e] * T[4 * s4 + e]; }
              T[t] = (acc4[0] + acc4[1]) + (acc4[2] + acc4[3]); asm volatile("" ::: "memory"); }
          LDS_WAIT(); asm volatile("" ::: "memory"); __builtin_amdgcn_sched_barrier(0);
#pragma unroll
          for (int t = 0; t < 32; ++t) if (hh == 0) *(LAS bf16*)(L + PR_BI + t * JT_PITCH + 2 * m) = (bf16)f2bf(T[t]);
        }
        LDS_WAIT(); asm volatile("" ::: "memory"); __builtin_amdgcn_sched_barrier(0);
        f32x16 Wk0 = zero16(), Wk1 = zero16(), Wv = zero16();
#pragma unroll
        for (int ks = 0; ks < 2; ++ks) {
            const bf16x8 ft = *(const LAS bf16x8*)(L + PR_BI + m * JT_PITCH + 32 * ks + 16 * hh);
            const bf16x8 fb0 = *(const LAS bf16x8*)(L + PR_KKGT + m * JT_PITCH + 32 * ks + 16 * hh), fb1 = *(const LAS bf16x8*)(L + PR_KKGT + (32 + m) * JT_PITCH + 32 * ks + 16 * hh);
            Wk0 = MFMA32(ft, fb0, Wk0); Wk1 = MFMA32(ft, fb1, Wk1);
            Wv = MFMA32(ld_perm(L + PR_BI + m * JT_PITCH, ks, hh), acc_frag(Akv, ks), Wv);
        }
        __builtin_amdgcn_sched_barrier(0);
        { f32x16 q0 = zero16(), q1 = zero16(), ae = zero16();
#pragma unroll
          for (int ks = 0; ks < 2; ++ks) { const bf16x8 fa = acc_frag(ArbT, ks); q0 = MFMA32(fa, acc_frag(Wk0, ks), q0); q1 = MFMA32(fa, acc_frag(Wk1, ks), q1); ae = MFMA32(fa, acc_frag(Wv, ks), ae); }
          const LAS unsigned char* rgb = L + PR_RG + (4 * hh) * IMG_PITCH + 2 * m; unsigned char* qb = op + ROP_QE + (4 * hh) * 128 + 2 * m; unsigned char* ab = op + ROP_AE + (4 * hh) * 64 + 2 * m;
#pragma unroll
          for (int r = 0; r < 16; ++r) { const int rc = 8 * (r >> 2) + (r & 3);
              const float rg0 = bflo(*(const LAS bf16*)(rgb + rc * IMG_PITCH)), rg1 = bflo(*(const LAS bf16*)(rgb + rc * IMG_PITCH + 64));
              const float v0 = rg0 - q0[r], v1 = rg1 - q1[r], v2 = Ark[r] - ae[r]; const float n0 = dpp_xor1(v0), n1 = dpp_xor1(v1), n2 = dpp_xor1(v2);
              { unsigned c0_ = pk2h_raw(v0, n0), c1_ = pk2h_raw(v1, n1), c2_ = pk2h_raw(v2, n2); if (FENCE_OPS) cvt_fence3(c0_, c1_, c2_); if (!(lane & 1)) { *(unsigned*)(qb + rc * 128) = c0_; *(unsigned*)(qb + rc * 128 + 64) = c1_; *(unsigned*)(ab + rc * 64) = c2_; } } }
        }
        __builtin_amdgcn_sched_barrier(0);
#pragma unroll
        for (int mt = 0; mt < 2; ++mt) {
            f32x16 g0 = zero16(), g1 = zero16(), ke = zero16();
#pragma unroll
            for (int ks = 0; ks < 2; ++ks) { const bf16x8 fa = ld_perm(L + PR_BIT + (32 * mt + m) * JT_PITCH, ks, hh); g0 = MFMA32(fa, acc_frag(Wk0, ks), g0); g1 = MFMA32(fa, acc_frag(Wk1, ks), g1); ke = MFMA32(fa, acc_frag(Wv, ks), ke); }
            const LAS unsigned char* gmb = L + PR_GAM + 4 * (4 * hh); const LAS unsigned char* kib = L + PR_KI + m * IMG_PITCH + 2 * (4 * hh);
            unsigned char* gb = op + ROP_G + (4 * hh) * 128 + 2 * m; unsigned char* kb = op + ROP_KE + (4 * hh) * 64 + 2 * m;
#pragma unroll
            for (int q = 0; q < 4; ++q) { const int jc = 32 * mt + 8 * q; const f32x4 gam = *(const LAS f32x4*)(gmb + 4 * jc); const v2u kiv = *(const LAS v2u*)(kib + 2 * jc); const f32x4 ki4 = unpk4(kiv);
#pragma unroll
                for (int e = 0; e < 4; ++e) { const int r = 4 * q + e, je = jc + e;
                    const float v0 = gam[e] * (((mh == je) ? 1.0f : 0.f) - g0[r]), v1 = gam[e] * (((mh == je - 32) ? 1.0f : 0.f) - g1[r]), v2 = gam[e] * (ki4[e] - ke[r]);
                    const float n0 = dpp_xor1(v0), n1 = dpp_xor1(v1), n2 = dpp_xor1(v2);
                    { unsigned c0_ = pk2h_raw(v0, n0), c1_ = pk2h_raw(v1, n1), c2_ = pk2h_raw(v2, n2); if (FENCE_OPS) cvt_fence3(c0_, c1_, c2_); if (!(lane & 1)) { *(unsigned*)(gb + je * 128) = c0_; *(unsigned*)(gb + je * 128 + 64) = c1_; *(unsigned*)(kb + je * 64) = c2_; } } } }
        }
        LDS_WAIT(); asm volatile("" ::: "memory"); __builtin_amdgcn_sched_barrier(0);
    }
}

struct SeqOpsR { v2u qe[8]; v4u ae[2]; v4u ke[4]; v4u vt[2]; v2u g[16]; };
__device__ __forceinline__ void seqr_load(SeqOpsR& L, const unsigned char* op, const unsigned char* vt, int nt, int lane) {
    const int m = lane & 31, h = lane >> 5;
#pragma unroll
    for (int ks = 0; ks < 4; ++ks) { L.qe[2 * ks] = *(const v2u*)(op + ROP_QE + m * 128 + 2 * (16 * ks + 4 * h)); L.qe[2 * ks + 1] = *(const v2u*)(op + ROP_QE + m * 128 + 2 * (16 * ks + 8 + 4 * h)); }
#pragma unroll
    for (int ks = 0; ks < 2; ++ks) { L.ae[ks] = *(const v4u*)(op + ROP_AE + m * 64 + 2 * (16 * ks + 8 * h)); L.vt[ks] = *(const v4u*)(vt + (32 * nt + m) * 64 + 2 * (16 * ks + 8 * h)); }
#pragma unroll
    for (int mt = 0; mt < 2; ++mt) {
#pragma unroll
        for (int ks = 0; ks < 2; ++ks) L.ke[2 * mt + ks] = *(const v4u*)(op + ROP_KE + (32 * mt + m) * 64 + 2 * (16 * ks + 8 * h));
#pragma unroll
        for (int ks = 0; ks < 4; ++ks) { L.g[8 * mt + 2 * ks] = *(const v2u*)(op + ROP_G + (32 * mt + m) * 128 + 2 * (16 * ks + 4 * h)); L.g[8 * mt + 2 * ks + 1] = *(const v2u*)(op + ROP_G + (32 * mt + m) * 128 + 2 * (16 * ks + 8 + 4 * h)); }
    }
}
__device__ __forceinline__ bf16x8 cat2(v2u a, v2u b) { const v4u p = {a.x, a.y, b.x, b.y}; return __builtin_bit_cast(bf16x8, p); }
__device__ __forceinline__ void phase_seq_rwkv(int unit0, int ustride, int lane, const RopMap& M, bf16* yr, float* out) {
    for (int u = unit0; u < 64 * 2; u += ustride) {
        const int bh = u >> 1, nt = u & 1, b = bh >> 3, h = bh & 7, m = lane & 31, hh = lane >> 5;
        const unsigned char* op0 = rop_ptr(M, bh); const unsigned char* vt0 = rvt_ptr(M, bh);
        f32x16 H0 = zero16(), H1 = zero16();
        bf16x8 HB[4];
#pragma unroll
        for (int i = 0; i < 4; ++i) HB[i] = (bf16x8){0, 0, 0, 0, 0, 0, 0, 0};
        SeqOpsR cur, nxt;
        seqr_load(cur, op0, vt0, nt, lane);
        for (int c = 0; c < 64; ++c) {
            const int cn = (c + 1 < 64) ? c + 1 : c;
            seqr_load(nxt, op0 + (size_t)cn * ROP_STRIDE, vt0 + (size_t)cn * RVT_STRIDE, nt, lane);
            f32x16 O = zero16();
#pragma unroll
            for (int ks = 0; ks < 4; ++ks) O = MFMA32(cat2(cur.qe[2 * ks], cur.qe[2 * ks + 1]), HB[ks], O);
#pragma unroll
            for (int ks = 0; ks < 2; ++ks) O = MFMA32(__builtin_bit_cast(bf16x8, cur.ae[ks]), __builtin_bit_cast(bf16x8, cur.vt[ks]), O);
            const int tokc = b * 2048 + 32 * c;
#pragma unroll
            for (int r = 0; r < 16; ++r) { const int t = 8 * (r >> 2) + 4 * hh + (r & 3); const float v = O[r], nb = dpp_xor1(v);
                if (!(lane & 1)) *(unsigned*)(yr + (size_t)(tokc + t) * 512 + h * 64 + 32 * nt + m) = pk2h(v, nb); }
            f32x16 N0 = zero16(), N1 = zero16();
#pragma unroll
            for (int ks = 0; ks < 4; ++ks) { N0 = MFMA32(cat2(cur.g[2 * ks], cur.g[2 * ks + 1]), HB[ks], N0); N1 = MFMA32(cat2(cur.g[8 + 2 * ks], cur.g[8 + 2 * ks + 1]), HB[ks], N1); }
#pragma unroll
            for (int ks = 0; ks < 2; ++ks) { N0 = MFMA32(__builtin_bit_cast(bf16x8, cur.ke[ks]), __builtin_bit_cast(bf16x8, cur.vt[ks]), N0); N1 = MFMA32(__builtin_bit_cast(bf16x8, cur.ke[2 + ks]), __builtin_bit_cast(bf16x8, cur.vt[ks]), N1); }
            H0 = N0; H1 = N1;
            HB[0] = acc_frag(H0, 0); HB[1] = acc_frag(H0, 1); HB[2] = acc_frag(H1, 0); HB[3] = acc_frag(H1, 1);
            cur = nxt;
        }
        float* st = out + O_WKVP + (size_t)bh * 4096 + (size_t)(32 * nt + m) * 64;
#pragma unroll
        for (int q = 0; q < 4; ++q) { *(f32x4*)(st + 8 * q + 4 * hh) = (f32x4){H0[4 * q], H0[4 * q + 1], H0[4 * q + 2], H0[4 * q + 3]};
            *(f32x4*)(st + 32 + 8 * q + 4 * hh) = (f32x4){H1[4 * q], H1[4 * q + 1], H1[4 * q + 2], H1[4 * q + 3]}; }
    }
}

constexpr int RS_QE = 0, RS_AE = 4608, RS_KE = 7168, RS_G = 12288, RS_VT = 21504, RS_SLOT = 26624;
constexpr int GS_QE = 0, GS_AE = 4608, GS_KE = 7168, GS_VT = 12288, GS_GAM = 22528, GS_SLOT = 22784;
static_assert(4 * RS_SLOT <= RING_BYTES && 4 * GS_SLOT <= RING_BYTES, "seq ring");
__device__ __forceinline__ int rs_piece_off(int p) {
    if (p < 256) return RS_QE + (p >> 3) * 144 + (p & 7) * 16;
    if (p < 384) { const int q = p - 256; return RS_AE + (q >> 2) * 80 + (q & 3) * 16; }
    if (p < 640) { const int q = p - 384; return RS_KE + (q >> 2) * 80 + (q & 3) * 16; }
    if (p < 1152) { const int q = p - 640; return RS_G + (q >> 3) * 144 + (q & 7) * 16; }
    const int q = p - 1152; return RS_VT + (q >> 2) * 80 + (q & 3) * 16;
}
__device__ __forceinline__ int gs_piece_off(int p) {
    if (p < 256) return GS_QE + (p >> 3) * 144 + (p & 7) * 16;
    if (p < 384) { const int q = p - 256; return GS_AE + (q >> 2) * 80 + (q & 3) * 16; }
    if (p < 640) { const int q = p - 384; return GS_KE + (q >> 2) * 80 + (q & 3) * 16; }
    if (p < 656) return GS_GAM + (p - 640) * 16;
    const int q = p - 656; return GS_VT + (q >> 2) * 80 + (q & 3) * 16;
}
template <bool IS_GLA> struct SeqCfg;
template <> struct SeqCfg<false> { static constexpr int NC = 2, NL = 6, NPIECE = 1408, SLOT = RS_SLOT, PPL = 4; };
template <> struct SeqCfg<true>  { static constexpr int NC = 4, NL = 4, NPIECE = 1168, SLOT = GS_SLOT, PPL = 5; };

__device__ __forceinline__ bf16x8 lds_frag(const LAS unsigned char* row, int ks, int h) { return *(const LAS bf16x8*)(row + 32 * ks + 16 * h); }

template <bool IS_GLA, int VAR = 0  >
__device__ __forceinline__ void phase_seq_ring(int head, int wave, int lane, LAS unsigned char* lds, const unsigned char* op0, int op_stride, const unsigned char* vt0, int vt_stride, bf16* yout, float* stout) {
    typedef SeqCfg<IS_GLA> Cfg;
    constexpr int PPL = Cfg::PPL, NLT = Cfg::NL * 64, NREC = IS_GLA ? 656 : 1152;
    if (wave >= Cfg::NC) {
        const int lt = (wave - Cfg::NC) * 64 + lane;
        const unsigned char* src[PPL]; unsigned sst[PPL]; int dst[PPL];
#pragma unroll
        for (int i = 0; i < PPL; ++i) { int p = lt + i * NLT; p = p < Cfg::NPIECE ? p : Cfg::NPIECE - 1; const bool isop = p < NREC;
            src[i] = isop ? op0 + 16 * p : vt0 + 16 * (p - NREC); sst[i] = isop ? (unsigned)op_stride : (unsigned)vt_stride; dst[i] = IS_GLA ? gs_piece_off(p) : rs_piece_off(p); }
        v4u R0[PPL], R1[PPL], R2[PPL], R3[PPL];
#define SEQ_ISSUE(RS, j) do { const int jj_ = (j) < 63 ? (j) : 63; _Pragma("unroll") for (int i = 0; i < PPL; ++i) { if (VAR & 1) RS[i] = (v4u){(unsigned)jj_, 0u, 0u, 0u}; else RS[i] = *(const v4u*)(src[i] + (size_t)jj_ * sst[i]); } } while (0)
#define SEQ_WRITE(RS, s) do { _Pragma("unroll") for (int i = 0; i < PPL; ++i) *(LAS v4u*)(lds + (s) * Cfg::SLOT + dst[i]) = RS[i]; } while (0)
        SEQ_ISSUE(R0, 0); SEQ_ISSUE(R1, 1); SEQ_ISSUE(R2, 2); SEQ_ISSUE(R3, 3);
        SEQ_WRITE(R0, 0); SEQ_ISSUE(R0, 4); SEQ_WRITE(R1, 1); SEQ_ISSUE(R1, 5);
        LDS_BARRIER();
        for (int c4 = 0; c4 < 64; c4 += 4) {
            SEQ_WRITE(R2, 2); SEQ_ISSUE(R2, c4 + 6); LDS_BARRIER();
            SEQ_WRITE(R3, 3); SEQ_ISSUE(R3, c4 + 7); LDS_BARRIER();
            SEQ_WRITE(R0, 0); SEQ_ISSUE(R0, c4 + 8); LDS_BARRIER();
            SEQ_WRITE(R1, 1); SEQ_ISSUE(R1, c4 + 9); LDS_BARRIER();
        }
#undef SEQ_ISSUE
#undef SEQ_WRITE
    } else {
        const int m = lane & 31, hh = lane >> 5, nt = wave;
        const int b = IS_GLA ? (head >> 2) : (head >> 3), h = IS_GLA ? (head & 3) : (head & 7);
        f32x16 H0 = zero16(), H1 = zero16();
        bf16x8 HB[4];
#pragma unroll
        for (int i = 0; i < 4; ++i) HB[i] = (bf16x8){0, 0, 0, 0, 0, 0, 0, 0};
        LDS_BARRIER();
        f32x16 Oprev = zero16();
#define SEQ_STORE_O(OV, cc) do { bf16* yb_ = yout + (size_t)(b * 2048 + 32 * (cc) + 4 * hh + (lane & 1)) * 512 + (IS_GLA ? h * 128 : h * 64) + 32 * nt + (m & ~1); \
            _Pragma("unroll") for (int q = 0; q < 8; ++q) { const float e0 = OV[2 * q], e1 = OV[2 * q + 1]; const bool odd = lane & 1; const float snd = odd ? e0 : e1, rcv = dpp_xor1(snd); \
                *(unsigned*)(yb_ + (size_t)(8 * (q >> 1) + 2 * (q & 1)) * 512) = odd ? pk2h(rcv, e1) : pk2h(e0, rcv); } } while (0)
        for (int c4 = 0; c4 < 64; c4 += 4) {
#pragma unroll
            for (int ci = 0; ci < 4; ++ci) {
                const int c = c4 + ci;
                if (VAR & 2) { LDS_BARRIER(); continue; }
                const LAS unsigned char* S = lds + ci * Cfg::SLOT;
                const LAS unsigned char* qrow = S + RS_QE + m * 144; const LAS unsigned char* arow = S + RS_AE + m * 80;
                const LAS unsigned char* vrow = S + (IS_GLA ? GS_VT : RS_VT) + (32 * nt + m) * 80;
                const LAS unsigned char* k0row = S + RS_KE + m * 80; const LAS unsigned char* k1row = S + RS_KE + (32 + m) * 80;
                const LAS unsigned char* g0row = S + RS_G + m * 144; const LAS unsigned char* g1row = S + RS_G + (32 + m) * 144;
                bf16x8 fq[4], fg0[4], fg1[4];
                f32x4 gm0[4], gm1[4];
#pragma unroll
                for (int ks = 0; ks < 4; ++ks) fq[ks] = ld_perm(qrow, ks, hh);
                if (!IS_GLA) {
#pragma unroll
                    for (int ks = 0; ks < 4; ++ks) { fg0[ks] = ld_perm(g0row, ks, hh); fg1[ks] = ld_perm(g1row, ks, hh); }
                } else {
#pragma unroll
                    for (int q = 0; q < 4; ++q) { gm0[q] = *(const LAS f32x4*)(S + GS_GAM + 4 * (8 * q + 4 * hh)); gm1[q] = *(const LAS f32x4*)(S + GS_GAM + 4 * (32 + 8 * q + 4 * hh)); }
                }
                const bf16x8 fv0 = lds_frag(vrow, 0, hh), fv1 = lds_frag(vrow, 1, hh), fa0 = lds_frag(arow, 0, hh), fa1 = lds_frag(arow, 1, hh);
                const bf16x8 fk00 = lds_frag(k0row, 0, hh), fk01 = lds_frag(k0row, 1, hh), fk10 = lds_frag(k1row, 0, hh), fk11 = lds_frag(k1row, 1, hh);
                __builtin_amdgcn_sched_barrier(0);
                const int cprev = c > 0 ? c - 1 : 0;
                bf16* ybp = yout + (size_t)(b * 2048 + 32 * cprev + 4 * hh + (lane & 1)) * 512 + (IS_GLA ? h * 128 : h * 64) + 32 * nt + (m & ~1);
#define SEQ_PIECE2(qa, qb_) do { const bool odd_ = lane & 1; const float a0_ = Oprev[2 * (qa)], a1_ = Oprev[2 * (qa) + 1], b0_ = Oprev[2 * (qb_)], b1_ = Oprev[2 * (qb_) + 1]; \
                    const float ra_ = dpp_xor1(odd_ ? a0_ : a1_), rb_ = dpp_xor1(odd_ ? b0_ : b1_); \
                    unsigned pa_ = odd_ ? pk2h_raw(ra_, a1_) : pk2h_raw(a0_, ra_), pb_ = odd_ ? pk2h_raw(rb_, b1_) : pk2h_raw(b0_, rb_); if (FENCE_RING) cvt_fence2(pa_, pb_); \
                    *(unsigned*)(ybp + (size_t)(8 * ((qa) >> 1) + 2 * ((qa) & 1)) * 512) = pa_; *(unsigned*)(ybp + (size_t)(8 * ((qb_) >> 1) + 2 * ((qb_) & 1)) * 512) = pb_; } while (0)
                f32x16 O = zero16(), N0, N1;
                if (IS_GLA) {
                    N0 = H0; N1 = H1;
                    O = MFMA32(fq[0], HB[0], O); O = MFMA32(fq[1], HB[1], O);
#pragma unroll
                    for (int q = 0; q < 4; ++q) {
#pragma unroll
                        for (int e = 0; e < 4; ++e) { N0[4 * q + e] *= gm0[q][e]; N1[4 * q + e] *= gm1[q][e]; } }
                    __builtin_amdgcn_sched_barrier(0);
                    O = MFMA32(fq[2], HB[2], O); N0 = MFMA32(fk00, fv0, N0); SEQ_PIECE2(0, 1); __builtin_amdgcn_sched_barrier(0);
                    O = MFMA32(fq[3], HB[3], O); N1 = MFMA32(fk10, fv0, N1); SEQ_PIECE2(2, 3); __builtin_amdgcn_sched_barrier(0);
                    O = MFMA32(fa0, fv0, O); N0 = MFMA32(fk01, fv1, N0); SEQ_PIECE2(4, 5); __builtin_amdgcn_sched_barrier(0);
                    O = MFMA32(fa1, fv1, O); N1 = MFMA32(fk11, fv1, N1); SEQ_PIECE2(6, 7); __builtin_amdgcn_sched_barrier(0);
                } else {
                    N0 = zero16(); N1 = zero16();
                    O = MFMA32(fq[0], HB[0], O); N0 = MFMA32(fg0[0], HB[0], N0); N1 = MFMA32(fg1[0], HB[0], N1); __builtin_amdgcn_sched_barrier(0);
                    O = MFMA32(fq[1], HB[1], O); N0 = MFMA32(fg0[1], HB[1], N0); N1 = MFMA32(fg1[1], HB[1], N1); SEQ_PIECE2(0, 1); __builtin_amdgcn_sched_barrier(0);
                    O = MFMA32(fq[2], HB[2], O); N0 = MFMA32(fg0[2], HB[2], N0); N1 = MFMA32(fg1[2], HB[2], N1); __builtin_amdgcn_sched_barrier(0);
                    O = MFMA32(fq[3], HB[3], O); N0 = MFMA32(fg0[3], HB[3], N0); N1 = MFMA32(fg1[3], HB[3], N1); SEQ_PIECE2(2, 3); __builtin_amdgcn_sched_barrier(0);
                    O = MFMA32(fa0, fv0, O); N0 = MFMA32(fk00, fv0, N0); N1 = MFMA32(fk10, fv0, N1); SEQ_PIECE2(4, 5); __builtin_amdgcn_sched_barrier(0);
                    O = MFMA32(fa1, fv1, O); N0 = MFMA32(fk01, fv1, N0); N1 = MFMA32(fk11, fv1, N1); SEQ_PIECE2(6, 7); __builtin_amdgcn_sched_barrier(0);
                }
#undef SEQ_PIECE2
                H0 = N0; H1 = N1;
                HB[0] = acc_frag(H0, 0); HB[1] = acc_frag(H0, 1); HB[2] = acc_frag(H1, 0); HB[3] = acc_frag(H1, 1);
                Oprev = O;
                LDS_BARRIER();
            }
        }
        if (!(VAR & 2)) SEQ_STORE_O(Oprev, 63);
#undef SEQ_STORE_O
        if (IS_GLA) { float* st = stout + (size_t)head * 8192 + (size_t)(4 * hh) * 128 + 32 * nt + m;
#pragma unroll
            for (int r = 0; r < 16; ++r) { const int dc = 8 * (r >> 2) + (r & 3); st[(size_t)dc * 128] = H0[r]; st[(size_t)(32 + dc) * 128] = H1[r]; }
        } else { float* st = stout + (size_t)head * 4096 + (size_t)(32 * nt + m) * 64 + 4 * hh;
#pragma unroll
            for (int q = 0; q < 4; ++q) { *(f32x4*)(st + 8 * q) = (f32x4){H0[4 * q], H0[4 * q + 1], H0[4 * q + 2], H0[4 * q + 3]}; *(f32x4*)(st + 32 + 8 * q) = (f32x4){H1[4 * q], H1[4 * q + 1], H1[4 * q + 2], H1[4 * q + 3]}; }
        }
    }
    __syncthreads();
}

struct Args { const float* in[N_IN]; float* out; unsigned char* ws; int ph_lo, ph_hi, use_bar, pad; };
#ifndef MK_N_LAUNCHES
#define MK_N_LAUNCHES 1
#endif

__global__ void __launch_bounds__(NWAVES * 64, 2) mega_fwd(Args args) {
    extern __shared__ __attribute__((aligned(16))) unsigned char lds_raw[];
    LAS unsigned char* lds = (LAS unsigned char*)lds_raw;
    volatile LAS unsigned* MISC = (volatile LAS unsigned*)(lds + MISC_OFF);
    const int tid = threadIdx.x, lane = tid & 63, wave = __builtin_amdgcn_readfirstlane(tid >> 6);
    const int G = gridDim.x, bx = blockIdx.x, vcu = (G % 8 == 0) ? (bx % 8) * (G / 8) + bx / 8 : bx;
    const int gw = vcu * NWAVES + wave, NGW = G * NWAVES;
    const float* const* in = args.in; float* out = args.out; unsigned char* ws = args.ws;
    for (int u = tid; u < (LDS_BYTES - LDSCTL_OFF) / 4; u += NWAVES * 64) ((LAS unsigned*)(lds + LDSCTL_OFF))[u] = 0u;
    __syncthreads();
    unsigned* ctl = (unsigned*)(ws + WS_CTL);
    XcdBarrier bar; bar.bar = ctl + CW_BAR; bar.x = 0; bar.st = nullptr; bar.wave = wave;
    if (args.use_bar) bar = xcd_barrier_post(ctl + CW_BAR, MISC + 8, wave);
    const int lo = args.ph_lo, hi = args.ph_hi;
#ifndef PROBE_MASK
#define PROBE_MASK 0
#endif
#ifndef PROBE_SUB
#define PROBE_SUB 0
#endif
#define REPS(k) (1 + ((PROBE_MASK >> (k)) & 1))
#define IN_PH(k) (lo <= (k) && (k) < hi)
#define PH_BEGIN(k) if (IN_PH(k)) { int lane = (int)__builtin_amdgcn_mbcnt_hi(~0u, __builtin_amdgcn_mbcnt_lo(~0u, 0u)); int tid = wave * 64 + lane;   _Pragma("unroll 1") for (int rep_ = 0; rep_ < REPS(k); ++rep_) { if (rep_ > 0) xcd_barrier(bar);
#define PH_END }}
#define SEAM(k) do { if (IN_PH(k) && IN_PH((k) + 1)) xcd_barrier(bar); } while (0)
    unsigned char* slotw = ws + WS_SLOTW;
    bf16* w2t = (bf16*)(out + O_REP);
    float* RM = (float*)(ws + WS_RM); bf16* RMB = (bf16*)(ws + WS_RM); bf16* RH = (bf16*)(ws + WS_RH);
    bf16* P = (bf16*)(ws + WS_R2); bf16* gbuf = (bf16*)(ws + WS_R2 + 119 * MiB); bf16* HID = (bf16*)(ws + WS_R2); bf16* UB = (bf16*)(ws + WS_R2);
    bf16* yr = (bf16*)RM; bf16* og = (bf16*)out;
    unsigned char* gopA = ws + WS_RM + 17 * MiB; unsigned char* gopB = ws + WS_RM + 50 * MiB; unsigned char* gvt = ws + WS_RM + 34 * MiB;
    float* wdec = out; bf16* abuf = (bf16*)((unsigned char*)out + 34 * MiB); float* ebuf = (float*)((unsigned char*)out + 51 * MiB);
    bf16* xresb = (bf16*)(ws + WS_RM + 34 * MiB);
    LAS float* scr = (LAS float*)(lds + wave * 16384);

    PH_BEGIN(0) {
        transpose_matrix(in[I_WMIXIN], 1024, NMIX_REAL, NMIX, (bf16*)(slotw + SW_W1T), 0, scr, gw, NGW, lane);
        transpose_matrix(in[I_WMIXOUT], 1024, 1024, 1024, w2t, 0, scr, gw, NGW, lane);
        transpose_matrix(in[I_W2], 64, 512, 512, (bf16*)(slotw + SW_LW2), 0, scr, gw, NGW, lane);
        transpose_matrix(in[I_A2], 64, 512, 512, (bf16*)(slotw + SW_LA2), 0, scr, gw, NGW, lane);
        transpose_matrix(in[I_G2], 128, 512, 512, (bf16*)(slotw + SW_LG2), 0, scr, gw, NGW, lane);
        { bf16* wa2T = (bf16*)(slotw + SW_LWA2); for (int i = bx * (NWAVES * 64) + tid; i < 256 * 16; i += G * NWAVES * 64) { const int n = i >> 4, k = i & 15; wa2T[i] = (bf16)f2bf(in[I_WA2][k * 256 + n]); } }
        rowfix_rows<false, 0, 0, true, 0>(vcu, wave, lane, in[I_XP], in[I_XS], nullptr, nullptr, nullptr, nullptr, nullptr, in[I_NMPRE], RH);
    }
    PH_END
    SEAM(0);
    PH_BEGIN(1) { pg8::Gemm g{RH, (const bf16*)(slotw + SW_W1T), TT, NMIX, 1024}; pg8::StaticOrder S; S.init(TT, NMIX, G, bx, 1024);
        pg8::EpiBf16<0> E{P, NMIX}; pg8::gemm_phase<pg8::EpiBf16<0>, pg8::StaticOrder, true, true>(lds, g, S, E, tid); }
    PH_END
    SEAM(1);
    PH_BEGIN(2) phase_prep<0, 0, NWAVES, 0, TP / 32>(gw, NGW, lane, in, P, (const bf16*)(slotw + SW_LW2), (const bf16*)(slotw + SW_LA2), (const bf16*)(slotw + SW_LG2), (const bf16*)(slotw + SW_LWA2), wdec, abuf, gbuf, ebuf);
    PH_END
    SEAM(2);
#define FFN_WEIGHTS(layer, wb, gw_, NGW_) do { \
        transpose_matrix(in[I_WUP] + (size_t)(layer) * 1024 * 4096, 1024, 4096, 4096, (bf16*)((wb) + SW_UP), 0, scr, gw_, NGW_, lane); \
        transpose_matrix(in[I_WDN] + (size_t)(layer) * 4096 * 1024, 4096, 1024, 1024, (bf16*)((wb) + SW_DN), 0, scr, gw_, NGW_, lane); } while (0)
    RopMap rmap; rmap.a = ws + WS_RM + 17 * MiB; rmap.b = (unsigned char*)RH; rmap.c = slotw + SW_W1T;
    PH_BEGIN(3) {
        if (wave < 4) phase_pre_rwkv(vcu, G, wave, 0, lds, in, P, wdec, abuf, rmap);
        else { phase_prep<0, 1, 4>(vcu * 4 + (wave - 4), G * 4, 0, in, P, (const bf16*)(slotw + SW_LW2), (const bf16*)(slotw + SW_LA2), (const bf16*)(slotw + SW_LG2), (const bf16*)(slotw + SW_LWA2), wdec, abuf, gbuf, ebuf);
            phase_prep<0, 0, 4, TP / 32, TS / 32>(vcu * 4 + (wave - 4), G * 4, 0, in, P, (const bf16*)(slotw + SW_LW2), (const bf16*)(slotw + SW_LA2), (const bf16*)(slotw + SW_LG2), (const bf16*)(slotw + SW_LWA2), wdec, abuf, gbuf, ebuf); } }
    PH_END
    SEAM(3);
    PH_BEGIN(4) {
        const bool do_ring = !(rep_ > 0 && PROBE_SUB == 2), do_scan = !(rep_ > 0 && PROBE_SUB == 1);
        if (bx < 64) { if (do_ring) phase_seq_ring<false>(bx, wave, lane, lds, rop_ptr(rmap, bx), ROP_STRIDE, rvt_ptr(rmap, bx), RVT_STRIDE, yr, out + O_WKVP); }
        else if (do_scan) { ScanCtx C; C.in = in; C.out = out; C.P = P; C.wdec = wdec; C.abuf = abuf; C.ebuf = ebuf; C.yr = yr; C.og = og; C.sb = bx - 64; C.nsb = G - 64; phase_scan<0>(C, lds, tid); }
    }
    PH_END
    SEAM(4);
    PH_BEGIN(5) phase_pre_gla(gw, NGW, lane, lds + wave * 16384, P, ebuf, gopA, gopB, gvt);
    PH_END
    SEAM(5);
    PH_BEGIN(6) { const bool do_ring = !(rep_ > 0 && PROBE_SUB == 2), do_post = !(rep_ > 0 && PROBE_SUB == 1);
        if (bx < 32) { if (do_ring) phase_seq_ring<true>(bx, wave, lane, lds, gop_ptr(gopA, gopB, bx), GOP_STRIDE, gvt + (size_t)bx * 64 * GVT_STRIDE, GVT_STRIDE, og, out + O_GLAP); }
        else if (do_post) { phase_post<true, false>((bx - 32) * NWAVES + wave, (G - 32) * NWAVES, lane, in, out, P, yr, og, abuf, gbuf, RH);
            if (rep_ == 0) FFN_WEIGHTS(0, slotw, (bx - 32) * NWAVES + wave, (G - 32) * NWAVES); } }
    PH_END
    SEAM(6);
    PH_BEGIN(7) phase_post<false, true>(gw, NGW, lane, in, out, P, yr, og, abuf, gbuf, RH);
    PH_END
    SEAM(7);
    PH_BEGIN(8) { pg8::Gemm g{RH, w2t, TT, 1024, 1024}; pg8::SplitOrder S; S.init(TP, TS, 1024, G, bx, 1024, 4);
        pg8::EpiF32 E{RMB, 1024, (float*)(ws + WS_R2), TP, TS}; pg8::gemm_phase<pg8::EpiF32, pg8::SplitOrder, true, true>(lds, g, S, E, tid); }
    PH_END
    SEAM(8);
#define FFN_UP(wb) do { pg8::Gemm g{RH, (const bf16*)((wb) + SW_UP), TT, 4096, 1024}; pg8::StaticOrder S; S.init(TT, 4096, G, bx, 1024); \
        pg8::EpiBf16<3> E{HID, 4096}; pg8::gemm_phase<pg8::EpiBf16<3>, pg8::StaticOrder, true, true>(lds, g, S, E, tid); } while (0)
#define FFN_DOWN(wb) do { pg8::Gemm g{HID, (const bf16*)((wb) + SW_DN), TT, 1024, 4096}; pg8::SplitOrder S; S.init(TP, TS, 1024, G, bx, 4096, 8); \
        pg8::EpiF32 E{RMB, 1024, (float*)RH, TP, TS}; pg8::gemm_phase<pg8::EpiF32, pg8::SplitOrder, true, true>(lds, g, S, E, tid); } while (0)
    unsigned char* lateW = (unsigned char*)out; unsigned char* s5w = lateW + 16 * MiB;
    PH_BEGIN(9) { rowfix_rows<true, 0, 1, true, 4>(vcu, wave, lane, in[I_XP], in[I_XS], xresb, RMB, (const float*)(ws + WS_R2), in[I_NMPOST], nullptr, in[I_NFPRE], RH); }
    PH_END
    SEAM(9);
    PH_BEGIN(10) { FFN_UP(slotw);
        const int nlast = (TT / 256) * 16 - 4 * G;
        if (G == 256 && bx >= nlast) { const int gw2 = (bx - nlast) * NWAVES + wave, NGW2 = (G - nlast) * NWAVES;
            FFN_WEIGHTS(1, lateW, gw2, NGW2);
            transpose_matrix(in[I_S5WIN], 1024, 1024, 1024, (bf16*)(s5w + SW_S5IN), 0, scr, gw2, NGW2, lane);
            transpose_matrix(in[I_S5WOUT], 1024, 2048, 2048, (bf16*)(s5w + SW_S5OUT), 1, scr, gw2, NGW2, lane);
            s5_tables((bx - nlast) * (NWAVES * 64) + tid, (G - nlast) * NWAVES * 64, in, (f32x2*)(s5w + SW_LAM), (bf16*)(s5w + SW_BOP), (bf16*)(s5w + SW_COP)); } }
    PH_END
    SEAM(10);
    PH_BEGIN(11) FFN_DOWN(slotw);
    PH_END
    SEAM(11);
    PH_BEGIN(12) {
        rowfix_rows<true, 1, 1, true, 8>(vcu, wave, lane, nullptr, nullptr, xresb, RMB, (const float*)RH, in[I_NFPOST], nullptr, in[I_NMPRE] + 1024, RH);
    }
    PH_END
    SEAM(12);
    PH_BEGIN(13) { pg8::Gemm g{RH, (const bf16*)(s5w + SW_S5IN), TT, 1024, 1024}; pg8::SplitOrder S; S.init(TP, TS, 1024, G, bx, 1024, 4);
        pg8::EpiBf16S E{UB, 1024, (float*)(ws + WS_R2 + 40 * MiB), TP, TS}; pg8::gemm_phase<pg8::EpiBf16S, pg8::SplitOrder, true, true>(lds, g, S, E, tid); }
    PH_END
    SEAM(13);
    PH_BEGIN(14) { S5Ctx C; C.U = UB; C.YG = RH; C.Bop = (const bf16*)(s5w + SW_BOP); C.Cop = (const bf16*)(s5w + SW_COP); C.Lam = (const f32x2*)(s5w + SW_LAM); C.dskip = in[I_S5D]; C.Us = (const float*)(ws + WS_R2 + 40 * MiB);
        phase_s5<0>(C, in, out, lds, tid, vcu, G); }
    PH_END
    SEAM(14);
    PH_BEGIN(15) { pg8::Gemm g{RH, (const bf16*)(s5w + SW_S5OUT), TT, 2048, 1024}; pg8::StaticOrder S; S.init(TT, 2048, G, bx, 1024);
        pg8::EpiGlu E{RMB, 1024}; pg8::gemm_phase<pg8::EpiGlu, pg8::StaticOrder, true, true>(lds, g, S, E, tid); }
    PH_END
    SEAM(15);
    PH_BEGIN(16) { rowfix_rows<true, 1, 1, true, 0>(vcu, wave, lane, nullptr, nullptr, xresb, RMB, nullptr, in[I_NMPOST] + 1024, nullptr, in[I_NFPRE] + 1024, RH); }
    PH_END
    SEAM(16);
    PH_BEGIN(17) FFN_UP(lateW);
    PH_END
    SEAM(17);
    PH_BEGIN(18) FFN_DOWN(lateW);
    PH_END
    SEAM(18);
    PH_BEGIN(19) rowfix_rows<true, 1, 2, false, 8>(vcu, wave, lane, nullptr, nullptr, xresb, RMB, (const float*)RH, in[I_NFPOST] + 1024, out + O_Y, nullptr, nullptr);
    PH_END
#ifdef PROBE_EXTRA
    if (args.use_bar) { xcd_barrier(bar); int lane = (int)__builtin_amdgcn_mbcnt_hi(~0u, __builtin_amdgcn_mbcnt_lo(~0u, 0u)); int tid = wave * 64 + lane;
#if PROBE_EXTRA == 1
        FFN_UP(slotw);
#elif PROBE_EXTRA == 2
        FFN_DOWN(slotw);
#elif PROBE_EXTRA == 3
        { pg8::Gemm g{RH, (const bf16*)(slotw), TT, NMIX, 1024}; pg8::StaticOrder S; S.init(TT, NMIX, G, bx, 1024); pg8::EpiBf16<0> E{P, NMIX}; pg8::gemm_phase<pg8::EpiBf16<0>, pg8::StaticOrder, true, true>(lds, g, S, E, tid); }
#elif PROBE_EXTRA >= 10 && PROBE_EXTRA < 20
        { ScanCtx C; C.in = in; C.out = (float*)(ws + WS_R2); C.P = P; C.wdec = (float*)(ws + WS_RM); C.abuf = (bf16*)(ws + WS_RH); C.ebuf = (float*)(ws + WS_RM); C.yr = (bf16*)(ws + WS_RH); C.og = (bf16*)(ws + WS_RH); C.sb = bx; C.nsb = G; phase_scan<PROBE_EXTRA - 10>(C, lds, tid); }
#elif PROBE_EXTRA >= 40 && PROBE_EXTRA < 44
        phase_prep<PROBE_EXTRA - 40>(gw, NGW, lane, in, P, (const bf16*)(slotw + SW_LW2), (const bf16*)(slotw + SW_LA2), (const bf16*)(slotw + SW_LG2), (const bf16*)(slotw + SW_LWA2), (float*)(ws + WS_RM), (bf16*)(ws + WS_RM + 36 * MiB), (bf16*)(ws + WS_RH), (float*)(ws + WS_R2 + 100 * MiB));
#elif PROBE_EXTRA == 5
        for (int i_ = 0; i_ < 20; ++i_) xcd_barrier(bar);
#elif PROBE_EXTRA == 6
        phase_post<true, true>(gw, NGW, lane, in, (float*)(ws + WS_R2), P, yr, og, abuf, gbuf, RH);
#elif PROBE_EXTRA == 7
        rowfix_rows<true, 1, 1, true, 0>(vcu, wave, lane, nullptr, nullptr, (bf16*)(ws + WS_R2), RMB, nullptr, in[I_NMPOST], nullptr, in[I_NFPRE], RH);
#elif PROBE_EXTRA == 8
        FFN_WEIGHTS(1, slotw, gw, NGW);
#elif PROBE_EXTRA == 20
        if (bx < 32) phase_seq_ring<true>(bx, wave, lane, lds, gop_ptr(gopA, gopB, bx), GOP_STRIDE, gvt + (size_t)bx * 64 * GVT_STRIDE, GVT_STRIDE, (bf16*)(ws + WS_R2), (float*)(ws + WS_R2 + 64 * MiB));
#elif PROBE_EXTRA == 23 || PROBE_EXTRA == 24
        if (bx < 64) phase_seq_ring<false, PROBE_EXTRA - 22>(bx, wave, lane, lds, rop_ptr(rmap, bx), ROP_STRIDE, rvt_ptr(rmap, bx), RVT_STRIDE, (bf16*)(ws + WS_R2), (float*)(ws + WS_R2 + 64 * MiB));
#elif PROBE_EXTRA == 21
        if (bx < 64) phase_seq_ring<false>(bx, wave, lane, lds, rop_ptr(rmap, bx), ROP_STRIDE, rvt_ptr(rmap, bx), RVT_STRIDE, (bf16*)(ws + WS_R2), (float*)(ws + WS_R2 + 64 * MiB));
#elif PROBE_EXTRA == 30 || PROBE_EXTRA == 31
        { S5Ctx C; C.U = UB; C.YG = (bf16*)(ws + WS_R2 + 64 * MiB); C.Bop = (const bf16*)(s5w + SW_BOP); C.Cop = (const bf16*)(s5w + SW_COP); C.Lam = (const f32x2*)(s5w + SW_LAM); C.dskip = in[I_S5D]; C.Us = (const float*)(ws + WS_R2 + 40 * MiB);
          phase_s5<PROBE_EXTRA == 30 ? 2 : 1>(C, in, (float*)(ws + WS_R2 + 100 * MiB) - O_REP, lds, tid, vcu, G); }
#elif PROBE_EXTRA == 32
        { RopMap dm; dm.a = ws + WS_R2; dm.b = ws + WS_R2 + 60 * MiB; dm.c = ws + WS_R2 + 100 * MiB; phase_pre_rwkv(vcu, G, wave, lane, lds, in, P, (const float*)(ws + WS_RM), (const bf16*)(ws + WS_RM), dm); }
#elif PROBE_EXTRA == 22
        if (bx >= 64) { ScanCtx C; C.in = in; C.out = (float*)(ws + WS_R2); C.P = P; C.wdec = (float*)(ws + WS_RM); C.abuf = (bf16*)(ws + WS_RH); C.ebuf = (float*)(ws + WS_RM); C.yr = (bf16*)(ws + WS_RH); C.og = (bf16*)(ws + WS_RH); C.sb = bx - 64; C.nsb = G - 64; phase_scan<0>(C, lds, tid); }
#elif PROBE_EXTRA == 4
        { pg8::Gemm g{RH, (const bf16*)(slotw), TT, 1024, 1024}; pg8::StaticOrder S; S.init(TT, 1024, G, bx, 1024); pg8::EpiF32 E{RMB, 1024, nullptr, 0, 0}; pg8::gemm_phase<pg8::EpiF32, pg8::StaticOrder, true, true>(lds, g, S, E, tid); }
#endif
    }
#endif
}

extern "C" void kernel_launch(void* const* d_in, const int* in_sizes, int n_in, void* d_out, int out_size, void* d_ws, size_t ws_size, hipStream_t stream) {
    static int grid = 0;
    if (grid == 0) {
        if (n_in != N_IN || out_size != (int)O_END || ws_size < WS_END) { fprintf(stderr, "kernel_launch: unexpected problem shape (n_in %d, out %d, ws %zu); nothing launched\n", n_in, out_size, ws_size); grid = -1; return; }
        int dev = 0, cus = 0, per_cu = 0;
        if (hipGetDevice(&dev) != hipSuccess || hipDeviceGetAttribute(&cus, hipDeviceAttributeMultiprocessorCount, dev) != hipSuccess) { grid = -1; return; }
        if (hipFuncSetAttribute((const void*)mega_fwd, hipFuncAttributeMaxDynamicSharedMemorySize, LDS_BYTES) != hipSuccess) { fprintf(stderr, "kernel_launch: hipFuncSetAttribute failed\n"); grid = -1; return; }
        if (hipOccupancyMaxActiveBlocksPerMultiprocessor(&per_cu, (const void*)mega_fwd, NWAVES * 64, LDS_BYTES) != hipSuccess || per_cu < 1) { fprintf(stderr, "kernel_launch: occupancy query reports %d blocks per CU\n", per_cu); per_cu = 0; }
        (void)hipGetLastError();
        if (cus < 256 || per_cu < 1) { fprintf(stderr, "kernel_launch: needs 256 CUs with one resident workgroup each (cus %d, per_cu %d); nothing launched\n", cus, per_cu); grid = -1; return; }
        grid = 256;
    }
    if (grid < 0) return;
    if (hipMemsetAsync((char*)d_ws + WS_CTL, 0, CTL_ZERO_BYTES, stream) != hipSuccess) return;
    Args a{};
    for (int i = 0; i < N_IN; ++i) a.in[i] = (const float*)d_in[i];
    a.out = (float*)d_out; a.ws = (unsigned char*)d_ws;
#if MK_N_LAUNCHES == 1
    a.ph_lo = 0; a.ph_hi = N_PHASES; a.use_bar = 1;
    { void* kargs[] = {&a}; hipError_t e = hipLaunchCooperativeKernel((const void*)mega_fwd, dim3(grid), dim3(NWAVES * 64), kargs, LDS_BYTES, stream);
      if (e != hipSuccess) fprintf(stderr, "kernel_launch: cooperative launch failed: %s\n", hipGetErrorString(e)); }
#else
    for (int li = 0; li < N_PHASES; ++li) { a.ph_lo = li; a.ph_hi = li + 1; a.use_bar = 0;
        hipLaunchKernelGGL(mega_fwd, dim3(grid), dim3(NWAVES * 64), LDS_BYTES, stream, a); }
#endif
}
```

```cpp
#include <hip/hip_runtime.h>
#include <cstdio>
#include <cstdint>
#define MK_N_LAUNCHES 1
#define PROBE_MASK 0
namespace pg8 {
#define PG8_LAS __attribute__((address_space(3)))
typedef unsigned short bf16_t;
typedef short bf16x8 __attribute__((ext_vector_type(8)));
typedef float f32x4 __attribute__((ext_vector_type(4)));
typedef unsigned u32x4 __attribute__((ext_vector_type(4)));
constexpr int BM = 256, BK = 64, HALF = 128, HTB = HALF * BK * 2  , STAGE_BYTES = 8 * HTB, NXCD = 8, WGM = 4;

__host__ __device__ __forceinline__ int lds_byte(int r, int c) { const int st = (r >> 4) * 2 + (c >> 5), rr = r & 15, cc = c & 31, ob = rr * 64 + cc * 2; return st * 1024 + (ob ^ (((ob >> 9) & 1) << 5)); }
__host__ __device__ __forceinline__ void stage_rc(int b, int& R, int& C) { const int st = b / 1024, sb = b % 1024, swz = sb ^ (((sb >> 9) & 1) << 5); R = (st >> 1) * 16 + swz / 64; C = (st & 1) * 32 + (swz % 64) / 2; }
__host__ __device__ __forceinline__ int perm32(int rho) { const int n = rho >> 4, i = rho & 15; return 8 * (i >> 2) + 4 * n + (i & 3); }

struct Unit { int pm, pn, k0, nt, slab; };
struct Gemm { const bf16_t* A; const bf16_t* Bt; int M, N, K; };

struct StaticOrder {
    int nM, nN, nwg, G, c, ntk;
    __host__ __device__ void init(int M, int N, int G_, int c_, int K_) { nM = M / BM; nN = N / BM; nwg = nM * nN; G = G_; c = c_; ntk = K_ / BK; }
    __host__ __device__ bool next(int i, Unit& u) const {
        const long L = (long)i * G + c; if (L >= nwg) return false;
        int wgid = (int)L; { const int q = nwg / NXCD, r = nwg % NXCD, xcd = wgid % NXCD, off = wgid / NXCD; wgid = (xcd < r ? xcd * (q + 1) : r * (q + 1) + (xcd - r) * q) + off; }
        const int nig = WGM * nN, gid = wgid / nig, fm = gid * WGM, gsz = (nM - fm) < WGM ? (nM - fm) : WGM;
        u.pm = fm + ((wgid % nig) % gsz); u.pn = (wgid % nig) / gsz; u.k0 = 0; u.nt = ntk; u.slab = -1; return true;
    }
    __device__ __forceinline__ void a_ready(const Unit&) const {}
    __device__ __forceinline__ void done(const Unit&) const {}
};
struct SplitOrder {
    StaticOrder P; int nwp, nsl, nts, nNs, nMs, pm0, nsub;
    __host__ __device__ void init(int Mp, int Ms, int N, int G_, int c_, int K_, int nsl_) { P.init(Mp, N, G_, c_, K_); nwp = P.nwg; nsl = nsl_; nts = (K_ / BK) / nsl_; nNs = N / BM; nMs = Ms / BM; pm0 = Mp / BM; nsub = nMs * nNs * nsl_; }
    __host__ __device__ bool next(int i, Unit& u) const {
        const long L = (long)i * P.G + P.c;
        if (L < nwp) return P.next(i, u);
        const int s = (int)(L - nwp); if (s >= nsub) return false;
        const int sl = s % nsl, t = s / nsl;
        u.pm = pm0 + (t % nMs); u.pn = t / nMs; u.k0 = sl * nts * BK; u.nt = nts; u.slab = sl; return true;
    }
    __device__ __forceinline__ void a_ready(const Unit&) const {}
    __device__ __forceinline__ void done(const Unit&) const {}
};

__device__ __forceinline__ unsigned cvt_pk_bf16(float lo, float hi) { unsigned r; asm volatile("v_cvt_pk_bf16_f32 %0, %1, %2" : "=v"(r) : "v"(lo), "v"(hi)); return r; }
typedef float f32x2 __attribute__((ext_vector_type(2)));
template <int ACT> struct EpiBf16 {
    static constexpr bool PERM = true, AFTER_DRAIN = false;
    bf16_t* O; int ldc;
    __device__ __forceinline__ void operator()(const f32x4 (&acc)[2][2][4][2], const Unit& u, int wr, int wc, int fr, int fq) const {
        const int row0 = u.pm * BM + wr * 64 + fr; const int col0 = u.pn * BM + wc * 32 + 8 * fq;
#pragma unroll
        for (int ai = 0; ai < 2; ++ai)
#pragma unroll
            for (int m = 0; m < 4; ++m) { bf16_t* rowp = O + (size_t)(row0 + ai * HALF + m * 16) * ldc + col0;
#pragma unroll
                for (int bj = 0; bj < 2; ++bj) { f32x4 v0 = acc[ai][bj][m][0], v1 = acc[ai][bj][m][1];
                    if (ACT == 3) {
#pragma unroll
                        for (int j = 0; j < 4; ++j) { const float a = fmaxf(v0[j], 0.f), b = fmaxf(v1[j], 0.f); v0[j] = a * a; v1[j] = b * b; } }
                    u32x4 w; w.x = cvt_pk_bf16(v0[0], v0[1]); w.y = cvt_pk_bf16(v0[2], v0[3]); w.z = cvt_pk_bf16(v1[0], v1[1]); w.w = cvt_pk_bf16(v1[2], v1[3]);
                    *(u32x4*)(rowp + bj * HALF) = w; } }
    }
};
struct EpiF32 {
    static constexpr bool PERM = false, AFTER_DRAIN = false;
    bf16_t* C; int ldc; float* S; int slab_row0, slab_rows;
    __device__ __forceinline__ void operator()(const f32x4 (&acc)[2][2][4][2], const Unit& u, int wr, int wc, int fr, int fq) const {
        const int row0 = u.pm * BM + wr * 64 + fr, col0 = u.pn * BM + wc * 32 + 4 * fq;
        if (u.slab >= 0) {
            float* base = S + ((ptrdiff_t)u.slab * slab_rows - slab_row0) * (ptrdiff_t)ldc;
#pragma unroll
            for (int ai = 0; ai < 2; ++ai)
#pragma unroll
                for (int m = 0; m < 4; ++m) { float* rowp = base + (size_t)(row0 + ai * HALF + m * 16) * ldc + col0;
#pragma unroll
                    for (int bj = 0; bj < 2; ++bj)
#pragma unroll
                        for (int n = 0; n < 2; ++n) *(f32x4*)(rowp + bj * HALF + n * 16) = acc[ai][bj][m][n]; }
        } else {
            typedef unsigned u32x2 __attribute__((ext_vector_type(2)));
#pragma unroll
            for (int ai = 0; ai < 2; ++ai)
#pragma unroll
                for (int m = 0; m < 4; ++m) { bf16_t* rowp = C + (size_t)(row0 + ai * HALF + m * 16) * ldc + col0;
#pragma unroll
                    for (int bj = 0; bj < 2; ++bj)
#pragma unroll
                        for (int n = 0; n < 2; ++n) { const f32x4 v = acc[ai][bj][m][n]; u32x2 w; w.x = cvt_pk_bf16(v[0], v[1]); w.y = cvt_pk_bf16(v[2], v[3]); *(u32x2*)(rowp + bj * HALF + n * 16) = w; } }
        }
    }
};

struct EpiBf16S {
    static constexpr bool PERM = true, AFTER_DRAIN = false;
    bf16_t* O; int ldc; float* S; int slab_row0, slab_rows;
    __device__ __forceinline__ void operator()(const f32x4 (&acc)[2][2][4][2], const Unit& u, int wr, int wc, int fr, int fq) const {
        const int row0 = u.pm * BM + wr * 64 + fr; const int col0 = u.pn * BM + wc * 32 + 8 * fq;
        if (u.slab >= 0) {
            float* base = S + ((ptrdiff_t)u.slab * slab_rows - slab_row0) * (ptrdiff_t)ldc;
#pragma unroll
            for (int ai = 0; ai < 2; ++ai)
#pragma unroll
                for (int m = 0; m < 4; ++m) { float* rowp = base + (size_t)(row0 + ai * HALF + m * 16) * ldc + col0;
#pragma unroll
                    for (int bj = 0; bj < 2; ++bj) { *(f32x4*)(rowp + bj * HALF) = acc[ai][bj][m][0]; *(f32x4*)(rowp + bj * HALF + 4) = acc[ai][bj][m][1]; } }
        } else {
#pragma unroll
            for (int ai = 0; ai < 2; ++ai)
#pragma unroll
                for (int m = 0; m < 4; ++m) { bf16_t* rowp = O + (size_t)(row0 + ai * HALF + m * 16) * ldc + col0;
#pragma unroll
                    for (int bj = 0; bj < 2; ++bj) { const f32x4 v0 = acc[ai][bj][m][0], v1 = acc[ai][bj][m][1];
                        u32x4 w; w.x = cvt_pk_bf16(v0[0], v0[1]); w.y = cvt_pk_bf16(v0[2], v0[3]); w.z = cvt_pk_bf16(v1[0], v1[1]); w.w = cvt_pk_bf16(v1[2], v1[3]);
                        *(u32x4*)(rowp + bj * HALF) = w; } }
        }
    }
};
struct EpiGlu {
    static constexpr bool PERM = false, AFTER_DRAIN = false;
    bf16_t* C; int ldc;
    __device__ __forceinline__ void operator()(const f32x4 (&acc)[2][2][4][2], const Unit& u, int wr, int wc, int fr, int fq) const {
        const int row0 = u.pm * BM + wr * 64 + fr, col0 = u.pn * HALF + wc * 32 + 4 * fq;
#pragma unroll
        for (int ai = 0; ai < 2; ++ai)
#pragma unroll
            for (int m = 0; m < 4; ++m) { bf16_t* rowp = C + (size_t)(row0 + ai * HALF + m * 16) * ldc + col0;
#pragma unroll
                for (int n = 0; n < 2; ++n) { const f32x4 v = acc[ai][0][m][n], g = acc[ai][1][m][n]; f32x4 o;
#pragma unroll
                    for (int j = 0; j < 4; ++j) o[j] = v[j] * __builtin_amdgcn_rcpf(1.0f + __expf(-g[j]));
                    typedef unsigned u32x2 __attribute__((ext_vector_type(2))); u32x2 w; w.x = cvt_pk_bf16(o[0], o[1]); w.y = cvt_pk_bf16(o[2], o[3]); *(u32x2*)(rowp + n * 16) = w; } }
    }
};

template <class Epi, class Sched, bool ALIGN_EPI = false, bool SP2 = false>
__device__ __forceinline__ void gemm_phase(PG8_LAS unsigned char* lds, const Gemm g, const Sched& S, const Epi& E, const int tid  ) {
    const int wid = __builtin_amdgcn_readfirstlane(tid >> 6), lane = tid & 63, wr = wid >> 2, wc = wid & 3, fr = lane & 15, fq = lane >> 4;
    const int K = g.K;
    unsigned voffA[2], voffB[2];
#pragma unroll
    for (int i = 0; i < 2; ++i) { int R, C; stage_rc(tid * 16 + i * 8192, R, C); const int Rb = Epi::PERM ? ((R & ~31) + perm32(R & 31)) : R;
        voffA[i] = (unsigned)(R * K + C) * 2u; voffB[i] = (unsigned)(Rb * K + C) * 2u; }
    const size_t kstep = (size_t)(BK * 2);
    const size_t hstep = (size_t)HALF * K * 2;
    const size_t tstep = 2 * hstep;
    const unsigned ldsw = (unsigned)wid * 1024u;
    const int aoff = lds_byte(wr * 64 + fr, fq * 8), boff = lds_byte(wc * 32 + fr, fq * 8);
#define PG8_SA(b, h) (((b) * 2 + (h)) * HTB)
#define PG8_SB(b, h) ((4 + (b) * 2 + (h)) * HTB)
#define PG8_STAGE(bufoff, gbase, voff) do { _Pragma("unroll") for (int _i = 0; _i < 2; ++_i) \
        __builtin_amdgcn_global_load_lds((const unsigned*)((const char*)(gbase) + (voff)[_i]), (PG8_LAS unsigned*)(lds + (bufoff) + ldsw + _i * 8192), 16, 0, 0); } while (0)
#define PG8_LDA(dst, b, h) do { _Pragma("unroll") for (int m = 0; m < 4; ++m) _Pragma("unroll") for (int k = 0; k < 2; ++k) dst[m][k] = *(const PG8_LAS bf16x8*)(lds + PG8_SA(b, h) + aoff + m * 2048 + k * 1024); } while (0)
#define PG8_LDB(dst, b, h) do { _Pragma("unroll") for (int n = 0; n < 2; ++n) _Pragma("unroll") for (int k = 0; k < 2; ++k) dst[n][k] = *(const PG8_LAS bf16x8*)(lds + PG8_SB(b, h) + boff + n * 2048 + k * 1024); } while (0)
#define PG8_MMA(ai, bj, At, Bt) do { __builtin_amdgcn_s_setprio(1); _Pragma("unroll") for (int m = 0; m < 4; ++m) _Pragma("unroll") for (int n = 0; n < 2; ++n) _Pragma("unroll") for (int k = 0; k < 2; ++k) \
        acc[ai][bj][m][n] = __builtin_amdgcn_mfma_f32_16x16x32_bf16(Bt[n][k], At[m][k], acc[ai][bj][m][n], 0, 0, 0); __builtin_amdgcn_s_setprio(0); } while (0)
#define PG8_WAIT_V(n) asm volatile("s_waitcnt vmcnt(" #n ")" ::: "memory")
#define PG8_WAIT_L(n) asm volatile("s_waitcnt lgkmcnt(" #n ")" ::: "memory")
#define PG8_BAR __builtin_amdgcn_s_barrier()
#define PG8_SCHED __builtin_amdgcn_sched_barrier(0)
    Unit cur, nxt; int ui = 0;
    if (!S.next(0, cur)) return;
    int nt = cur.nt;
    f32x4 acc[2][2][4][2];
#pragma unroll
    for (int a = 0; a < 2; ++a)
#pragma unroll
        for (int b = 0; b < 2; ++b)
#pragma unroll
            for (int m = 0; m < 4; ++m)
#pragma unroll
                for (int n = 0; n < 2; ++n) acc[a][b][m][n] = (f32x4){0.f, 0.f, 0.f, 0.f};
    bf16x8 At[4][2], B0[2][2], B1[2][2];
    const char* cA = (const char*)g.A + (size_t)cur.pm * tstep + (size_t)cur.k0 * 2; const char* cB = (const char*)g.Bt + (size_t)cur.pn * tstep + (size_t)cur.k0 * 2;
    S.a_ready(cur);
    if constexpr (SP2) {
        PG8_STAGE(PG8_SB(0, 0), cB, voffB); PG8_STAGE(PG8_SB(0, 1), cB + hstep, voffB); PG8_STAGE(PG8_SA(0, 0), cA, voffA); PG8_STAGE(PG8_SA(0, 1), cA + hstep, voffA);
        if (wr == 1) PG8_BAR;
        PG8_WAIT_V(2); PG8_BAR;
        PG8_STAGE(PG8_SB(1, 0), cB + kstep, voffB); PG8_STAGE(PG8_SA(1, 0), cA + kstep, voffA); PG8_STAGE(PG8_SB(1, 1), cB + hstep + kstep, voffB);
        PG8_WAIT_V(6); PG8_BAR;
    } else {
        PG8_STAGE(PG8_SB(0, 0), cB, voffB); PG8_STAGE(PG8_SA(0, 0), cA, voffA); PG8_STAGE(PG8_SB(0, 1), cB + hstep, voffB); PG8_STAGE(PG8_SA(0, 1), cA + hstep, voffA);
        if (wr == 1) PG8_BAR;
        PG8_WAIT_V(4); PG8_BAR;
        PG8_STAGE(PG8_SB(1, 0), cB + kstep, voffB); PG8_STAGE(PG8_SA(1, 0), cA + kstep, voffA); PG8_STAGE(PG8_SB(1, 1), cB + hstep + kstep, voffB);
        PG8_WAIT_V(6); PG8_BAR;
    }
    for (;;) {
        const bool has_next = S.next(ui + 1, nxt);
        const char* nA = has_next ? (const char*)g.A + (size_t)nxt.pm * tstep + (size_t)nxt.k0 * 2 : cA; const char* nB = has_next ? (const char*)g.Bt + (size_t)nxt.pn * tstep + (size_t)nxt.k0 * 2 : cB;
        for (int t = 0; t < nt; t += 2) {
            const bool last = (t == nt - 2);
            const char* a1 = cA + (size_t)(t + 1) * kstep;
            const char* a2 = last ? nA : cA + (size_t)(t + 2) * kstep; const char* b2 = last ? nB : cB + (size_t)(t + 2) * kstep;
            const char* a3 = a2 + kstep; const char* b3 = b2 + kstep;
            if (last && has_next) S.a_ready(nxt);
            if constexpr (SP2) {
            PG8_LDB(B0, 0, 0); PG8_LDB(B1, 0, 1); PG8_SCHED; PG8_LDA(At, 0, 0); PG8_STAGE(PG8_SA(1, 1), a1 + hstep, voffA);
            PG8_WAIT_V(8); PG8_WAIT_L(0); PG8_BAR; PG8_MMA(0, 0, At, B0); PG8_MMA(0, 1, At, B1); PG8_BAR; PG8_SCHED;
            PG8_LDA(At, 0, 1); PG8_STAGE(PG8_SB(0, 0), b2, voffB); PG8_STAGE(PG8_SB(0, 1), b2 + hstep, voffB); PG8_STAGE(PG8_SA(0, 0), a2, voffA);
            PG8_WAIT_V(8); PG8_WAIT_L(0); PG8_BAR; PG8_MMA(1, 0, At, B0); PG8_MMA(1, 1, At, B1); PG8_BAR; PG8_SCHED;
            PG8_LDB(B0, 1, 0); PG8_LDB(B1, 1, 1); PG8_SCHED; PG8_LDA(At, 1, 0); PG8_STAGE(PG8_SA(0, 1), a2 + hstep, voffA);
            PG8_WAIT_V(8); PG8_WAIT_L(0); PG8_BAR; PG8_MMA(0, 0, At, B0); PG8_MMA(0, 1, At, B1); PG8_BAR; PG8_SCHED;
            PG8_LDA(At, 1, 1); PG8_STAGE(PG8_SB(1, 0), b3, voffB); PG8_STAGE(PG8_SB(1, 1), b3 + hstep, voffB); PG8_STAGE(PG8_SA(1, 0), a3, voffA);
            PG8_WAIT_V(8); PG8_WAIT_L(0); PG8_BAR; PG8_MMA(1, 0, At, B0); PG8_MMA(1, 1, At, B1); PG8_BAR; PG8_SCHED;
            } else {
            PG8_LDB(B0, 0, 0); PG8_SCHED; PG8_LDA(At, 0, 0); PG8_STAGE(PG8_SA(1, 1), a1 + hstep, voffA);
            PG8_WAIT_L(8); PG8_BAR; PG8_WAIT_L(0); PG8_MMA(0, 0, At, B0); PG8_BAR; PG8_SCHED;
            PG8_LDB(B1, 0, 1); PG8_STAGE(PG8_SB(0, 0), b2, voffB);
            PG8_BAR; PG8_WAIT_L(0); PG8_MMA(0, 1, At, B1); PG8_BAR;
            PG8_LDA(At, 0, 1); PG8_STAGE(PG8_SA(0, 0), a2, voffA);
            PG8_BAR; PG8_WAIT_L(0); PG8_MMA(1, 0, At, B0); PG8_BAR; PG8_SCHED;
            PG8_STAGE(PG8_SB(0, 1), b2 + hstep, voffB);
            PG8_WAIT_V(6); PG8_BAR; PG8_MMA(1, 1, At, B1); PG8_BAR;
            PG8_LDB(B0, 1, 0); PG8_SCHED; PG8_LDA(At, 1, 0); PG8_STAGE(PG8_SA(0, 1), a2 + hstep, voffA);
            PG8_WAIT_L(8); PG8_BAR; PG8_WAIT_L(0); PG8_MMA(0, 0, At, B0); PG8_BAR; PG8_SCHED;
            PG8_LDB(B1, 1, 1); PG8_STAGE(PG8_SB(1, 0), b3, voffB);
            PG8_BAR; PG8_WAIT_L(0); PG8_MMA(0, 1, At, B1); PG8_BAR;
            PG8_LDA(At, 1, 1); PG8_STAGE(PG8_SA(1, 0), a3, voffA);
            PG8_BAR; PG8_WAIT_L(0); PG8_MMA(1, 0, At, B0); PG8_BAR; PG8_SCHED;
            PG8_STAGE(PG8_SB(1, 1), b3 + hstep, voffB);
            PG8_WAIT_V(6); PG8_BAR; PG8_MMA(1, 1, At, B1); PG8_BAR;
            }
        }
        if constexpr (ALIGN_EPI) { if (wr == 0) PG8_BAR; }
        if constexpr (!Epi::AFTER_DRAIN) { E(acc, cur, wr, wc, fr, fq); S.done(cur); }
        if (!has_next) break;
#pragma unroll
        for (int a = 0; a < 2; ++a)
#pragma unroll
            for (int b = 0; b < 2; ++b)
#pragma unroll
                for (int m = 0; m < 4; ++m)
#pragma unroll
                    for (int n = 0; n < 2; ++n) acc[a][b][m][n] = (f32x4){0.f, 0.f, 0.f, 0.f};
        cur = nxt; cA = nA; cB = nB; ++ui; nt = cur.nt;
        if constexpr (ALIGN_EPI) { if (wr == 1) PG8_BAR; }
    }
    PG8_WAIT_V(0);
    if constexpr (!ALIGN_EPI) { if (wr == 0) PG8_BAR; }
    PG8_BAR;
    if constexpr (Epi::AFTER_DRAIN) { E.fused(acc, cur, wr, wc, fr, fq, lds, wid, lane); S.done(cur); }
#undef PG8_SA
#undef PG8_SB
#undef PG8_STAGE
#undef PG8_LDA
#undef PG8_LDB
#undef PG8_MMA
#undef PG8_WAIT_V
#undef PG8_WAIT_L
#undef PG8_BAR
#undef PG8_SCHED
}
}

#define GAS __attribute__((address_space(1)))
#define LAS __attribute__((address_space(3)))
typedef unsigned short bf16;
typedef unsigned v4u __attribute__((ext_vector_type(4)));
typedef unsigned v2u __attribute__((ext_vector_type(2)));
typedef float f32x4 __attribute__((ext_vector_type(4)));
typedef float f32x2 __attribute__((ext_vector_type(2)));
typedef float f32x16 __attribute__((ext_vector_type(16)));
typedef short bf16x8 __attribute__((ext_vector_type(8)));
#define LDS_WAIT() asm volatile("s_waitcnt lgkmcnt(0)" ::: "memory")
#define LDS_BARRIER() do { asm volatile("s_waitcnt lgkmcnt(0)" ::: "memory"); __builtin_amdgcn_s_barrier(); asm volatile("" ::: "memory"); } while (0)

constexpr int NWAVES = 8;
constexpr int TP = 16384, TS = 1024, TT = 17408, D = 1024, FF = 4096;
constexpr int NMIX = 3584, NMIX_REAL = 3344, PRW = 1792, GB = 1792;
constexpr int GQ = GB, GK = GB + 256, GV = GB + 512, GXA = GB + 1024, GGZ = GB + 1040;
enum { I_XP = 0, I_XS, I_SSH, I_SWKV, I_SGLA, I_SRE, I_SIM, I_NMPRE, I_NMPOST, I_NFPRE, I_NFPOST, I_WMIXIN, I_WMIXOUT, I_MU, I_W0, I_W2, I_A0, I_A2, I_G2,
       I_KK, I_KA, I_RK, I_GNG, I_GNB, I_WA2, I_BA, I_GNORM, I_S5WIN, I_LAMRE, I_LAMIM, I_LOGDT, I_BRE, I_BIM, I_CRE, I_CIM, I_S5D, I_S5WOUT, I_WUP, I_WDN, N_IN };
constexpr size_t O_Y = 0, O_SHP = 17825792, O_SHS = 17840128, O_WKVP = 18069504, O_WKVS = 18331648, O_GLAP = 22525952, O_GLAS = 22788096,
                 O_REP = 26982400, O_RES = 27015168, O_IMP = 27539456, O_IMS = 27572224, O_END = 28096512;
constexpr size_t KiB = 1024, MiB = 1024 * 1024;
constexpr size_t WS_CTL = 0, CTL_ZERO_BYTES = 64 * KiB;
constexpr size_t WS_SLOTW = 256 * KiB;
constexpr size_t WS_RM = WS_SLOTW + 16 * MiB;
constexpr size_t WS_RH = WS_RM + 68 * MiB;
constexpr size_t WS_R2 = WS_RH + 34 * MiB;
constexpr size_t WS_END = WS_R2 + 136 * MiB;
static_assert(WS_END <= 256 * MiB, "ws map");
constexpr size_t SW_W1T = 0, SW_W2T = 7 * MiB, SW_LW2 = 9 * MiB, SW_LA2 = 9 * MiB + 64 * KiB, SW_LG2 = 9 * MiB + 128 * KiB, SW_LWA2 = 9 * MiB + 256 * KiB;
constexpr size_t SW_UP = 0, SW_DN = 8 * MiB;
constexpr size_t SW_S5IN = 0, SW_S5OUT = 2 * MiB, SW_BOP = 6 * MiB, SW_COP = 6 * MiB + 256 * KiB, SW_LAM = 6 * MiB + 768 * KiB, SW_WOP = 8 * MiB  , SW_GOP = 12 * MiB  , SW_MOP = 16 * MiB  , SW_BF32 = 24 * MiB  ;
constexpr int CW_BAR = 4096;
constexpr int RING_BYTES = 131072, LDSCTL_OFF = RING_BYTES, MISC_OFF = LDSCTL_OFF + 320, LDS_BYTES = 147456;
constexpr int N_PHASES = 20;

typedef __bf16 bf16x2_t __attribute__((ext_vector_type(2)));
__device__ __forceinline__ unsigned pk2h_raw(float lo, float hi) { const f32x2 v = {lo, hi}; const bf16x2_t b = __builtin_convertvector(v, bf16x2_t); return __builtin_bit_cast(unsigned, b); }
__device__ __forceinline__ unsigned pk2h(float lo, float hi) { unsigned r = pk2h_raw(lo, hi); asm("s_nop 1" : "+v"(r)); return r; }
#ifndef FENCE_PREP
#define FENCE_PREP 0
#endif
#ifndef FENCE_OPS
#define FENCE_OPS 0
#endif
#ifndef FENCE_RING
#define FENCE_RING 0
#endif
#define cvt_fence2(a, b) asm("s_nop 1" : "+v"(a), "+v"(b))
#define cvt_fence3(a, b, c) asm("s_nop 1" : "+v"(a), "+v"(b), "+v"(c))
#define cvt_fence4(a, b, c, d) asm("s_nop 1" : "+v"(a), "+v"(b), "+v"(c), "+v"(d))
#define cvt_fence8(w) asm("s_nop 1" : "+v"((w)[0]), "+v"((w)[1]), "+v"((w)[2]), "+v"((w)[3]), "+v"((w)[4]), "+v"((w)[5]), "+v"((w)[6]), "+v"((w)[7]))
__device__ __forceinline__ unsigned f2bf(float f) { unsigned u = __builtin_bit_cast(unsigned, f); return (u + 0x7fffu + ((u >> 16) & 1u)) >> 16; }
__device__ __forceinline__ unsigned pk2(float lo, float hi) { return f2bf(lo) | (f2bf(hi) << 16); }
__device__ __forceinline__ unsigned pk2i(float lo, float hi) { return pk2(lo, hi); }
__device__ __forceinline__ float bflo(unsigned u) { return __builtin_bit_cast(float, u << 16); }
__device__ __forceinline__ float bfhi(unsigned u) { return __builtin_bit_cast(float, u & 0xffff0000u); }
__device__ __forceinline__ f32x4 unpk4(v2u v) { return (f32x4){bflo(v.x), bfhi(v.x), bflo(v.y), bfhi(v.y)}; }
__device__ __forceinline__ float wave_sum(float v) {
#pragma unroll
    for (int o = 1; o < 64; o <<= 1) v += __shfl_xor(v, o);
    return v;
}
__device__ __forceinline__ float ar8(float x) {
    x += __builtin_amdgcn_update_dpp(0.f, x, 0xB1, 0xF, 0xF, true);
    x += __builtin_amdgcn_update_dpp(0.f, x, 0x4E, 0xF, 0xF, true);
    x += __builtin_amdgcn_update_dpp(0.f, x, 0x141, 0xF, 0xF, true);
    return x;
}
__device__ __forceinline__ float ar16(float x) { x = ar8(x); x += __builtin_amdgcn_update_dpp(0.f, x, 0x140, 0xF, 0xF, true); return x; }
__device__ __forceinline__ float dpp_xor1(float x) { return __builtin_amdgcn_update_dpp(0.f, x, 0xB1, 0xF, 0xF, true); }
__device__ __forceinline__ bool tok_first(int tok) { return tok < TP ? (tok & 2047) == 0 : (tok & 7) == 0; }
__device__ __forceinline__ bool tok_last(int tok) { return tok < TP ? (tok & 2047) == 2047 : (tok & 7) == 7; }
__device__ __forceinline__ float frcp(float v) { return __builtin_amdgcn_rcpf(v); }
__device__ __forceinline__ float sigmoidf_(float v) { return frcp(1.0f + __expf(-v)); }

#define XB_TMO      128
#define XB_XCNT(j)  (256  + 64 * (j))
#define XB_XSUB(j)  (1280 + 64 * (j))
#define XB_XGEN(j)  (2304 + 64 * (j))
#define XB_TOP      3328
#define XB_TOPGEN   3392
#define XCD_BAR_WORDS 3456
#define XB_SPIN_CAP (1u << 18)

__device__ __forceinline__ unsigned xb_ld(unsigned* p)              { return __hip_atomic_load(p, __ATOMIC_RELAXED, __HIP_MEMORY_SCOPE_AGENT); }
__device__ __forceinline__ unsigned xb_add(unsigned* p, unsigned v) { return __hip_atomic_fetch_add(p, v, __ATOMIC_RELAXED, __HIP_MEMORY_SCOPE_AGENT); }
__device__ __forceinline__ unsigned xb_xcc_id() { return (unsigned)__builtin_amdgcn_s_getreg((3 << 11) | 20) & 0xFu; }
#define XB_SPIN(cond, bar) do { unsigned _sp = 0; while (cond) { __builtin_amdgcn_s_sleep(1); \
    if ((++_sp & 255u) == 0u) { if (xb_ld(&(bar)[XB_TMO])) break; if (_sp > XB_SPIN_CAP) { atomicAdd(&(bar)[XB_TMO], 1u); break; } } } } while (0)

__device__ __forceinline__ bool xb_thread0(int wave) { return (__builtin_amdgcn_mbcnt_hi(~0u, __builtin_amdgcn_mbcnt_lo(~0u, 0u)) == 0u) && (wave == 0); }
struct XcdBarrier {
    unsigned* bar; unsigned x; int wave;
    volatile LAS unsigned* st;
};

__device__ __forceinline__ XcdBarrier xcd_barrier_post(unsigned* bar, volatile LAS unsigned* st, int wave) {
    XcdBarrier b; b.bar = bar; b.x = xb_xcc_id(); b.st = st; b.wave = wave;
    if (xb_thread0(wave)) (void)xb_add(&bar[XB_XCNT(b.x)], 1u);
    return b;
}
__device__ __forceinline__ void xcd_barrier_complete(unsigned* bar, unsigned x, unsigned& nloc, unsigned& nx) {
    const unsigned G = gridDim.x * gridDim.y * gridDim.z;
    unsigned sum, cnt, mine, sp = 0u;
    for (;;) {
        sum = 0u; cnt = 0u; mine = 0u;
#pragma unroll
        for (unsigned j = 0; j < 16; ++j) { const unsigned c = xb_ld(&bar[XB_XCNT(j)]); sum += c; cnt += (c > 0u) ? 1u : 0u; mine = (j == x) ? c : mine; }
        if (sum == G) break;
        __builtin_amdgcn_s_sleep(1);
        if ((++sp & 255u) == 0u) { if (xb_ld(&bar[XB_TMO])) break; if (sp > XB_SPIN_CAP) { atomicAdd(&bar[XB_TMO], 1u); break; } }
    }
    nloc = mine > 0u ? mine : 1u; nx = cnt > 0u ? cnt : 1u;
}

__device__ __forceinline__ void xcd_barrier(const XcdBarrier& b) {
    asm volatile("s_waitcnt vmcnt(0)" ::: "memory");
    __syncthreads();
    if (xb_thread0(b.wave)) {
        unsigned* bar = b.bar;
        __builtin_amdgcn_s_waitcnt(0);
        unsigned nloc = b.st[0], nx = b.st[1];
        if (nloc == 0u) { xcd_barrier_complete(bar, b.x, nloc, nx); b.st[0] = nloc; b.st[1] = nx; }
        const unsigned old = xb_add(&bar[XB_XSUB(b.x)], 1u);
        const unsigned gen = old / nloc;
        if (old + 1u == (gen + 1u) * nloc) {
            __builtin_amdgcn_fence(__ATOMIC_RELEASE, "agent");
            asm volatile("s_waitcnt vmcnt(0)" ::: "memory");
            const unsigned og = xb_add(&bar[XB_TOP], 1u);
            const unsigned tg = og / nx;
            if (og + 1u == (tg + 1u) * nx) xb_add(&bar[XB_TOPGEN], 1u);
            else XB_SPIN(xb_ld(&bar[XB_TOPGEN]) == tg, bar);
            __builtin_amdgcn_fence(__ATOMIC_ACQUIRE, "agent");
            xb_add(&bar[XB_XGEN(b.x)], 1u);
            asm volatile("s_waitcnt vmcnt(0)" ::: "memory");
        } else {
            XB_SPIN(xb_ld(&bar[XB_XGEN(b.x)]) == gen, bar);
            __builtin_amdgcn_fence(__ATOMIC_ACQUIRE, "agent");
            asm volatile("s_waitcnt vmcnt(0)" ::: "memory");
        }
    }
    __syncthreads();
}

__device__ __forceinline__ void transpose_item(const float* W, int K, int Nsrc, bf16* WT, int mode, LAS float* scr, int item, int nblk, int lane) {
    const int kb = item / nblk, nb = item % nblk, k0 = 64 * kb, n0 = 32 * nb;
    const int kr = lane >> 3, c4 = 4 * (lane & 7); const bool okc = (n0 + c4 < Nsrc);
    f32x4 v[8];
#pragma unroll
    for (int i = 0; i < 8; ++i) v[i] = okc ? *(const f32x4*)(W + (size_t)(k0 + 8 * i + kr) * Nsrc + n0 + c4) : (f32x4){0.f, 0.f, 0.f, 0.f};
#pragma unroll
    for (int i = 0; i < 8; ++i) { LAS float* d = scr + (8 * i + kr) * 33 + c4; d[0] = v[i].x; d[1] = v[i].y; d[2] = v[i].z; d[3] = v[i].w; }
    LDS_WAIT(); asm volatile("" ::: "memory");
    int rb = n0;
    if (mode == 1) { const int c = n0; rb = (c < 1024) ? (256 * (c >> 7) + (c & 127)) : (256 * ((c - 1024) >> 7) + 128 + ((c - 1024) & 127)); }
    const int c8 = lane & 7;
#pragma unroll
    for (int j = 0; j < 4; ++j) { const int n = (lane >> 3) + 8 * j; const LAS float* s = scr + (8 * c8) * 33 + n;
        v4u o; o.x = pk2h_raw(s[0 * 33], s[1 * 33]); o.y = pk2h_raw(s[2 * 33], s[3 * 33]); o.z = pk2h_raw(s[4 * 33], s[5 * 33]); o.w = pk2h_raw(s[6 * 33], s[7 * 33]); cvt_fence4(o.x, o.y, o.z, o.w);
        *(v4u*)(WT + (size_t)(rb + n) * K + k0 + 8 * c8) = o; }
    LDS_WAIT(); asm volatile("" ::: "memory");
}
__device__ __forceinline__ void transpose_matrix(const float* W, int K, int Nsrc, int Ncover, bf16* WT, int mode, LAS float* scr, int gw, int NGW, int lane) {
    const int nblk = Ncover / 32, nitems = (K / 64) * nblk;
    for (int it = gw; it < nitems; it += NGW) transpose_item(W, K, Nsrc, WT, mode, scr, it, nblk, lane);
}

struct RowRaw { f32x4 xf[4]; v2u xh[4]; v2u mh[4]; };
template <bool HAS_M, int XIN>
__device__ __forceinline__ void rowfix_load(RowRaw& R, int row, int lane, const float* xp, const float* xs, const bf16* xb, const bf16* m) {
    if (XIN == 0) { const float* xr = row < TP ? xp + (size_t)row * D : xs + (size_t)(row - TP) * D;
#pragma unroll
        for (int j = 0; j < 4; ++j) R.xf[j] = ((const f32x4*)xr)[lane + 64 * j];
    } else {
#pragma unroll
        for (int j = 0; j < 4; ++j) R.xh[j] = ((const v2u*)(xb + (size_t)row * D))[lane + 64 * j];
    }
    if (HAS_M) {
#pragma unroll
        for (int j = 0; j < 4; ++j) R.mh[j] = ((const v2u*)(m + (size_t)row * D))[lane + 64 * j];
    }
}
template <bool HAS_M, int XIN, int XOUT, bool WRITE_H, int NSLAB>
__device__ __forceinline__ void rowfix_finish(const RowRaw& R, int row, int lane, bf16* xb, const float* slabs, const f32x4 (&gp)[4], float* xout, const f32x4 (&gq)[4], bf16* h) {
    f32x4 v[4];
#pragma unroll
    for (int j = 0; j < 4; ++j) v[j] = (XIN == 0) ? R.xf[j] : unpk4(R.xh[j]);
    if (HAS_M) {
        f32x4 mm[4]; float s = 0.f;
        if (NSLAB > 0) {
#pragma unroll
            for (int j = 0; j < 4; ++j) mm[j] = (f32x4){0.f, 0.f, 0.f, 0.f};
#pragma unroll
            for (int sl = 0; sl < NSLAB; ++sl) {
                const f32x4* sp = (const f32x4*)(slabs + ((size_t)sl * 1024 + (row - TP)) * D);
#pragma unroll
                for (int j = 0; j < 4; ++j) mm[j] = mm[j] + sp[lane + 64 * j];
            }
        } else {
#pragma unroll
            for (int j = 0; j < 4; ++j) mm[j] = unpk4(R.mh[j]);
        }
#pragma unroll
        for (int j = 0; j < 4; ++j) s += (mm[j].x * mm[j].x + mm[j].y * mm[j].y) + (mm[j].z * mm[j].z + mm[j].w * mm[j].w);
        const float rs = rsqrtf(wave_sum(s) * (1.0f / D) + 1e-6f);
#pragma unroll
        for (int j = 0; j < 4; ++j) v[j] = v[j] + (mm[j] * rs) * gp[j];
    }
    if (XOUT == 2) {
#pragma unroll
        for (int j = 0; j < 4; ++j) ((f32x4*)(xout + (size_t)row * D))[lane + 64 * j] = v[j];
    }
    if (XOUT == 1) {
        unsigned long long* x8 = (unsigned long long*)(xb + (size_t)row * D) + lane; unsigned xw[8];
#pragma unroll
        for (int j = 0; j < 4; ++j) { xw[2 * j] = pk2h_raw(v[j].x, v[j].y); xw[2 * j + 1] = pk2h_raw(v[j].z, v[j].w); }
        cvt_fence8(xw);
#pragma unroll
        for (int j = 0; j < 4; ++j) x8[64 * j] = (unsigned long long)xw[2 * j] | ((unsigned long long)xw[2 * j + 1] << 32);
    }
    if (WRITE_H) {
        float s2 = 0.f;
#pragma unroll
        for (int j = 0; j < 4; ++j) s2 += (v[j].x * v[j].x + v[j].y * v[j].y) + (v[j].z * v[j].z + v[j].w * v[j].w);
        const float rs2 = rsqrtf(wave_sum(s2) * (1.0f / D) + 1e-6f);
        unsigned long long* o8 = (unsigned long long*)(h + (size_t)row * D) + lane; unsigned hw[8];
#pragma unroll
        for (int j = 0; j < 4; ++j) { const f32x4 o = (v[j] * rs2) * gq[j]; hw[2 * j] = pk2h_raw(o.x, o.y); hw[2 * j + 1] = pk2h_raw(o.z, o.w); }
        cvt_fence8(hw);
#pragma unroll
        for (int j = 0; j < 4; ++j) o8[64 * j] = (unsigned long long)hw[2 * j] | ((unsigned long long)hw[2 * j + 1] << 32);
    }
}
template <bool HAS_M, int XIN, int XOUT, bool WRITE_H, int NSLAB>
__device__ __forceinline__ void rowfix_rows(int vcu, int wave, int lane, const float* xp, const float* xs, bf16* xb, const bf16* m, const float* slabs, const float* gpost, float* xout, const float* gpre, bf16* h) {
    f32x4 gp[4], gq[4];
#pragma unroll
    for (int j = 0; j < 4; ++j) { gp[j] = HAS_M ? ((const f32x4*)gpost)[lane + 64 * j] : (f32x4){0.f, 0.f, 0.f, 0.f}; gq[j] = WRITE_H ? ((const f32x4*)gpre)[lane + 64 * j] : (f32x4){0.f, 0.f, 0.f, 0.f}; }
    if (wave < 4) { const int row = TP + 4 * vcu + wave; RowRaw R; rowfix_load<HAS_M && NSLAB == 0, XIN>(R, row, lane, xp, xs, xb, m); rowfix_finish<HAS_M, XIN, XOUT, WRITE_H, NSLAB>(R, row, lane, xb, slabs, gp, xout, gq, h); }
    asm volatile("s_waitcnt vmcnt(0)" ::: "memory");
    __syncthreads();
    for (int i = wave; i < 64; i += 2 * NWAVES) { const int ia = i, ib = i + NWAVES;
        const int rowA = NSLAB == 8 ? 2048 * ((ia >> 1) & 7) + 2 * (4 * vcu + (ia >> 4)) + (ia & 1) : 64 * vcu + ia, rowB = NSLAB == 8 ? 2048 * ((ib >> 1) & 7) + 2 * (4 * vcu + (ib >> 4)) + (ib & 1) : 64 * vcu + ib;
        RowRaw RA, RB; rowfix_load<HAS_M, XIN>(RA, rowA, lane, xp, xs, xb, m); rowfix_load<HAS_M, XIN>(RB, rowB, lane, xp, xs, xb, m);
        __builtin_amdgcn_sched_barrier(0);
        rowfix_finish<HAS_M, XIN, XOUT, WRITE_H, 0>(RA, rowA, lane, xb, slabs, gp, xout, gq, h);
        rowfix_finish<HAS_M, XIN, XOUT, WRITE_H, 0>(RB, rowB, lane, xb, slabs, gp, xout, gq, h); }
}

template <int K, int ACT  , bool SHIFT>
__device__ __forceinline__ void prep_afrags(bf16x8 (&A)[K / 16], const bf16* P, int tok, int colbase, const float* mu, const float* shift_state, int kh) {
    constexpr int KS = K / 16, GS = KS < 4 ? KS : 4;
    const bf16* prow = P + (size_t)tok * NMIX + colbase + 8 * kh;
    const bool first = tok_first(tok), sample_tile = tok >= TP;
#pragma unroll
    for (int g0 = 0; g0 < KS; g0 += GS) {
        v4u c[GS], p[GS]; f32x4 m0[GS], m1[GS], s0[GS], s1[GS];
#pragma unroll
        for (int ks = 0; ks < GS; ++ks) c[ks] = *(const v4u*)(prow + 16 * (g0 + ks));
        if (SHIFT) {
            const bf16* pp = first ? prow : prow - NMIX;
#pragma unroll
            for (int ks = 0; ks < GS; ++ks) p[ks] = *(const v4u*)(pp + 16 * (g0 + ks));
#pragma unroll
            for (int ks = 0; ks < GS; ++ks) { const float* mp = mu + colbase + 8 * kh + 16 * (g0 + ks); m0[ks] = *(const f32x4*)mp; m1[ks] = *(const f32x4*)(mp + 4); }
            if (__builtin_amdgcn_readfirstlane((int)sample_tile)) {
                const float* sp = shift_state + (size_t)((tok - TP) >> 3) * PRW + colbase + 8 * kh;
#pragma unroll
                for (int ks = 0; ks < GS; ++ks) { s0[ks] = *(const f32x4*)(sp + 16 * (g0 + ks)); s1[ks] = *(const f32x4*)(sp + 16 * (g0 + ks) + 4); }
            } else {
#pragma unroll
                for (int ks = 0; ks < GS; ++ks) { s0[ks] = (f32x4){0.f, 0.f, 0.f, 0.f}; s1[ks] = (f32x4){0.f, 0.f, 0.f, 0.f}; }
            }
        }
#pragma unroll
        for (int ks = 0; ks < GS; ++ks) {
            float x[8] = {bflo(c[ks].x), bfhi(c[ks].x), bflo(c[ks].y), bfhi(c[ks].y), bflo(c[ks].z), bfhi(c[ks].z), bflo(c[ks].w), bfhi(c[ks].w)};
            if (SHIFT) {
                const float pq[8] = {bflo(p[ks].x), bfhi(p[ks].x), bflo(p[ks].y), bfhi(p[ks].y), bflo(p[ks].z), bfhi(p[ks].z), bflo(p[ks].w), bfhi(p[ks].w)};
                const float sv[8] = {s0[ks].x, s0[ks].y, s0[ks].z, s0[ks].w, s1[ks].x, s1[ks].y, s1[ks].z, s1[ks].w};
                const float mv[8] = {m0[ks].x, m0[ks].y, m0[ks].z, m0[ks].w, m1[ks].x, m1[ks].y, m1[ks].z, m1[ks].w};
#pragma unroll
                for (int j = 0; j < 8; ++j) { const float pv = first ? sv[j] : pq[j]; x[j] = x[j] + (pv - x[j]) * mv[j]; }
            }
#pragma unroll
            for (int j = 0; j < 8; ++j) { if (ACT == 1) x[j] = 1.0f - 2.0f * frcp(1.0f + __expf(2.0f * x[j])); if (ACT == 2) x[j] = sigmoidf_(x[j]); }
            v4u o; o.x = pk2i(x[0], x[1]); o.y = pk2i(x[2], x[3]); o.z = pk2i(x[4], x[5]); o.w = pk2i(x[6], x[7]);
            A[g0 + ks] = __builtin_bit_cast(bf16x8, o);
        }
    }
}
template <int K>
__device__ __forceinline__ void prep_ldb(bf16x8 (&B)[K / 16], const bf16* WT, int n0, int lane) {
    const bf16* brow = WT + (size_t)(n0 + (lane & 31)) * K + 8 * (lane >> 5);
#pragma unroll
    for (int ks = 0; ks < K / 16; ++ks) B[ks] = *(const bf16x8*)(brow + 16 * ks);
}
template <int K>
__device__ __forceinline__ f32x16 prep_mma(const bf16x8 (&A)[K / 16], const bf16x8 (&B)[K / 16]) {
    f32x16 acc;
#pragma unroll
    for (int r = 0; r < 16; ++r) acc[r] = 0.f;
#pragma unroll
    for (int ks = 0; ks < K / 16; ++ks) acc = __builtin_amdgcn_mfma_f32_32x32x16_bf16(A[ks], B[ks], acc, 0, 0, 0);
    return acc;
}
#define PREP_LDSET(KK, WT, BIASP, BS, BB, ntv) do { const int ntl_ = (ntv) < nt1 ? (ntv) : nt1 - 1; BS = (BIASP)[32 * ntl_ + n]; prep_ldb<KK>(BB, WT, 32 * ntl_, lane); } while (0)
#define PREP_NT_LOOP(KK, WT, BIASP, AFRAGS_EARLY, AFRAGS_LATE, EPI) do { bf16x8 B0[(KK) / 16], B1[(KK) / 16], B2[(KK) / 16], B3[(KK) / 16]; float bs0, bs1, bs2, bs3; \
        AFRAGS_EARLY; \
        PREP_LDSET(KK, WT, BIASP, bs0, B0, nt0); PREP_LDSET(KK, WT, BIASP, bs1, B1, nt0 + 1); PREP_LDSET(KK, WT, BIASP, bs2, B2, nt0 + 2); \
        AFRAGS_LATE; \
        for (int nt_ = nt0; nt_ < nt1; nt_ += 4) { \
            PREP_LDSET(KK, WT, BIASP, bs3, B3, nt_ + 3); { const f32x16 acc = prep_mma<KK>(A, B0); const int nt = nt_; const float bias = bs0; EPI } \
            PREP_LDSET(KK, WT, BIASP, bs0, B0, nt_ + 4); { const f32x16 acc = prep_mma<KK>(A, B1); const int nt = nt_ + 1; const float bias = bs1; EPI } \
            PREP_LDSET(KK, WT, BIASP, bs1, B1, nt_ + 5); { const f32x16 acc = prep_mma<KK>(A, B2); const int nt = nt_ + 2; const float bias = bs2; EPI } \
            PREP_LDSET(KK, WT, BIASP, bs2, B2, nt_ + 6); { const f32x16 acc = prep_mma<KK>(A, B3); const int nt = nt_ + 3; const float bias = bs3; EPI } \
        } } while (0)
template <int VAR  , int JSEL = -1, int WPB = NWAVES, int T0 = 0, int NT = TT / 32>
__device__ __forceinline__ void phase_prep(int gw, int NGW, int lane, const float* const* in, const bf16* P, const bf16* w2T, const bf16* a2T, const bf16* g2T, const bf16* wa2T,
                                           float* wdec, bf16* abuf, bf16* gbuf, float* ebuf) {
    constexpr int NU = NT * (JSEL < 0 ? 8 : 4);
    const int nfull = NU / NGW, nrem = NU - nfull * NGW, nwg = NGW / WPB, vcu_ = gw / WPB, wv_ = gw % WPB, nextra = (nrem - vcu_ + nwg - 1) / nwg;
    for (int k = 0; k < nfull + nextra; ++k) {
        int u;
        if (k < nfull) u = gw + k * NGW;
        else { const int e = k - nfull; if (wv_ != ((e + vcu_) & (WPB - 1))) continue; u = nfull * NGW + vcu_ + e * nwg; }
        unsigned z_ = 0u; asm volatile("" : "+v"(z_));
        const int lane_ = (int)__builtin_amdgcn_mbcnt_hi(~0u, __builtin_amdgcn_mbcnt_lo(~0u, z_)); (void)lane;
        const int n = lane_ & 31, hh = lane_ >> 5, kh = hh;
#define lane lane_
        const int tile = T0 + (JSEL < 0 ? (u >> 3) : (u >> 2)), job = JSEL < 0 ? ((u >> 1) & 3) : (2 * JSEL + ((u >> 1) & 1)), hf = u & 1, tok0 = tile * 32, tok = tok0 + (lane & 31);
        const int nt0 = (job == 3) ? 4 * hf : 8 * hf, nt1 = nt0 + ((job == 3) ? 4 : 8);
        if (job == 0) {
            bf16x8 A[4];
            PREP_NT_LOOP(64, w2T, in[I_W0], (void)0, (prep_afrags<64, 1, true>(A, P, tok, 1536, in[I_MU], in[I_SSH], kh)), {
                _Pragma("unroll") for (int r = 0; r < 16; ++r) { const int mm = 8 * (r >> 2) + 4 * hh + (r & 3); const float v = bias + acc[r];
                    const float sg = (VAR & 2) ? v : frcp(1.0f + __expf(-v)); const float wv = (VAR & 2) ? sg * 0.5f : __expf(-0.6065306597126334f * sg); if (!(VAR & 1) || wv == 1234.5f) wdec[(size_t)(tok0 + mm) * 512 + 32 * nt + n] = wv; } });
        } else if (job == 1) {
            bf16x8 A[4];
            PREP_NT_LOOP(64, a2T, in[I_A0], (void)0, (prep_afrags<64, 0, true>(A, P, tok, 1600, in[I_MU], in[I_SSH], kh)), {
                unsigned pkv[8];
                _Pragma("unroll") for (int q = 0; q < 8; ++q) { const float e0 = (VAR & 2) ? bias + acc[2 * q] : sigmoidf_(bias + acc[2 * q]); const float e1 = (VAR & 2) ? bias + acc[2 * q + 1] : sigmoidf_(bias + acc[2 * q + 1]); const bool odd = lane & 1;
                    const float rcv = dpp_xor1(odd ? e0 : e1);
                    pkv[q] = odd ? pk2h_raw(rcv, e1) : pk2h_raw(e0, rcv); }
                if (FENCE_PREP) cvt_fence8(pkv);
                _Pragma("unroll") for (int q = 0; q < 8; ++q) { if (!(VAR & 1) || pkv[q] == 0x12345u) *(unsigned*)(abuf + (size_t)(tok0 + 8 * (q >> 1) + 4 * hh + 2 * (q & 1) + (lane & 1)) * 512 + 32 * nt + (n & ~1)) = pkv[q]; } });
        } else if (job == 2) {
            bf16x8 A[8];
            PREP_NT_LOOP(128, g2T, in[I_A0], (prep_afrags<128, 2, true>(A, P, tok, 1664, in[I_MU], in[I_SSH], kh)), (void)0, { (void)bias;
                unsigned pkv[8];
                _Pragma("unroll") for (int q = 0; q < 8; ++q) { const float e0 = acc[2 * q]; const float e1 = acc[2 * q + 1]; const bool odd = lane & 1;
                    const float rcv = dpp_xor1(odd ? e0 : e1);
                    pkv[q] = odd ? pk2h_raw(rcv, e1) : pk2h_raw(e0, rcv); }
                if (FENCE_PREP) cvt_fence8(pkv);
                _Pragma("unroll") for (int q = 0; q < 8; ++q) { if (!(VAR & 1) || pkv[q] == 0x12345u) *(unsigned*)(gbuf + (size_t)(tok0 + 8 * (q >> 1) + 4 * hh + 2 * (q & 1) + (lane & 1)) * 512 + 32 * nt + (n & ~1)) = pkv[q]; } });
        } else {
            bf16x8 A[1];
            PREP_NT_LOOP(16, wa2T, in[I_BA], (void)0, (prep_afrags<16, 0, false>(A, P, tok, GXA, nullptr, nullptr, kh)), {
                _Pragma("unroll") for (int r = 0; r < 16; ++r) { const int mm = 8 * (r >> 2) + 4 * hh + (r & 3); const float v = bias + acc[r];
                    const float ls = (VAR & 2) ? v : fminf(v, 0.f) - __logf(1.0f + __expf(-fabsf(v))); const float ev = (VAR & 2) ? ls * 0.0625f : __expf(ls * 0.0625f); if (!(VAR & 1) || ev == 1234.5f) ebuf[(size_t)(tok0 + mm) * 256 + 32 * nt + n] = ev; } });
        }
    }
}
#undef lane
#undef PREP_NT_LOOP
#undef PREP_LDSET
constexpr int SS_R = 340, SS_G = 212;
constexpr int LDS_SR = 0, LDS_SG = 2 * 16 * SS_R * 4, LDS_YR = LDS_SG + 2 * 16 * SS_G * 4, LDS_YG = LDS_YR + 2 * 256 * 4, LDS_CT = LDS_YG + 2 * 256 * 4  ,
              LDS_SH = LDS_CT + 5 * 512 * 4  , LDS_SCAN_END = LDS_SH + 24 * 192 * 4;
static_assert(LDS_SCAN_END <= RING_BYTES, "scan LDS");
struct SItem { int tok0, h, r0, kidx; const float* init; float* fin; };
struct ScanCtx { const float* const* in; float* out; const bf16* P; const float* wdec; const bf16* abuf; const float* ebuf; bf16* yr; bf16* og; int sb, nsb; };

template <int TYPE>
__device__ __forceinline__ SItem scan_item(const ScanCtx& C, int i, int half) {
    int k = 2 * i + half, it = C.sb + C.nsb * k;
    if (it >= 4096) { k = 2 * i; it = C.sb + C.nsb * k; }
    SItem d; d.kidx = k; const int b = it >> 5; d.tok0 = TP + 8 * b;
    if (TYPE == 0) { const int h = (it >> 2) & 7; d.h = h; d.r0 = 16 * (it & 3); d.init = C.in[I_SWKV] + (size_t)(b * 8 + h) * 4096; d.fin = C.out + O_WKVS + (size_t)(b * 8 + h) * 4096; }
    else { const int h = (it >> 3) & 3; d.h = h; d.r0 = 16 * (it & 7); d.init = C.in[I_SGLA] + (size_t)(b * 4 + h) * 8192; d.fin = C.out + O_GLAS + (size_t)(b * 4 + h) * 8192; }
    return d;
}
struct LRegR { v2u a0, a1, a2, p0, p1, p2, aa; f32x4 w; };
struct LRegG { v2u a0, a1, a2; f32x4 w; };
__device__ __forceinline__ void ld_issue_r(LRegR& L, const ScanCtx& C, int i, int tg) {
    const int tk = tg >> 4, jq = tg & 15; const SItem d = scan_item<0>(C, i, tk >> 3);
    const int tok = d.tok0 + (tk & 7), col = d.h * 64 + 4 * jq; const bf16* b0 = C.P + (size_t)tok * NMIX + col;
    L.a0 = *(const v2u*)b0; L.a1 = *(const v2u*)(b0 + 512); L.a2 = *(const v2u*)(b0 + 1024);
    L.p0 = *(const v2u*)(b0 - NMIX); L.p1 = *(const v2u*)(b0 - NMIX + 512); L.p2 = *(const v2u*)(b0 - NMIX + 1024);
    L.aa = *(const v2u*)(C.abuf + (size_t)tok * 512 + col);
    L.w = *(const f32x4*)(C.wdec + (size_t)tok * 512 + col);
}
__device__ __forceinline__ void ld_process_r(const LRegR& L, const ScanCtx& C, int i, int tg, LAS float* slots, const LAS float* ct, const LAS float* sh) {
    const int tk = tg >> 4, jq = tg & 15, step = tk & 7; const SItem d = scan_item<0>(C, i, tk >> 3);
    LAS float* slot = slots + (i & 1) * (16 * SS_R);
    const f32x4 r = unpk4(L.a0), kx = unpk4(L.a1), v = unpk4(L.a2);
    const int col = d.h * 64 + 4 * jq;
    f32x4 pr = unpk4(L.p0), pk = unpk4(L.p1), pv = unpk4(L.p2);
    { const LAS float* sp0 = sh + d.kidx * 192 + 4 * jq; const f32x4 s0 = *(const LAS f32x4*)sp0, s1 = *(const LAS f32x4*)(sp0 + 64), s2 = *(const LAS f32x4*)(sp0 + 128);
      if (step == 0) { pr = s0; pk = s1; pv = s2; } }
    const f32x4 mur = *(const LAS f32x4*)(ct + col), muk = *(const LAS f32x4*)(ct + 512 + col), muv = *(const LAS f32x4*)(ct + 1024 + col), kkc = *(const LAS f32x4*)(ct + 1536 + col), kac = *(const LAS f32x4*)(ct + 2048 + col);
    const f32x4 zr = r + (pr - r) * mur, zk = kx + (pk - kx) * muk, zv = v + (pv - v) * muv;
    const f32x4 kkr = zk * kkc;
    const float ss = ar16((kkr.x * kkr.x + kkr.y * kkr.y) + (kkr.z * kkr.z + kkr.w * kkr.w));
    const float inv = rsqrtf(fmaxf(ss, 1e-24f));
    const f32x4 kk = kkr * inv, a = unpk4(L.aa);
    const f32x4 kmod = zk * (1.0f + (a - 1.0f) * kac), bb = kk * a, wr = L.w * zr;
    const f32x4 q1 = kmod * zr, q2 = bb * zr;
    const float c1 = ar16((q1.x + q1.y) + (q1.z + q1.w)), c2 = ar16((q2.x + q2.y) + (q2.z + q2.w));
    LAS float* sp = slot + tk * SS_R + 4 * jq;
    *(LAS f32x4*)(sp) = kk; *(LAS f32x4*)(sp + 64) = L.w; *(LAS f32x4*)(sp + 128) = bb; *(LAS f32x4*)(sp + 192) = kmod; *(LAS f32x4*)(sp + 256) = wr;
    if (4 * jq >= d.r0 && 4 * jq < d.r0 + 16) *(LAS f32x4*)(slot + tk * SS_R + 320 + 4 * jq - d.r0) = zv;
    if (jq == 0) *(LAS f32x2*)(slot + tk * SS_R + 336) = (f32x2){c1, c2};
}
__device__ __forceinline__ void ld_issue_g(LRegG& L, const ScanCtx& C, int i, int tg) {
    const int tk = tg >> 4, jq = tg & 15; const SItem d = scan_item<1>(C, i, tk >> 3);
    const int tok = d.tok0 + (tk & 7); const bf16* prow = C.P + (size_t)tok * NMIX;
    L.a0 = *(const v2u*)(prow + GQ + d.h * 64 + 4 * jq); L.a1 = *(const v2u*)(prow + GK + d.h * 64 + 4 * jq);
    L.a2 = *(const v2u*)(prow + GV + d.h * 128 + d.r0 + 4 * (jq & 3));
    L.w = *(const f32x4*)(C.ebuf + (size_t)tok * 256 + d.h * 64 + 4 * jq);
}
__device__ __forceinline__ void ld_process_g(const LRegG& L, int i, int tg, LAS float* slots) {
    const int tk = tg >> 4, jq = tg & 15;
    LAS float* slot = slots + (i & 1) * (16 * SS_G);
    const f32x4 q = unpk4(L.a0) * 0.125f, kx = unpk4(L.a1), eq = L.w * q, kq = kx * q;
    const float cc = ar16((kq.x + kq.y) + (kq.z + kq.w));
    LAS float* sp = slot + tk * SS_G + 4 * jq;
    *(LAS f32x4*)(sp) = L.w; *(LAS f32x4*)(sp + 64) = kx; *(LAS f32x4*)(sp + 128) = eq;
    if (jq < 4) *(LAS f32x4*)(slot + tk * SS_G + 192 + 4 * jq) = unpk4(L.a2);
    if (jq == 0) slot[tk * SS_G + 208] = cc;
}
template <int TYPE>
__device__ __forceinline__ void flush_y(const ScanCtx& C, int i, int tg, const LAS float* ybuf) {
    const int tk = tg >> 4, row = tg & 15; const SItem d = scan_item<TYPE>(C, i, tk >> 3);
    const int tok = d.tok0 + (tk & 7);
    const float v = ybuf[(i & 1) * 256 + tk * 16 + row];
    if (TYPE == 0) C.yr[(size_t)tok * 512 + d.h * 64 + d.r0 + row] = (bf16)f2bf(v);
    else C.og[(size_t)tok * 512 + d.h * 128 + d.r0 + row] = (bf16)f2bf(v);
}
struct OpR { f32x4 kk, w, bb, kx, wr; float v; f32x2 cc; };
__device__ __forceinline__ OpR ldop_r(const LAS float* slot, int s, int jq, int lr) {
    OpR o; const LAS float* sp = slot + s * SS_R + 4 * jq;
    o.kk = *(const LAS f32x4*)sp; o.w = *(const LAS f32x4*)(sp + 64); o.bb = *(const LAS f32x4*)(sp + 128); o.kx = *(const LAS f32x4*)(sp + 192); o.wr = *(const LAS f32x4*)(sp + 256);
    o.v = slot[s * SS_R + 320 + lr]; o.cc = *(const LAS f32x2*)(slot + s * SS_R + 336); return o;
}
__device__ __forceinline__ float rwkv_step1(f32x4& S, const OpR& o) {
    const f32x4 t = S * o.kk, u = S * o.wr;
    const f32x4 Pp = S * o.w + o.kx * o.v;
    const float d = ar16((t.x + t.y) + (t.z + t.w)), e = ar16((u.x + u.y) + (u.z + u.w));
    S = Pp - o.bb * d;
    return e + o.v * o.cc.x - d * o.cc.y;
}
__device__ __forceinline__ void rwkv_steps2(const LAS float* slot, LAS float* yb, int jq, int lr, f32x4& SA, f32x4& SB) {
    float yk = 0.f;
    OpR ca = ldop_r(slot, 0, jq, lr), cb = ldop_r(slot, 8, jq, lr);
#pragma unroll
    for (int s = 0; s < 8; ++s) {
        OpR na = ca, nb = cb;
        if (s + 1 < 8) na = ldop_r(slot, s + 1, jq, lr);
        __builtin_amdgcn_sched_barrier(0);
        const float ya = rwkv_step1(SA, ca);
        __builtin_amdgcn_sched_barrier(0);
        if (s + 1 < 8) nb = ldop_r(slot, s + 9, jq, lr);
        __builtin_amdgcn_sched_barrier(0);
        const float yb_ = rwkv_step1(SB, cb);
        yk = (jq == s) ? ya : ((jq == s + 8) ? yb_ : yk);
        ca = na; cb = nb;
    }
    yb[jq * 16 + lr] = yk;
}
struct OpG { f32x4 e, kx, eq; float v, cc; };
__device__ __forceinline__ OpG ldop_g(const LAS float* slot, int s, int jq, int lr) {
    OpG o; const LAS float* sp = slot + s * SS_G + 4 * jq;
    o.e = *(const LAS f32x4*)sp; o.kx = *(const LAS f32x4*)(sp + 64); o.eq = *(const LAS f32x4*)(sp + 128);
    o.v = slot[s * SS_G + 192 + lr]; o.cc = slot[s * SS_G + 208]; return o;
}
__device__ __forceinline__ float gla_step1(f32x4& S, const OpG& o) {
    const f32x4 u = S * o.eq;
    S = S * o.e + o.kx * o.v;
    return ar16((u.x + u.y) + (u.z + u.w)) + o.v * o.cc;
}
__device__ __forceinline__ void gla_steps2(const LAS float* slot, LAS float* yb, int jq, int lr, f32x4& SA, f32x4& SB) {
    float yk = 0.f;
    OpG ca = ldop_g(slot, 0, jq, lr), cb = ldop_g(slot, 8, jq, lr);
#pragma unroll
    for (int s = 0; s < 8; ++s) {
        OpG na = ca, nb = cb;
        if (s + 1 < 8) na = ldop_g(slot, s + 1, jq, lr);
        __builtin_amdgcn_sched_barrier(0);
        const float ya = gla_step1(SA, ca);
        __builtin_amdgcn_sched_barrier(0);
        if (s + 1 < 8) nb = ldop_g(slot, s + 9, jq, lr);
        __builtin_amdgcn_sched_barrier(0);
        const float yb_ = gla_step1(SB, cb);
        yk = (jq == s) ? ya : ((jq == s + 8) ? yb_ : yk);
        ca = na; cb = nb;
    }
    yb[jq * 16 + lr] = yk;
}
__device__ __forceinline__ f32x4 gla_state_ld(const float* p) { f32x4 S; S.x = p[0]; S.y = p[128]; S.z = p[256]; S.w = p[384]; return S; }
__device__ __forceinline__ void gla_state_st(float* p, const f32x4& S) { p[0] = S.x; p[128] = S.y; p[256] = S.z; p[384] = S.w; }

template <int VAR>
__device__ __forceinline__ void phase_scan(const ScanCtx& C, LAS unsigned char* lds, int tid) {
    const int wave = __builtin_amdgcn_readfirstlane(tid >> 6), lane = tid & 63;
    const int tg = tid & 255, rp = lane >> 4, jq = lane & 15, lr = 4 * (wave & 3) + rp;
    const int nk = (4096 - C.sb + C.nsb - 1) / C.nsb;
    const int ni = (nk + 1) >> 1;
    LAS float* ct = (LAS float*)(lds + LDS_CT); LAS float* sh = (LAS float*)(lds + LDS_SH);
    for (int i = tid; i < 5 * 512; i += NWAVES * 64) { const int w5 = i >> 9, cc = i & 511; ct[i] = (w5 < 3) ? C.in[I_MU][w5 * 512 + cc] : (w5 == 3 ? C.in[I_KK][cc] : C.in[I_KA][cc]); }
    for (int i = tid; i < nk * 192; i += NWAVES * 64) { const int kk_ = i / 192, rem = i % 192, w3 = rem >> 6, j = rem & 63; const int it = C.sb + C.nsb * kk_, b = it >> 5, h = (it >> 2) & 7;
        sh[i] = C.in[I_SSH][(size_t)b * PRW + w3 * 512 + h * 64 + j]; }
    __syncthreads();
    if (wave < 4) {
        LAS float* slots = (LAS float*)(lds + LDS_SR); LAS float* ybuf = (LAS float*)(lds + LDS_YR);
        LRegR L0, L1; f32x4 SA, SB;
        ld_issue_r(L0, C, 0, tg); ld_issue_r(L1, C, ni > 1 ? 1 : 0, tg);
        { const SItem dA = scan_item<0>(C, 0, 0), dB = scan_item<0>(C, 0, 1); SA = *(const f32x4*)(dA.init + (size_t)(dA.r0 + lr) * 64 + 4 * jq); SB = *(const f32x4*)(dB.init + (size_t)(dB.r0 + lr) * 64 + 4 * jq); }
        ld_process_r(L0, C, 0, tg, slots, ct, sh);
        LDS_BARRIER();
#define SCAN_BODY_R(i_, LI, LP) do { const int i = (i_), inx = i + 1 < ni ? i + 1 : ni - 1, iis = i + 2 < ni ? i + 2 : ni - 1; \
            const SItem nA = scan_item<0>(C, inx, 0), nB = scan_item<0>(C, inx, 1); \
            const f32x4 NA = *(const f32x4*)(nA.init + (size_t)(nA.r0 + lr) * 64 + 4 * jq), NB = *(const f32x4*)(nB.init + (size_t)(nB.r0 + lr) * 64 + 4 * jq); \
            ld_issue_r(LI, C, iis, tg); \
            if (i > 0) flush_y<0>(C, i - 1, tg, ybuf); \
            rwkv_steps2(slots + (i & 1) * (16 * SS_R), ybuf + (i & 1) * 256, jq, lr, SA, SB); \
            { const SItem dA = scan_item<0>(C, i, 0), dB = scan_item<0>(C, i, 1); *(f32x4*)(dA.fin + (size_t)(dA.r0 + lr) * 64 + 4 * jq) = SA; *(f32x4*)(dB.fin + (size_t)(dB.r0 + lr) * 64 + 4 * jq) = SB; } \
            SA = NA; SB = NB; \
            if (i + 1 < ni) ld_process_r(LP, C, i + 1, tg, slots, ct, sh); \
            LDS_BARRIER(); } while (0)
        for (int i2 = 0; i2 < ni; i2 += 2) { SCAN_BODY_R(i2, L0, L1); if (i2 + 1 < ni) SCAN_BODY_R(i2 + 1, L1, L0); }
#undef SCAN_BODY_R
        flush_y<0>(C, ni - 1, tg, ybuf);
    } else {
        LAS float* slots = (LAS float*)(lds + LDS_SG); LAS float* ybuf = (LAS float*)(lds + LDS_YG);
        LRegG L0, L1; f32x4 SA, SB;
        ld_issue_g(L0, C, 0, tg); ld_issue_g(L1, C, ni > 1 ? 1 : 0, tg);
        { const SItem dA = scan_item<1>(C, 0, 0), dB = scan_item<1>(C, 0, 1); SA = gla_state_ld(dA.init + (size_t)(4 * jq) * 128 + dA.r0 + lr); SB = gla_state_ld(dB.init + (size_t)(4 * jq) * 128 + dB.r0 + lr); }
        ld_process_g(L0, 0, tg, slots);
        LDS_BARRIER();
#define SCAN_BODY_G(i_, LI, LP) do { const int i = (i_), inx = i + 1 < ni ? i + 1 : ni - 1, iis = i + 2 < ni ? i + 2 : ni - 1; \
            const SItem nA = scan_item<1>(C, inx, 0), nB = scan_item<1>(C, inx, 1); \
            const f32x4 NA = gla_state_ld(nA.init + (size_t)(4 * jq) * 128 + nA.r0 + lr), NB = gla_state_ld(nB.init + (size_t)(4 * jq) * 128 + nB.r0 + lr); \
            ld_issue_g(LI, C, iis, tg); \
            if (i > 0) flush_y<1>(C, i - 1, tg, ybuf); \
            gla_steps2(slots + (i & 1) * (16 * SS_G), ybuf + (i & 1) * 256, jq, lr, SA, SB); \
            { const SItem dA = scan_item<1>(C, i, 0), dB = scan_item<1>(C, i, 1); gla_state_st(dA.fin + (size_t)(4 * jq) * 128 + dA.r0 + lr, SA); gla_state_st(dB.fin + (size_t)(4 * jq) * 128 + dB.r0 + lr, SB); } \
            SA = NA; SB = NB; \
            if (i + 1 < ni) ld_process_g(LP, i + 1, tg, slots); \
            LDS_BARRIER(); } while (0)
        for (int i2 = 0; i2 < ni; i2 += 2) { SCAN_BODY_G(i2, L0, L1); if (i2 + 1 < ni) SCAN_BODY_G(i2 + 1, L1, L0); }
#undef SCAN_BODY_G
        flush_y<1>(C, ni - 1, tg, ybuf);
    }
    __syncthreads();
}

template <bool DO_R, bool DO_G>
__device__ __forceinline__ void phase_post(int gw, int NGW, int lane, const float* const* in, float* out, const bf16* P, const bf16* yr, const bf16* og, const bf16* abuf, const bf16* gbuf, bf16* A2) {
    const int c0 = 8 * lane;
    float mur[8], muk[8], muv[8], ka[8], rk[8], gng[8], gnb[8], gnorm[8];
#pragma unroll
    for (int j = 0; j < 8; ++j) { mur[j] = in[I_MU][c0 + j]; muk[j] = in[I_MU][512 + c0 + j]; muv[j] = in[I_MU][1024 + c0 + j]; ka[j] = in[I_KA][c0 + j]; rk[j] = in[I_RK][c0 + j];
        gng[j] = in[I_GNG][c0 + j]; gnb[j] = in[I_GNB][c0 + j]; gnorm[j] = in[I_GNORM][(c0 + j) & 127]; }
    for (int tok = gw; tok < TT; tok += NGW) {
        const bf16* prow = P + (size_t)tok * NMIX;
        const bool first = tok_first(tok);
        if (DO_R) {
        float r[8], kx[8], v[8], pr[8], pk[8], pv[8];
        { const v4u a = *(const v4u*)(prow + c0), b = *(const v4u*)(prow + 512 + c0), c = *(const v4u*)(prow + 1024 + c0);
          r[0] = bflo(a.x); r[1] = bfhi(a.x); r[2] = bflo(a.y); r[3] = bfhi(a.y); r[4] = bflo(a.z); r[5] = bfhi(a.z); r[6] = bflo(a.w); r[7] = bfhi(a.w);
          kx[0] = bflo(b.x); kx[1] = bfhi(b.x); kx[2] = bflo(b.y); kx[3] = bfhi(b.y); kx[4] = bflo(b.z); kx[5] = bfhi(b.z); kx[6] = bflo(b.w); kx[7] = bfhi(b.w);
          v[0] = bflo(c.x); v[1] = bfhi(c.x); v[2] = bflo(c.y); v[3] = bfhi(c.y); v[4] = bflo(c.z); v[5] = bfhi(c.z); v[6] = bflo(c.w); v[7] = bfhi(c.w); }
        if (!first) { const v4u a = *(const v4u*)(prow - NMIX + c0), b = *(const v4u*)(prow - NMIX + 512 + c0), c = *(const v4u*)(prow - NMIX + 1024 + c0);
          pr[0] = bflo(a.x); pr[1] = bfhi(a.x); pr[2] = bflo(a.y); pr[3] = bfhi(a.y); pr[4] = bflo(a.z); pr[5] = bfhi(a.z); pr[6] = bflo(a.w); pr[7] = bfhi(a.w);
          pk[0] = bflo(b.x); pk[1] = bfhi(b.x); pk[2] = bflo(b.y); pk[3] = bfhi(b.y); pk[4] = bflo(b.z); pk[5] = bfhi(b.z); pk[6] = bflo(b.w); pk[7] = bfhi(b.w);
          pv[0] = bflo(c.x); pv[1] = bfhi(c.x); pv[2] = bflo(c.y); pv[3] = bfhi(c.y); pv[4] = bflo(c.z); pv[5] = bfhi(c.z); pv[6] = bflo(c.w); pv[7] = bfhi(c.w); }
        else if (tok >= TP) { const float* s = in[I_SSH] + (size_t)((tok - TP) >> 3) * PRW + c0;
#pragma unroll
          for (int j = 0; j < 8; ++j) { pr[j] = s[j]; pk[j] = s[512 + j]; pv[j] = s[1024 + j]; } }
        else {
#pragma unroll
          for (int j = 0; j < 8; ++j) { pr[j] = 0.f; pk[j] = 0.f; pv[j] = 0.f; } }
        const v4u av = *(const v4u*)(abuf + (size_t)tok * 512 + c0), gv = *(const v4u*)(gbuf + (size_t)tok * 512 + c0);
        const float a8[8] = {bflo(av.x), bfhi(av.x), bflo(av.y), bfhi(av.y), bflo(av.z), bfhi(av.z), bflo(av.w), bfhi(av.w)};
        const float g8[8] = {bflo(gv.x), bfhi(gv.x), bflo(gv.y), bfhi(gv.y), bflo(gv.z), bfhi(gv.z), bflo(gv.w), bfhi(gv.w)};
        const v4u yv = *(const v4u*)(yr + (size_t)tok * 512 + c0);
        const float y8[8] = {bflo(yv.x), bfhi(yv.x), bflo(yv.y), bfhi(yv.y), bflo(yv.z), bfhi(yv.z), bflo(yv.w), bfhi(yv.w)};
        float dot = 0.f, sy = 0.f;
#pragma unroll
        for (int j = 0; j < 8; ++j) { r[j] = r[j] + (pr[j] - r[j]) * mur[j]; kx[j] = kx[j] + (pk[j] - kx[j]) * muk[j]; v[j] = v[j] + (pv[j] - v[j]) * muv[j];
            const float km = kx[j] * (1.0f + (a8[j] - 1.0f) * ka[j]); dot += r[j] * km * rk[j]; sy += y8[j]; }
        dot = ar8(dot); const float mean = ar8(sy) * (1.0f / 64.0f);
        float sv = 0.f;
#pragma unroll
        for (int j = 0; j < 8; ++j) { const float dd = y8[j] - mean; sv += dd * dd; }
        const float rstd = rsqrtf(ar8(sv) * (1.0f / 64.0f) + 64e-5f);
        float o[8];
#pragma unroll
        for (int j = 0; j < 8; ++j) o[j] = ((y8[j] - mean) * rstd * gng[j] + gnb[j] + dot * v[j]) * g8[j];
        { v4u w; w.x = pk2h_raw(o[0], o[1]); w.y = pk2h_raw(o[2], o[3]); w.z = pk2h_raw(o[4], o[5]); w.w = pk2h_raw(o[6], o[7]); cvt_fence4(w.x, w.y, w.z, w.w); *(v4u*)(A2 + (size_t)tok * D + c0) = w; }
        }
        if (DO_G) {
        const v4u ov = *(const v4u*)(og + (size_t)tok * 512 + c0);
        const float o8[8] = {bflo(ov.x), bfhi(ov.x), bflo(ov.y), bfhi(ov.y), bflo(ov.z), bfhi(ov.z), bflo(ov.w), bfhi(ov.w)};
        float so = 0.f;
#pragma unroll
        for (int j = 0; j < 8; ++j) so += o8[j] * o8[j];
        const float rs = rsqrtf(ar16(so) * (1.0f / 128.0f) + 1e-6f);
        const v4u zv = *(const v4u*)(prow + GGZ + c0);
        const float z8[8] = {bflo(zv.x), bfhi(zv.x), bflo(zv.y), bfhi(zv.y), bflo(zv.z), bfhi(zv.z), bflo(zv.w), bfhi(zv.w)};
        float o[8];
#pragma unroll
        for (int j = 0; j < 8; ++j) o[j] = o8[j] * rs * gnorm[j] * (z8[j] * sigmoidf_(z8[j]));
        { v4u w; w.x = pk2h_raw(o[0], o[1]); w.y = pk2h_raw(o[2], o[3]); w.z = pk2h_raw(o[4], o[5]); w.w = pk2h_raw(o[6], o[7]); cvt_fence4(w.x, w.y, w.z, w.w); *(v4u*)(A2 + (size_t)tok * D + 512 + c0) = w; }
        }
        if (DO_R && tok_last(tok)) { const int seq = tok < TP ? (tok >> 11) : 8 + ((tok - TP) >> 3);
            float* dst = (seq < 8) ? out + O_SHP + (size_t)seq * PRW : out + O_SHS + (size_t)(seq - 8) * PRW;
            for (int cc = lane; cc < PRW; cc += 64) dst[cc] = __builtin_bit_cast(float, ((unsigned)prow[cc]) << 16); }
    }
}


__device__ __forceinline__ void sincos_d(double x, double& s, double& c) {
    const double TWO_PI = 6.283185307179586476925;
    const double kq = rint(x / TWO_PI); const double r = x - kq * TWO_PI;
    const double t = r * 0.125, t2 = t * t;
    double sn = t * (1.0 + t2 * (-1.0 / 6 + t2 * (1.0 / 120 + t2 * (-1.0 / 5040 + t2 * (1.0 / 362880 + t2 * (-1.0 / 39916800 + t2 * (1.0 / 6227020800.0)))))));
    double cs = 1.0 + t2 * (-0.5 + t2 * (1.0 / 24 + t2 * (-1.0 / 720 + t2 * (1.0 / 40320 + t2 * (-1.0 / 3628800 + t2 * (1.0 / 479001600.0 + t2 * (-1.0 / 87178291200.0)))))));
#pragma unroll
    for (int i = 0; i < 3; ++i) { const double s2 = 2.0 * sn * cs, c2 = cs * cs - sn * sn; sn = s2; cs = c2; }
    s = sn; c = cs;
}
__device__ __forceinline__ void s5_disc(float lr, float li, float dt, f32x2& Lb, f32x2& f) {
    const float x = lr * dt, y = li * dt, em1 = expm1f(x), mag = em1 + 1.0f, sh = __sinf(0.5f * y), cm1 = -2.0f * sh * sh, sn = __sinf(y), cs = cm1 + 1.0f;
    Lb = (f32x2){mag * cs, mag * sn};
    const float ar = em1 * cs + cm1, ai = mag * sn, den = __builtin_amdgcn_rcpf(lr * lr + li * li);
    f = (f32x2){(ar * lr + ai * li) * den, (ai * lr - ar * li) * den};
}
__device__ __forceinline__ void s5_wop(int gtid, int gthreads, const float* const* in, bf16* Wop) {
    for (int i3 = gtid; i3 < 64 * 64 * 16; i3 += gthreads) {
        const int p = i3 & 63, tau = (i3 >> 6) & 15, g = i3 >> 10, idx = g * 64 + p; const float kpow = (float)(15 - tau), dt = __expf(in[I_LOGDT][g]);
        f32x2 Lb, ff; s5_disc(in[I_LAMRE][idx], in[I_LAMIM][idx], dt, Lb, ff);
        const float magk = __expf(in[I_LAMRE][idx] * dt * kpow), angk = in[I_LAMIM][idx] * dt * kpow, pr = magk * __cosf(angk), pi = magk * __sinf(angk);
        const float gr = pr * ff.x - pi * ff.y, gi = pr * ff.y + pi * ff.x;
        const f32x4* bre = (const f32x4*)(in[I_BRE] + (size_t)idx * 16); const f32x4* bim = (const f32x4*)(in[I_BIM] + (size_t)idx * 16);
        unsigned wr_[8], wi_[8];
#pragma unroll
        for (int c4 = 0; c4 < 4; ++c4) { const f32x4 br = bre[c4], bi = bim[c4];
            wr_[2 * c4] = f2bf(gr * br.x - gi * bi.x) | (f2bf(gr * br.y - gi * bi.y) << 16); wr_[2 * c4 + 1] = f2bf(gr * br.z - gi * bi.z) | (f2bf(gr * br.w - gi * bi.w) << 16);
            wi_[2 * c4] = f2bf(gr * bi.x + gi * br.x) | (f2bf(gr * bi.y + gi * br.y) << 16); wi_[2 * c4 + 1] = f2bf(gr * bi.z + gi * br.z) | (f2bf(gr * bi.w + gi * br.w) << 16); }
        v4u* wre = (v4u*)(Wop + (((size_t)g * 16 + tau) * 128 + p) * 16); v4u* wim = wre + 64 * 2;
        wre[0] = (v4u){wr_[0], wr_[1], wr_[2], wr_[3]}; wre[1] = (v4u){wr_[4], wr_[5], wr_[6], wr_[7]};
        wim[0] = (v4u){wi_[0], wi_[1], wi_[2], wi_[3]}; wim[1] = (v4u){wi_[4], wi_[5], wi_[6], wi_[7]};
    }
}
__device__ __forceinline__ void s5_gop(int gtid, int gthreads, const float* const* in, bf16* Gop) {
    for (int i4 = gtid; i4 < 64 * 16 * 8 * 16; i4 += gthreads) {
        const int ch = i4 & 15, ks = (i4 >> 4) & 7, tau = (i4 >> 7) & 15, g = i4 >> 11; const float k2 = (float)(tau + 1) * __expf(in[I_LOGDT][g]);
        unsigned w[8]; f32x4 crv[2], civ[2], lrv[2], liv[2];
#pragma unroll
        for (int q = 0; q < 2; ++q) { crv[q] = *(const f32x4*)(in[I_CRE] + ((size_t)g * 16 + ch) * 64 + 4 * ks + 32 * q); civ[q] = *(const f32x4*)(in[I_CIM] + ((size_t)g * 16 + ch) * 64 + 4 * ks + 32 * q);
            lrv[q] = *(const f32x4*)(in[I_LAMRE] + g * 64 + 4 * ks + 32 * q); liv[q] = *(const f32x4*)(in[I_LAMIM] + g * 64 + 4 * ks + 32 * q); }
#pragma unroll
        for (int nn = 0; nn < 4; ++nn) { float v4[4];
#pragma unroll
            for (int q = 0; q < 2; ++q) {
                const float mg = __expf(lrv[q][nn] * k2), ang = liv[q][nn] * k2, Lr = mg * __cosf(ang), Li = mg * __sinf(ang);
                const float cr = crv[q][nn], ci = civ[q][nn];
                v4[q] = cr * Lr - ci * Li; v4[2 + q] = -(cr * Li + ci * Lr); }
            w[2 * nn] = f2bf(v4[0]) | (f2bf(v4[1]) << 16); w[2 * nn + 1] = f2bf(v4[2]) | (f2bf(v4[3]) << 16); }
        v4u* dst = (v4u*)(Gop + (((size_t)g * 8 + ks) * 256 + tau * 16 + ch) * 16);
        dst[0] = (v4u){w[0], w[1], w[2], w[3]}; dst[1] = (v4u){w[4], w[5], w[6], w[7]};
    }
}
__device__ __forceinline__ void s5_tables(int gtid, int gthreads, const float* const* in, f32x2* Lam, bf16* Bop, bf16* Cop) {
    for (int idx = gtid; idx < 64 * 64; idx += gthreads) {
        const int g = idx >> 6, p = idx & 63;
        const double lr = (double)in[I_LAMRE][idx], li = (double)in[I_LAMIM][idx], dt = exp((double)in[I_LOGDT][g]);
        const double mag = exp(lr * dt); double sn, cs; sincos_d(li * dt, sn, cs);
        const double abr = mag * cs, abi = mag * sn, den = lr * lr + li * li;
        const double fr = ((abr - 1.0) * lr + abi * li) / den, fi = (abi * lr - (abr - 1.0) * li) / den;
        Lam[idx] = (f32x2){(float)abr, (float)abi};
        const float* bre = in[I_BRE] + (size_t)idx * 16; const float* bim = in[I_BIM] + (size_t)idx * 16;
#pragma unroll 4
        for (int c = 0; c < 16; ++c) { const double br = bre[c], bi = bim[c];
            Bop[((size_t)g * 128 + p) * 16 + c] = (bf16)f2bf((float)(fr * br - fi * bi)); Bop[((size_t)g * 128 + 64 + p) * 16 + c] = (bf16)f2bf((float)(fr * bi + fi * br)); }
        const int n = p & 31, q = p >> 5;
        for (int ch = 0; ch < 16; ++ch) { const float cr = in[I_CRE][((size_t)g * 16 + ch) * 64 + p], ci = in[I_CIM][((size_t)g * 16 + ch) * 64 + p];
            Cop[((size_t)g * 32 + ch) * 128 + 4 * n + q] = (bf16)f2bf(cr); Cop[((size_t)g * 32 + ch) * 128 + 4 * n + 2 + q] = (bf16)f2bf(-ci);
            Cop[((size_t)g * 32 + 16 + ch) * 128 + 4 * n + q] = 0; Cop[((size_t)g * 32 + 16 + ch) * 128 + 4 * n + 2 + q] = 0; }
    }
}
__device__ __forceinline__ void s5_mop(int gtid, int gthreads, const float* const* in, bf16* Mop) {
    for (int t8 = gtid; t8 < 64 * 16 * 16 * 8; t8 += gthreads) {
        const int it = t8 >> 3, pl = t8 & 7, g = it >> 8, ch = (it >> 4) & 15, cp = it & 15;
        float k[16];
#pragma unroll
        for (int d = 0; d < 16; ++d) k[d] = 0.f;
        f32x4 crv[2], civ[2]; f32x2 bbv[8], lmv[8]; const float dtg = __expf(in[I_LOGDT][g]);
#pragma unroll
        for (int h2 = 0; h2 < 2; ++h2) { crv[h2] = *(const f32x4*)(in[I_CRE] + ((size_t)g * 16 + ch) * 64 + 8 * pl + 4 * h2); civ[h2] = *(const f32x4*)(in[I_CIM] + ((size_t)g * 16 + ch) * 64 + 8 * pl + 4 * h2); }
#pragma unroll
        for (int pi = 0; pi < 8; ++pi) { const int idx = g * 64 + 8 * pl + pi; f32x2 ff; s5_disc(in[I_LAMRE][idx], in[I_LAMIM][idx], dtg, lmv[pi], ff);
            const float br = in[I_BRE][(size_t)idx * 16 + cp], bi = in[I_BIM][(size_t)idx * 16 + cp]; bbv[pi] = (f32x2){ff.x * br - ff.y * bi, ff.x * bi + ff.y * br}; }
#pragma unroll
        for (int pi = 0; pi < 8; ++pi) {
            const float cr = crv[pi >> 2][pi & 3], ci = civ[pi >> 2][pi & 3];
            const f32x2 bb = bbv[pi], lam = lmv[pi];
            float wr = cr * bb.x - ci * bb.y, wi = cr * bb.y + ci * bb.x;
#pragma unroll
            for (int d = 0; d < 16; ++d) { k[d] += wr; const float nr = wr * lam.x - wi * lam.y, ni = wr * lam.y + wi * lam.x; wr = nr; wi = ni; }
        }
#pragma unroll
        for (int d = 0; d < 16; ++d) k[d] = ar8(k[d]);
        if (ch == cp) k[0] += in[I_S5D][g * 16 + ch];
#pragma unroll
        for (int d = 0; d < 16; ++d) if ((d >> 1) == pl) Mop[(((size_t)g * 16 + d) * 16 + ch) * 16 + cp] = (bf16)f2bf(k[d]);
    }
}
__device__ __forceinline__ float sfma(float a, float b, float c) { float d; asm("v_fma_f32 %0, %1, %2, %3" : "=v"(d) : "v"(a), "v"(b), "v"(c)); return d; }
__device__ __forceinline__ float gelu_tanh(float x) { return x * __builtin_amdgcn_rcpf(1.0f + __expf(-1.5957691216057308f * (x + 0.044715f * x * x * x))); }
constexpr int XS_PITCH = 272;
struct S5Ctx { const bf16* U; bf16* YG; const bf16* Bop; const bf16* Cop; const f32x2* Lam; const float* dskip; const float* Us; const bf16* Wop; const bf16* Gop; const bf16* Mop; };
struct S5In { v4u au; v2u u0, u1; };
template <bool FULLOUT>
__device__ __forceinline__ S5In s5_fetch(const S5Ctx& C, int g, int tokA, int tokB, int nvalid, int lane) {
    const int m = lane & 31, kh = lane >> 5, tau = 4 * (m >> 3) + (m & 3), bsel = (m >> 2) & 1;
    const int tokrow = (bsel ? tokB : tokA) + tau;
    S5In I; I.au = (v4u){0u, 0u, 0u, 0u}; I.u0 = I.u1 = (v2u){0u, 0u};
    if (tau < nvalid) {
        if (tokrow >= TP) {
            const float* sp = C.Us + (size_t)(tokrow - TP) * D + g * 16; f32x4 s4[4];
#pragma unroll
            for (int q = 0; q < 4; ++q) s4[q] = *(const f32x4*)(sp + 4 * q);
#pragma unroll
            for (int sl = 1; sl < 4; ++sl) {
#pragma unroll
                for (int q = 0; q < 4; ++q) s4[q] = s4[q] + *(const f32x4*)(sp + (size_t)sl * 1024 * D + 4 * q); }
            unsigned w[8];
#pragma unroll
            for (int q = 0; q < 4; ++q) { w[2 * q] = pk2(s4[q].x, s4[q].y); w[2 * q + 1] = pk2(s4[q].z, s4[q].w); }
            I.au = kh ? (v4u){w[4], w[5], w[6], w[7]} : (v4u){w[0], w[1], w[2], w[3]};
            if (FULLOUT) { I.u0 = kh ? (v2u){w[2], w[3]} : (v2u){w[0], w[1]}; I.u1 = kh ? (v2u){w[6], w[7]} : (v2u){w[4], w[5]}; }
        } else { const bf16* up = C.U + (size_t)tokrow * D + g * 16; I.au = *(const v4u*)(up + 8 * kh); if (FULLOUT) { I.u0 = *(const v2u*)(up + 4 * kh); I.u1 = *(const v2u*)(up + 8 + 4 * kh); } }
    }
    return I;
}
template <bool FULLOUT>
__device__ __forceinline__ S5In s5_fetch_p(const S5Ctx& C, int g, int tokA, int tokB, int lane) {
    const int m = lane & 31, kh = lane >> 5, tau = 4 * (m >> 3) + (m & 3), bsel = (m >> 2) & 1;
    const bf16* up = C.U + (size_t)((bsel ? tokB : tokA) + tau) * D + g * 16;
    S5In I; I.au = *(const v4u*)(up + 8 * kh); I.u0 = I.u1 = (v2u){0u, 0u};
    return I;
}
__device__ __forceinline__ void s5_skip_from_au(S5In& I, int kh) {
    const unsigned s0 = kh ? I.au.x : I.au.z, s1 = kh ? I.au.y : I.au.w;
    const unsigned r0 = (unsigned)__shfl_xor((int)s0, 32), r1 = (unsigned)__shfl_xor((int)s1, 32);
    I.u0 = kh ? (v2u){r0, r1} : (v2u){I.au.x, I.au.y}; I.u1 = kh ? (v2u){I.au.z, I.au.w} : (v2u){r0, r1};
}
template <bool FULLOUT, int PV = 0  >
__device__ __forceinline__ void s5_chunk(const S5Ctx& C, const S5In& I, int g, int tokA, int tokB, int nvalid, int lane, const bf16x8 (&Bf)[4], const bf16x8 (&Cf)[8],
                                         f32x2 a0, f32x2 a1, const f32x4 (&dsk)[2], float (&st)[4], float (&cap)[4], LAS unsigned char* xs) {
    const int m = lane & 31, kh = lane >> 5, tau = 4 * (m >> 3) + (m & 3), bsel = (m >> 2) & 1;
    const int tokrow = (bsel ? tokB : tokA) + tau;
    const bf16x8 Af = __builtin_bit_cast(bf16x8, I.au);
    f32x16 e[4];
#pragma unroll
    for (int nt = 0; nt < 4; ++nt) {
#pragma unroll
        for (int r = 0; r < 16; ++r) e[nt][r] = 0.f;
        e[nt] = __builtin_amdgcn_mfma_f32_32x32x16_bf16(Af, Bf[nt], e[nt], 0, 0, 0);
    }
    float re0 = st[0], im0 = st[1], re1 = st[2], im1 = st[3];
    asm volatile("s_nop 15\n\ts_nop 15\n\ts_nop 15" : "+v"(e[0]), "+v"(e[1]), "+v"(e[2]), "+v"(e[3]));
    const float na0y = -a0.y, na1y = -a1.y;
#pragma unroll
    for (int r = 0; r < 16; ++r) {
        const float t0 = sfma(na0y, im0, e[0][r]), u0 = sfma(a0.y, re0, e[2][r]), t1 = sfma(na1y, im1, e[1][r]), u1 = sfma(a1.y, re1, e[3][r]);
        const float nr0 = sfma(a0.x, re0, t0), ni0 = sfma(a0.x, im0, u0), nr1 = sfma(a1.x, re1, t1), ni1 = sfma(a1.x, im1, u1);
        re0 = nr0; im0 = ni0; re1 = nr1; im1 = ni1;
        e[0][r] = re0; e[2][r] = im0; e[1][r] = re1; e[3][r] = im1;
        if (r == 7) { cap[0] = re0; cap[1] = im0; cap[2] = re1; cap[3] = im1; }
    }
    st[0] = re0; st[1] = im0; st[2] = re1; st[3] = im1;
    if (FULLOUT) {
        const int n = lane & 31, hh = lane >> 5;
        { v2u xw[16];
#pragma unroll
          for (int r = 0; r < 16; ++r) xw[r] = (v2u){pk2h_raw(e[0][r], e[1][r]), pk2h_raw(e[2][r], e[3][r])};
          __builtin_amdgcn_sched_barrier(0);
          LAS unsigned char* xb = xs + (4 * hh) * XS_PITCH + n * 8;
#pragma unroll
          for (int r = 0; r < 16; ++r) *(LAS v2u*)(xb + (8 * (r >> 2) + (r & 3)) * XS_PITCH) = xw[r]; }
        LDS_WAIT(); asm volatile("" ::: "memory");
        f32x16 y;
#pragma unroll
        for (int r = 0; r < 16; ++r) y[r] = 0.f;
#pragma unroll
        for (int ks = 0; ks < 8; ++ks) { const bf16x8 xf = *(const LAS bf16x8*)(xs + m * XS_PITCH + 32 * ks + 16 * kh); y = __builtin_amdgcn_mfma_f32_32x32x16_bf16(Cf[ks], xf, y, 0, 0, 0); }
        LDS_WAIT(); asm volatile("" ::: "memory");
        if (tau < nvalid) {
            const int hh2 = lane >> 5;
#pragma unroll
            for (int half = 0; half < 2; ++half) {
                const int ch = 8 * half + 4 * hh2;
                const f32x4 u4 = unpk4(half ? I.u1 : I.u0);
                const f32x4 d4 = dsk[half];
                float o[4];
#pragma unroll
                for (int j = 0; j < 4; ++j) o[j] = gelu_tanh(y[4 * half + j] + d4[j] * u4[j]);
                const v2u ow = (v2u){pk2h(o[0], o[1]), pk2h(o[2], o[3])};
                if (!(PV & 4) || ow.x == 0x12345u) *(v2u*)(C.YG + (size_t)tokrow * D + g * 16 + ch) = ow;
            }
        }
    }
}
__device__ __forceinline__ void s5_load_frags(const S5Ctx& C, int g, int lane, bf16x8 (&Bf)[4], bf16x8 (&Cf)[8], f32x2& a0, f32x2& a1, f32x4 (&dsk)[2]) {
    const int n = lane & 31, kh = lane >> 5;
#pragma unroll
    for (int nt = 0; nt < 4; ++nt) Bf[nt] = *(const bf16x8*)(C.Bop + ((size_t)g * 128 + 32 * nt + n) * 16 + 8 * kh);
#pragma unroll
    for (int ks = 0; ks < 8; ++ks) Cf[ks] = *(const bf16x8*)(C.Cop + ((size_t)g * 32 + n) * 128 + 16 * ks + 8 * kh);
    a0 = C.Lam[g * 64 + n]; a1 = C.Lam[g * 64 + n + 32];
    dsk[0] = *(const f32x4*)(C.dskip + g * 16 + 4 * kh); dsk[1] = *(const f32x4*)(C.dskip + g * 16 + 8 + 4 * kh);
}
__device__ __forceinline__ void s5_pass_a(const S5Ctx& C, int g, int tokA, int tokB, int lane, const LAS unsigned char* wl, f32x2 a0, f32x2 a1, float (&st)[4], f32x16 (&z)[4], v4u (&A)[16]) {
    const int m = lane & 31, kh = lane >> 5, cc = 4 * (m >> 3) + (m & 3), bsel = (m >> 2) & 1;
    const bf16* up = C.U + (size_t)((bsel ? tokB : tokA) + 16 * cc) * D + g * 16 + 8 * kh;
#pragma unroll
    for (int tau = 0; tau < 16; ++tau) A[tau] = *(const v4u*)(up + (size_t)tau * D);
#pragma unroll
    for (int nt = 0; nt < 4; ++nt) {
#pragma unroll
        for (int r = 0; r < 16; ++r) z[nt][r] = 0.f; }
    const LAS unsigned char* wf = wl + m * 32 + 16 * kh;
#pragma unroll
    for (int tau = 0; tau < 16; ++tau) {
        bf16x8 w[4];
#pragma unroll
        for (int nt = 0; nt < 4; ++nt) w[nt] = *(const LAS bf16x8*)(wf + (tau * 128 + 32 * nt) * 32);
#pragma unroll
        for (int nt = 0; nt < 4; ++nt) z[nt] = __builtin_amdgcn_mfma_f32_32x32x16_bf16(__builtin_bit_cast(bf16x8, A[tau]), w[nt], z[nt], 0, 0, 0);
    }
    f32x2 p0 = a0, p1 = a1;
#pragma unroll
    for (int i = 0; i < 4; ++i) { p0 = (f32x2){p0.x * p0.x - p0.y * p0.y, 2.f * p0.x * p0.y}; p1 = (f32x2){p1.x * p1.x - p1.y * p1.y, 2.f * p1.x * p1.y}; }
    asm volatile("s_nop 15\n\ts_nop 15\n\ts_nop 15" : "+v"(z[0]), "+v"(z[1]), "+v"(z[2]), "+v"(z[3]));
    float re0 = 0.f, im0 = 0.f, re1 = 0.f, im1 = 0.f; const float np0y = -p0.y, np1y = -p1.y;
#pragma unroll
    for (int r = 0; r < 16; ++r) {
        const float t0 = sfma(np0y, im0, z[0][r]), u0 = sfma(p0.y, re0, z[2][r]), t1 = sfma(np1y, im1, z[1][r]), u1 = sfma(p1.y, re1, z[3][r]);
        const float nr0 = sfma(p0.x, re0, t0), ni0 = sfma(p0.x, im0, u0), nr1 = sfma(p1.x, re1, t1), ni1 = sfma(p1.x, im1, u1);
        re0 = nr0; im0 = ni0; re1 = nr1; im1 = ni1;
    }
    st[0] = re0; st[1] = im0; st[2] = re1; st[3] = im1;
}
template <int PV>
__device__ __forceinline__ void s5_pass_b(const S5Ctx& C, int g, int tokA, int tokB, int lane, int tid, LAS unsigned char* lds, LAS unsigned char* xs, f32x2 a0, f32x2 a1, const f32x16 (&z)[4], const v4u (&A)[16], float (&st)[4]) {
    const int m = lane & 31, n = m, hh = lane >> 5, kh = hh;
    f32x2 p0 = a0, p1 = a1;
#pragma unroll
    for (int i = 0; i < 4; ++i) { p0 = (f32x2){p0.x * p0.x - p0.y * p0.y, 2.f * p0.x * p0.y}; p1 = (f32x2){p1.x * p1.x - p1.y * p1.y, 2.f * p1.x * p1.y}; }
    float re0 = st[0], im0 = st[1], re1 = st[2], im1 = st[3]; const float np0y = -p0.y, np1y = -p1.y;
    v2u xw[16];
#pragma unroll
    for (int c = 0; c < 16; ++c) {
        xw[c] = (v2u){pk2h_raw(re0, re1), pk2h_raw(im0, im1)};
        const float t0 = np0y * im0 + z[0][c], u0 = p0.y * re0 + z[2][c], t1 = np1y * im1 + z[1][c], u1 = p1.y * re1 + z[3][c];
        const float nr0 = p0.x * re0 + t0, ni0 = p0.x * im0 + u0, nr1 = p1.x * re1 + t1, ni1 = p1.x * im1 + u1;
        re0 = nr0; im0 = ni0; re1 = nr1; im1 = ni1;
    }
    st[0] = re0; st[1] = im0; st[2] = re1; st[3] = im1;
    __builtin_amdgcn_sched_barrier(0);
    { LAS unsigned char* xb = xs + (4 * hh) * XS_PITCH + n * 8;
#pragma unroll
      for (int c = 0; c < 16; ++c) *(LAS v2u*)(xb + (8 * (c >> 2) + (c & 3)) * XS_PITCH) = xw[c]; }
    LDS_WAIT(); asm volatile("" ::: "memory");
    bf16x8 Ax[8];
#pragma unroll
    for (int ks = 0; ks < 8; ++ks) Ax[ks] = *(const LAS bf16x8*)(xs + m * XS_PITCH + 32 * ks + 16 * kh);
    LDS_WAIT(); asm volatile("" ::: "memory");
    const int cc = 4 * (m >> 3) + (m & 3), bsel = (m >> 2) & 1;
    bf16* yrow8 = C.YG + (size_t)((bsel ? tokB : tokA) + 16 * cc) * D + g * 16 + 8 * hh;
    const unsigned char* gsrc = (const unsigned char*)(C.Gop + (size_t)g * 8 * 256 * 16);
    const unsigned char* msrc = (const unsigned char*)(C.Mop + (size_t)g * 16 * 16 * 16);
    LAS unsigned char* tb = lds + 80 * 1024;
    const unsigned char* sbase[3]; int sf[3], sd0[3];
#pragma unroll
    for (int i = 0; i < 3; ++i) { const int pc = tid + 512 * i, f = pc >> 6, off = pc & 63; sf[i] = f; sd0[i] = (off >> 5) - (f - 8);
        sbase[i] = (f < 8) ? gsrc + (size_t)f * 8192 + 16 * off : msrc + (ptrdiff_t)sd0[i] * 512 + ((off >> 1) & 15) * 32 + 16 * (off & 1); }
#define S5_SLICE_LOAD(R, jj) do { _Pragma("unroll") for (int i = 0; i < 3; ++i) { \
        if (sf[i] < 10 + 2 * (jj)) R[i] = (sf[i] < 8 || 2 * (jj) + sd0[i] >= 0) ? *(const v4u*)(sbase[i] + 1024 * (jj)) : (v4u){0u, 0u, 0u, 0u}; } } while (0)
#define S5_SLICE_STORE(R, jj) do { _Pragma("unroll") for (int i = 0; i < 3; ++i) { const int pc = tid + 512 * i; if ((pc >> 6) < 10 + 2 * (jj)) *(LAS v4u*)(tb + ((jj) & 1) * 24576 + 16 * pc) = R[i]; } } while (0)
    { v4u R0[3]; S5_SLICE_LOAD(R0, 0); S5_SLICE_STORE(R0, 0); }
    LDS_WAIT(); __builtin_amdgcn_s_barrier(); asm volatile("" ::: "memory");
#pragma unroll
    for (int j = 0; j < 8; ++j) {
        v4u R[3];
        if (j + 1 < 8) S5_SLICE_LOAD(R, j + 1);
        const LAS unsigned char* sl = tb + (j & 1) * 24576 + m * 32 + 16 * kh;
        f32x16 acc;
#pragma unroll
        for (int r = 0; r < 16; ++r) acc[r] = 0.f;
#pragma unroll
        for (int ks = 0; ks < 8; ++ks) acc = __builtin_amdgcn_mfma_f32_32x32x16_bf16(*(const LAS bf16x8*)(sl + ks * 1024), Ax[ks], acc, 0, 0, 0);
#pragma unroll
        for (int sg = 0; sg < 2 * j + 2; ++sg) acc = __builtin_amdgcn_mfma_f32_32x32x16_bf16(*(const LAS bf16x8*)(sl + (8 + sg) * 1024), __builtin_bit_cast(bf16x8, A[sg]), acc, 0, 0, 0);
#pragma unroll
        for (int t2 = 0; t2 < 2; ++t2) { v2u oq[2];
#pragma unroll
            for (int h2 = 0; h2 < 2; ++h2) { float o[4];
#pragma unroll
                for (int e = 0; e < 4; ++e) o[e] = gelu_tanh(acc[4 * (2 * t2 + h2) + e]);
                oq[h2] = (v2u){pk2h(o[0], o[1]), pk2h(o[2], o[3])}; }
            const v2u snd = hh ? oq[0] : oq[1];
            const v2u rcv = (v2u){(unsigned)__shfl_xor((int)snd.x, 32), (unsigned)__shfl_xor((int)snd.y, 32)};
            const v4u ow = hh ? (v4u){rcv.x, rcv.y, oq[1].x, oq[1].y} : (v4u){oq[0].x, oq[0].y, rcv.x, rcv.y};
            if (!(PV & 4) || ow.x == 0x12345u) *(v4u*)(yrow8 + (size_t)(2 * j + t2) * D) = ow; }
        if (j + 1 < 8) S5_SLICE_STORE(R, j + 1);
        LDS_WAIT(); __builtin_amdgcn_s_barrier(); asm volatile("" ::: "memory");
    }
#undef S5_SLICE_LOAD
#undef S5_SLICE_STORE
}
template <int VAR = 0>
__device__ __forceinline__ void phase_s5(const S5Ctx& C, const float* const* in, float* out, LAS unsigned char* lds, int tid, int vcu, int G) {
    const int wave = __builtin_amdgcn_readfirstlane(tid >> 6), lane = tid & 63, n = lane & 31, hh = lane >> 5;
    LAS unsigned char* xs = lds + wave * (32 * XS_PITCH);
    LAS f32x4* ebuf = (LAS f32x4*)(lds + 8 * 32 * XS_PITCH);
    bf16x8 Bf[4], Cf[8]; f32x2 a0, a1; f32x4 dsk[2]; float st[4], cap[4];
    if (!(VAR & 1)) for (int u = vcu * NWAVES + wave; u < 64 * 64; u += G * NWAVES) {
        const int bp = u >> 6, g = u & 63, b = 2 * bp + hh;
        s5_load_frags(C, g, lane, Bf, Cf, a0, a1, dsk);
        const size_t sb = ((size_t)b * 64 + g) * 64 + n;
        st[0] = in[I_SRE][sb]; st[1] = in[I_SIM][sb]; st[2] = in[I_SRE][sb + 32]; st[3] = in[I_SIM][sb + 32];
        { const S5In I = s5_fetch<true>(C, g, TP + 16 * bp, TP + 16 * bp + 8, 8, lane); s5_chunk<true>(C, I, g, TP + 16 * bp, TP + 16 * bp + 8, 8, lane, Bf, Cf, a0, a1, dsk, st, cap, xs); }
        out[O_RES + sb] = cap[0]; out[O_IMS + sb] = cap[1]; out[O_RES + sb + 32] = cap[2]; out[O_IMS + sb + 32] = cap[3];
    }
    if (!(VAR & 2)) for (int u = vcu; u < 4 * 64; u += G) {
        int lane_ = lane; asm volatile("" : "+v"(lane_));
        const int lane = lane_, n = lane & 31, hh = lane >> 5;
        const int bp = u >> 6, g = u & 63, b = 2 * bp + hh;
        const int tokA = (2 * bp) * 2048 + 256 * wave, tokB = tokA + 2048;
        __syncthreads();
        { const v4u* wsrc = (const v4u*)(C.Wop + (size_t)g * 16 * 128 * 16);
          v4u wv[8];
#pragma unroll
          for (int i = 0; i < 8; ++i) wv[i] = wsrc[tid + 512 * i];
#pragma unroll
          for (int i = 0; i < 8; ++i) *(LAS v4u*)(lds + 16 * (tid + 512 * i)) = wv[i]; }
        a0 = C.Lam[g * 64 + n]; a1 = C.Lam[g * 64 + n + 32];
        __syncthreads();
        f32x16 zc[4]; v4u Au[16];
        s5_pass_a(C, g, tokA, tokB, lane, lds, a0, a1, st, zc, Au);
        ebuf[wave * 64 + lane] = (f32x4){st[0], st[1], st[2], st[3]};
        f32x2 p0 = a0, p1 = a1;
#pragma unroll
        for (int i = 0; i < 8; ++i) { p0 = (f32x2){p0.x * p0.x - p0.y * p0.y, 2.f * p0.x * p0.y}; p1 = (f32x2){p1.x * p1.x - p1.y * p1.y, 2.f * p1.x * p1.y}; }
        __syncthreads();
        st[0] = st[1] = st[2] = st[3] = 0.f;
        for (int v = 0; v < wave; ++v) { const f32x4 ev = ebuf[v * 64 + lane];
            const float r0 = p0.x * st[0] - p0.y * st[1] + ev.x, i0 = p0.x * st[1] + p0.y * st[0] + ev.y, r1 = p1.x * st[2] - p1.y * st[3] + ev.z, i1 = p1.x * st[3] + p1.y * st[2] + ev.w;
            st[0] = r0; st[1] = i0; st[2] = r1; st[3] = i1; }
        s5_pass_b<VAR>(C, g, tokA, tokB, lane, tid, lds, xs, a0, a1, zc, Au, st);
        if (wave == 7) { const size_t sb = ((size_t)b * 64 + g) * 64 + n;
            out[O_REP + sb] = st[0]; out[O_IMP + sb] = st[1]; out[O_REP + sb + 32] = st[2]; out[O_IMP + sb + 32] = st[3]; }
        __syncthreads();
    }
}

constexpr int GOP_STRIDE = 11264;
constexpr int GOP_QE = 0, GOP_AE = 4096, GOP_KE = 6144, GOP_GAM = 10240;
constexpr int GVT_STRIDE = 8192;
constexpr int IMG_PITCH = 144;

__device__ __forceinline__ unsigned char* gop_ptr(unsigned char* gopA, unsigned char* gopB, int bh) { return bh < 24 ? gopA + (size_t)bh * (64 * GOP_STRIDE) : gopB + (size_t)(bh - 24) * (64 * GOP_STRIDE); }
__device__ __forceinline__ void phase_pre_gla(int gw, int NGW, int lane, LAS unsigned char* lds_wave, const bf16* P, const float* ebuf, unsigned char* gopA, unsigned char* gopB, unsigned char* gvt) {
    LAS unsigned char* imgQ = lds_wave; LAS unsigned char* imgK = lds_wave + 32 * IMG_PITCH;
    for (int u = gw; u < 8 * 4 * 64; u += NGW) {
        const int b = u >> 8, h = (u >> 6) & 3, c = u & 63, tok0 = b * 2048 + 32 * c;
        unsigned char* op = gop_ptr(gopA, gopB, u >> 6) + (size_t)(u & 63) * GOP_STRIDE; unsigned char* vt = gvt + (size_t)u * GVT_STRIDE;
        unsigned vraw[2][32];
#pragma unroll
        for (int pass = 0; pass < 2; ++pass)
#pragma unroll
            for (int i = 0; i < 32; ++i) vraw[pass][i] = (unsigned)P[(size_t)(tok0 + i) * NMIX + GV + h * 128 + 64 * pass + lane];
        __builtin_amdgcn_sched_barrier(0);
        float g = 1.0f; float kin[32];
#pragma unroll
        for (int tb = 0; tb < 2; ++tb) {
            float e8[16]; unsigned qr[16], kr[16];
#pragma unroll
            for (int i = 0; i < 16; ++i) { const int tok = tok0 + 16 * tb + i; const bf16* prow = P + (size_t)tok * NMIX;
                e8[i] = ebuf[(size_t)tok * 256 + h * 64 + lane]; qr[i] = (unsigned)prow[GQ + h * 64 + lane]; kr[i] = (unsigned)prow[GK + h * 64 + lane]; }
            __builtin_amdgcn_sched_barrier(0);
#pragma unroll
            for (int i = 0; i < 16; ++i) { const int t = 16 * tb + i; g *= e8[i]; const float qg = bflo(qr[i]) * 0.125f * g, ki = bflo(kr[i]) * frcp(g); kin[t] = ki;
                *(LAS bf16*)(imgQ + t * IMG_PITCH + 2 * lane) = (bf16)f2bf(qg); *(LAS bf16*)(imgK + t * IMG_PITCH + 2 * lane) = (bf16)f2bf(ki); }
        }
        { v4u o[4];
#pragma unroll
          for (int i = 0; i < 4; ++i) { o[i].x = pk2h_raw(kin[8 * i] * g, kin[8 * i + 1] * g); o[i].y = pk2h_raw(kin[8 * i + 2] * g, kin[8 * i + 3] * g); o[i].z = pk2h_raw(kin[8 * i + 4] * g, kin[8 * i + 5] * g); o[i].w = pk2h_raw(kin[8 * i + 6] * g, kin[8 * i + 7] * g);
              if (FENCE_OPS) cvt_fence4(o[i].x, o[i].y, o[i].z, o[i].w);
              *(v4u*)(op + GOP_KE + lane * 64 + 16 * i) = o[i]; }
          *(float*)(op + GOP_GAM + 4 * lane) = g; }
#pragma unroll
        for (int pass = 0; pass < 2; ++pass) { const int dv = 64 * pass + lane;
#pragma unroll
            for (int i = 0; i < 4; ++i) *(v4u*)(vt + dv * 64 + 16 * i) = (v4u){vraw[pass][8 * i] | (vraw[pass][8 * i + 1] << 16), vraw[pass][8 * i + 2] | (vraw[pass][8 * i + 3] << 16), vraw[pass][8 * i + 4] | (vraw[pass][8 * i + 5] << 16), vraw[pass][8 * i + 6] | (vraw[pass][8 * i + 7] << 16)}; }
        LDS_WAIT(); asm volatile("" ::: "memory");
        { const int m = lane & 31, kh = lane >> 5; f32x16 acc;
#pragma unroll
          for (int r = 0; r < 16; ++r) acc[r] = 0.f;
#pragma unroll
          for (int ks = 0; ks < 4; ++ks) { const bf16x8 a = *(const LAS bf16x8*)(imgQ + m * IMG_PITCH + 32 * ks + 16 * kh), bb = *(const LAS bf16x8*)(imgK + m * IMG_PITCH + 32 * ks + 16 * kh);
              acc = __builtin_amdgcn_mfma_f32_32x32x16_bf16(a, bb, acc, 0, 0, 0); }
#pragma unroll
          for (int r8 = 0; r8 < 16; r8 += 8) { unsigned pa[8];
#pragma unroll
              for (int i = 0; i < 8; ++i) { const int r = r8 + i, t = 8 * (r >> 2) + 4 * kh + (r & 3); const float v = (m <= t) ? acc[r] : 0.f; const float nb = dpp_xor1(v); pa[i] = pk2h_raw(v, nb); }
              if (FENCE_OPS) cvt_fence8(pa);
              if (!(lane & 1)) {
#pragma unroll
                  for (int i = 0; i < 8; ++i) { const int r = r8 + i, t = 8 * (r >> 2) + 4 * kh + (r & 3); *(unsigned*)(op + GOP_AE + t * 64 + 2 * m) = pa[i]; } } }
#pragma unroll
          for (int i = 0; i < 4; ++i) { const int pc = lane + 64 * i, t = pc >> 3, cc = pc & 7; *(v4u*)(op + GOP_QE + t * 128 + 16 * cc) = *(const LAS v4u*)(imgQ + t * IMG_PITCH + 16 * cc); }
        }
        LDS_WAIT(); asm volatile("" ::: "memory");
    }
}

struct SeqOpsG { v2u qe[8]; v4u ae[2]; v4u ke[4]; v4u vt[2]; f32x4 gam[8]; };
__device__ __forceinline__ void seqg_load(SeqOpsG& L, const unsigned char* op, const unsigned char* vt, int nt, int lane) {
    const int m = lane & 31, h = lane >> 5;
#pragma unroll
    for (int ks = 0; ks < 4; ++ks) { L.qe[2 * ks] = *(const v2u*)(op + GOP_QE + m * 128 + 2 * (16 * ks + 4 * h)); L.qe[2 * ks + 1] = *(const v2u*)(op + GOP_QE + m * 128 + 2 * (16 * ks + 8 + 4 * h)); }
#pragma unroll
    for (int ks = 0; ks < 2; ++ks) { L.ae[ks] = *(const v4u*)(op + GOP_AE + m * 64 + 2 * (16 * ks + 8 * h)); L.vt[ks] = *(const v4u*)(vt + (32 * nt + m) * 64 + 2 * (16 * ks + 8 * h)); }
#pragma unroll
    for (int mt = 0; mt < 2; ++mt)
#pragma unroll
        for (int ks = 0; ks < 2; ++ks) L.ke[2 * mt + ks] = *(const v4u*)(op + GOP_KE + (32 * mt + m) * 64 + 2 * (16 * ks + 8 * h));
#pragma unroll
    for (int mt = 0; mt < 2; ++mt)
#pragma unroll
        for (int q = 0; q < 4; ++q) L.gam[4 * mt + q] = *(const f32x4*)(op + GOP_GAM + 4 * (32 * mt + 8 * q + 4 * h));
}
__device__ __forceinline__ void phase_seq_gla(int unit0, int ustride, int lane, const unsigned char* gop, const unsigned char* gvt, bf16* og, float* out) {
    for (int u = unit0; u < 8 * 4 * 4; u += ustride) {
        const int bh = u >> 2, nt = u & 3, b = bh >> 2, h = bh & 3, m = lane & 31, hh = lane >> 5;
        f32x16 H0, H1;
#pragma unroll
        for (int r = 0; r < 16; ++r) { H0[r] = 0.f; H1[r] = 0.f; }
        bf16x8 HB[4];
#pragma unroll
        for (int i = 0; i < 4; ++i) HB[i] = (bf16x8){0, 0, 0, 0, 0, 0, 0, 0};
        SeqOpsG cur, nxt;
        seqg_load(cur, gop + (size_t)(bh * 64) * GOP_STRIDE, gvt + (size_t)(bh * 64) * GVT_STRIDE, nt, lane);
        for (int c = 0; c < 64; ++c) {
            const int cn = (c + 1 < 64) ? c + 1 : c;
            seqg_load(nxt, gop + (size_t)(bh * 64 + cn) * GOP_STRIDE, gvt + (size_t)(bh * 64 + cn) * GVT_STRIDE, nt, lane);
            f32x16 O;
#pragma unroll
            for (int r = 0; r < 16; ++r) O[r] = 0.f;
#pragma unroll
            for (int ks = 0; ks < 4; ++ks) { const v4u a = {cur.qe[2 * ks].x, cur.qe[2 * ks].y, cur.qe[2 * ks + 1].x, cur.qe[2 * ks + 1].y}; O = __builtin_amdgcn_mfma_f32_32x32x16_bf16(__builtin_bit_cast(bf16x8, a), HB[ks], O, 0, 0, 0); }
#pragma unroll
            for (int ks = 0; ks < 2; ++ks) O = __builtin_amdgcn_mfma_f32_32x32x16_bf16(__builtin_bit_cast(bf16x8, cur.ae[ks]), __builtin_bit_cast(bf16x8, cur.vt[ks]), O, 0, 0, 0);
            const int tokc = b * 2048 + 32 * c;
#pragma unroll
            for (int r = 0; r < 16; ++r) { const int t = 8 * (r >> 2) + 4 * hh + (r & 3); const float v = O[r], nb = dpp_xor1(v);
                if (!(lane & 1)) *(unsigned*)(og + (size_t)(tokc + t) * 512 + h * 128 + 32 * nt + m) = pk2h(v, nb); }
#pragma unroll
            for (int r = 0; r < 16; ++r) { H0[r] *= cur.gam[r >> 2][r & 3]; H1[r] *= cur.gam[4 + (r >> 2)][r & 3]; }
#pragma unroll
            for (int ks = 0; ks < 2; ++ks) { H0 = __builtin_amdgcn_mfma_f32_32x32x16_bf16(__builtin_bit_cast(bf16x8, cur.ke[ks]), __builtin_bit_cast(bf16x8, cur.vt[ks]), H0, 0, 0, 0);
                H1 = __builtin_amdgcn_mfma_f32_32x32x16_bf16(__builtin_bit_cast(bf16x8, cur.ke[2 + ks]), __builtin_bit_cast(bf16x8, cur.vt[ks]), H1, 0, 0, 0); }
#pragma unroll
            for (int s2 = 0; s2 < 2; ++s2) { v4u p0, p1;
                p0.x = pk2h(H0[8 * s2], H0[8 * s2 + 1]); p0.y = pk2h(H0[8 * s2 + 2], H0[8 * s2 + 3]); p0.z = pk2h(H0[8 * s2 + 4], H0[8 * s2 + 5]); p0.w = pk2h(H0[8 * s2 + 6], H0[8 * s2 + 7]);
                p1.x = pk2h(H1[8 * s2], H1[8 * s2 + 1]); p1.y = pk2h(H1[8 * s2 + 2], H1[8 * s2 + 3]); p1.z = pk2h(H1[8 * s2 + 4], H1[8 * s2 + 5]); p1.w = pk2h(H1[8 * s2 + 6], H1[8 * s2 + 7]);
                HB[s2] = __builtin_bit_cast(bf16x8, p0); HB[2 + s2] = __builtin_bit_cast(bf16x8, p1); }
            cur = nxt;
        }
        float* st = out + O_GLAP + (size_t)bh * 8192;
#pragma unroll
        for (int r = 0; r < 16; ++r) { const int d = 8 * (r >> 2) + 4 * hh + (r & 3); st[(size_t)d * 128 + 32 * nt + m] = H0[r]; st[(size_t)(32 + d) * 128 + 32 * nt + m] = H1[r]; }
    }
}

constexpr int ROP_QE = 0, ROP_AE = 4096, ROP_KE = 6144, ROP_G = 10240, ROP_STRIDE = 18432;
constexpr int RVT_STRIDE = 4096;
constexpr int JT_PITCH = 80;
constexpr int PR_KKG = 0, PR_RG = 4608, PR_KI = 9216, PR_BI = 13824, PR_KKGT = 18432, PR_BIT = 23552, PR_GAM = 28672, PR_BYTES = 28928;
constexpr int PR_WAVES = 4;
static_assert(PR_WAVES * PR_BYTES <= LDSCTL_OFF, "pre_rwkv LDS");
struct RopMap { unsigned char *a, *b, *c; };
__device__ __forceinline__ unsigned char* rop_ptr(const RopMap& M, int bh) { return bh < 45 ? M.a + (size_t)bh * (64 * ROP_STRIDE) : M.b + (size_t)(bh - 45) * (64 * ROP_STRIDE); }
__device__ __forceinline__ unsigned char* rvt_ptr(const RopMap& M, int bh) { return bh < 50 ? M.b + (size_t)19 * (64 * ROP_STRIDE) + (size_t)bh * (64 * RVT_STRIDE) : M.c + (size_t)(bh - 50) * (64 * RVT_STRIDE); }

__device__ __forceinline__ bf16x8 acc_frag(const f32x16& x, int s) {
    v4u p; p.x = pk2h_raw(x[8 * s], x[8 * s + 1]); p.y = pk2h_raw(x[8 * s + 2], x[8 * s + 3]); p.z = pk2h_raw(x[8 * s + 4], x[8 * s + 5]); p.w = pk2h_raw(x[8 * s + 6], x[8 * s + 7]);
    asm("s_nop 1" : "+v"(p.x), "+v"(p.y), "+v"(p.z), "+v"(p.w));
    return __builtin_bit_cast(bf16x8, p);
}
__device__ __forceinline__ bf16x8 ld_perm(const LAS unsigned char* row, int ks, int h) {
    const v2u lo = *(const LAS v2u*)(row + 2 * (16 * ks + 4 * h)), hi = *(const LAS v2u*)(row + 2 * (16 * ks + 8 + 4 * h)); const v4u p = {lo.x, lo.y, hi.x, hi.y}; return __builtin_bit_cast(bf16x8, p);
}
__device__ __forceinline__ f32x16 zero16() { f32x16 z;
#pragma unroll
    for (int r = 0; r < 16; ++r) z[r] = 0.f;
    return z; }
#define MFMA32(a, b, c) __builtin_amdgcn_mfma_f32_32x32x16_bf16((a), (b), (c), 0, 0, 0)

__device__ __forceinline__ void phase_pre_rwkv(int vcu, int G, int wave, int lane_in, LAS unsigned char* lds, const float* const* in, const bf16* P, const float* wdec, const bf16* abuf, const RopMap& M) {
    if (wave >= PR_WAVES) return;
    LAS unsigned char* L = lds + wave * PR_BYTES;
    for (int u = vcu * PR_WAVES + wave; u < 64 * 64; u += G * PR_WAVES) {
        unsigned z_ = 0u; asm volatile("" : "+v"(z_)); const int lane = (int)__builtin_amdgcn_mbcnt_hi(~0u, __builtin_amdgcn_mbcnt_lo(~0u, z_)); (void)lane_in;
        const int m = lane & 31, hh = lane >> 5;
        const int bh = u >> 6, c = u & 63, b = bh >> 3, h = bh & 7, tok0 = b * 2048 + 32 * c, col = h * 64 + lane;
        unsigned char* op = rop_ptr(M, bh) + (size_t)c * ROP_STRIDE; unsigned char* vt = rvt_ptr(M, bh) + (size_t)c * RVT_STRIDE;
        {
            const int jg = lane & 7, tg = lane >> 3, cb = h * 64 + 8 * jg;
            float cmur[8], cmuk[8], cmuv[8], ckk[8], cka[8];
            { const float* p5[5] = {in[I_MU] + cb, in[I_MU] + 512 + cb, in[I_MU] + 1024 + cb, in[I_KK] + cb, in[I_KA] + cb};
              const f32x4 a0 = *(const f32x4*)p5[0], a1 = *(const f32x4*)(p5[0] + 4), b0 = *(const f32x4*)p5[1], b1 = *(const f32x4*)(p5[1] + 4), c0 = *(const f32x4*)p5[2], c1 = *(const f32x4*)(p5[2] + 4),
                          d0 = *(const f32x4*)p5[3], d1 = *(const f32x4*)(p5[3] + 4), e0 = *(const f32x4*)p5[4], e1 = *(const f32x4*)(p5[4] + 4);
#pragma unroll
              for (int e = 0; e < 4; ++e) { cmur[e] = a0[e]; cmur[4 + e] = a1[e]; cmuk[e] = b0[e]; cmuk[4 + e] = b1[e]; cmuv[e] = c0[e]; cmuv[4 + e] = c1[e]; ckk[e] = d0[e]; ckk[4 + e] = d1[e]; cka[e] = e0[e]; cka[4 + e] = e1[e]; } }
            v4u Lr[5], Lk[5], Lv[5], La[4]; f32x4 Lw[4][2];
            const int tfirst = tok0 + 4 * tg;
#pragma unroll
            for (int i = 0; i < 5; ++i) { const int tok = tfirst + i - 1; const bool ok = (i > 0) || (c > 0) || (tg > 0);
                if (ok) { const bf16* q = P + (size_t)tok * NMIX + cb; Lr[i] = *(const v4u*)q; Lk[i] = *(const v4u*)(q + 512); Lv[i] = *(const v4u*)(q + 1024); }
                else { Lr[i] = Lk[i] = Lv[i] = (v4u){0u, 0u, 0u, 0u}; } }
#pragma unroll
            for (int i = 0; i < 4; ++i) { const int tok = tfirst + i; La[i] = *(const v4u*)(abuf + (size_t)tok * 512 + cb); Lw[i][0] = *(const f32x4*)(wdec + (size_t)tok * 512 + cb); Lw[i][1] = *(const f32x4*)(wdec + (size_t)tok * 512 + cb + 4); }
            float lw[4][8];
#pragma unroll
            for (int e = 0; e < 8; ++e) { float acc = 1.0f;
#pragma unroll
                for (int i = 0; i < 4; ++i) { acc *= Lw[i][e >> 2][e & 3]; lw[i][e] = acc; } }
            float Pin[8], Eex[8];
#pragma unroll
            for (int e = 0; e < 8; ++e) { float p = lw[3][e];
#pragma unroll
                for (int dd = 1; dd < 8; dd <<= 1) { const float o = __shfl_up(p, 8 * dd); p = (tg >= dd) ? p * o : p; }
                Pin[e] = p; const float ex = __shfl_up(p, 8); Eex[e] = (tg >= 1) ? ex : 1.0f; }
            if (tg == 7) { *(LAS f32x4*)(L + PR_GAM + 4 * (8 * jg)) = (f32x4){Pin[0], Pin[1], Pin[2], Pin[3]}; *(LAS f32x4*)(L + PR_GAM + 4 * (8 * jg + 4)) = (f32x4){Pin[4], Pin[5], Pin[6], Pin[7]}; }
            unsigned kkgt[8], bit[8], vtt[8];
#pragma unroll
            for (int i = 0; i < 4; ++i) {
                float r8[8], k8[8], v8[8], pr8[8], pk8[8], pv8[8], a8[8];
                { const v4u x = Lr[i + 1], y = Lk[i + 1], z = Lv[i + 1], xp = Lr[i], yp = Lk[i], zp = Lv[i], aa = La[i];
                  const unsigned xr[4] = {x.x, x.y, x.z, x.w}, yr[4] = {y.x, y.y, y.z, y.w}, zr4[4] = {z.x, z.y, z.z, z.w}, xq[4] = {xp.x, xp.y, xp.z, xp.w}, yq[4] = {yp.x, yp.y, yp.z, yp.w}, zq[4] = {zp.x, zp.y, zp.z, zp.w}, aq[4] = {aa.x, aa.y, aa.z, aa.w};
#pragma unroll
                  for (int e = 0; e < 4; ++e) { r8[2 * e] = bflo(xr[e]); r8[2 * e + 1] = bfhi(xr[e]); k8[2 * e] = bflo(yr[e]); k8[2 * e + 1] = bfhi(yr[e]); v8[2 * e] = bflo(zr4[e]); v8[2 * e + 1] = bfhi(zr4[e]);
                      pr8[2 * e] = bflo(xq[e]); pr8[2 * e + 1] = bfhi(xq[e]); pk8[2 * e] = bflo(yq[e]); pk8[2 * e + 1] = bfhi(yq[e]); pv8[2 * e] = bflo(zq[e]); pv8[2 * e + 1] = bfhi(zq[e]); a8[2 * e] = bflo(aq[e]); a8[2 * e + 1] = bfhi(aq[e]); } }
                float zr[8], zk[8], zv[8], kkr[8]; float ss = 0.f;
#pragma unroll
                for (int e = 0; e < 8; ++e) { zr[e] = r8[e] + (pr8[e] - r8[e]) * cmur[e]; zk[e] = k8[e] + (pk8[e] - k8[e]) * cmuk[e]; zv[e] = v8[e] + (pv8[e] - v8[e]) * cmuv[e]; kkr[e] = zk[e] * ckk[e]; ss += kkr[e] * kkr[e]; }
                ss = ar8(ss); const float inv = rsqrtf(fmaxf(ss, 1e-24f));
                float okkg[8], org[8], oki[8], obi[8];
#pragma unroll
                for (int e = 0; e < 8; ++e) { const float kk = kkr[e] * inv, kmod = zk[e] * (1.0f + (a8[e] - 1.0f) * cka[e]), bb = kk * a8[e];
                    const float gp = Eex[e] * ((i == 0) ? 1.0f : lw[(i == 0) ? 0 : i - 1][e]), gt = Eex[e] * lw[i][e], ig = frcp(gt);
                    okkg[e] = kk * gp; org[e] = zr[e] * gt; oki[e] = kmod * ig; obi[e] = bb * ig; }
                const int t = 4 * tg + i;
                v4u w0, w1, w2, w3;
                w0.x = pk2h_raw(okkg[0], okkg[1]); w0.y = pk2h_raw(okkg[2], okkg[3]); w0.z = pk2h_raw(okkg[4], okkg[5]); w0.w = pk2h_raw(okkg[6], okkg[7]);
                w1.x = pk2h_raw(org[0], org[1]); w1.y = pk2h_raw(org[2], org[3]); w1.z = pk2h_raw(org[4], org[5]); w1.w = pk2h_raw(org[6], org[7]);
                w2.x = pk2h_raw(oki[0], oki[1]); w2.y = pk2h_raw(oki[2], oki[3]); w2.z = pk2h_raw(oki[4], oki[5]); w2.w = pk2h_raw(oki[6], oki[7]);
                w3.x = pk2h_raw(obi[0], obi[1]); w3.y = pk2h_raw(obi[2], obi[3]); w3.z = pk2h_raw(obi[4], obi[5]); w3.w = pk2h_raw(obi[6], obi[7]);
                unsigned pw0[8], pw1[8], pw2[8];
                if (i & 1) {
#pragma unroll
                    for (int e = 0; e < 8; ++e) { pw0[e] = pk2h_raw(__builtin_bit_cast(float, kkgt[e]), okkg[e]); pw1[e] = pk2h_raw(__builtin_bit_cast(float, bit[e]), obi[e]); pw2[e] = pk2h_raw(__builtin_bit_cast(float, vtt[e]), zv[e]); }
                } else {
#pragma unroll
                    for (int e = 0; e < 8; ++e) { kkgt[e] = __builtin_bit_cast(unsigned, okkg[e]); bit[e] = __builtin_bit_cast(unsigned, obi[e]); vtt[e] = __builtin_bit_cast(unsigned, zv[e]); }
                }
                __builtin_amdgcn_sched_barrier(0);
                *(LAS v4u*)(L + PR_KKG + t * IMG_PITCH + 16 * jg) = w0; *(LAS v4u*)(L + PR_RG + t * IMG_PITCH + 16 * jg) = w1; *(LAS v4u*)(L + PR_KI + t * IMG_PITCH + 16 * jg) = w2; *(LAS v4u*)(L + PR_BI + t * IMG_PITCH + 16 * jg) = w3;
                if (i & 1) { const int o2 = 2 * (4 * tg + i - 1);
#pragma unroll
                    for (int e = 0; e < 8; ++e) { *(LAS unsigned*)(L + PR_KKGT + (8 * jg + e) * JT_PITCH + o2) = pw0[e]; *(LAS unsigned*)(L + PR_BIT + (8 * jg + e) * JT_PITCH + o2) = pw1[e]; *(unsigned*)(vt + (8 * jg + e) * 64 + o2) = pw2[e]; } }
            }
        }
        LDS_WAIT(); asm volatile("" ::: "memory"); __builtin_amdgcn_sched_barrier(0);
        f32x16 Akv = zero16(), Akb = zero16(), Ark = zero16(), ArbT = zero16();
#pragma unroll
        for (int ks = 0; ks < 4; ++ks) {
            const int off = m * IMG_PITCH + 32 * ks + 16 * hh;
            const bf16x8 fkkg = *(const LAS bf16x8*)(L + PR_KKG + off), frg = *(const LAS bf16x8*)(L + PR_RG + off), fki = *(const LAS bf16x8*)(L + PR_KI + off), fbi = *(const LAS bf16x8*)(L + PR_BI + off);
            Akv = MFMA32(fkkg, fki, Akv); Akb = MFMA32(fkkg, fbi, Akb); Ark = MFMA32(frg, fki, Ark); ArbT = MFMA32(fbi, frg, ArbT);
        }
        const int mh = m - 4 * hh;
#pragma unroll
        for (int r = 0; r < 16; ++r) { const int rc = 8 * (r >> 2) + (r & 3);
            Akv[r] = (mh < rc) ? Akv[r] : 0.f; Akb[r] = (mh < rc) ? Akb[r] : 0.f; Ark[r] = (mh <= rc) ? Ark[r] : 0.f; ArbT[r] = (rc <= mh) ? ArbT[r] : 0.f; }
        LDS_WAIT(); asm volatile("" ::: "memory"); __builtin_amdgcn_sched_barrier(0);
        { LAS float* A = (LAS float*)(L + PR_KKG);
          { LAS float* Ab = A + (4 * hh) * 32 + m;
#pragma unroll
            for (int r = 0; r < 16; ++r) Ab[(8 * (r >> 2) + (r & 3)) * 32] = Akb[r]; }
          LDS_WAIT(); asm volatile("" ::: "memory"); __builtin_amdgcn_sched_barrier(0);
          float T[32];
#pragma unroll
          for (int t = 0; t < 32; ++t) { float acc4[4] = {(t == m) ? 1.0f : 0.f, 0.f, 0.f, 0.f};
              int dep = 0; if (t > 0) asm volatile("v_and_b32 %0, 0, %1" : "=v"(dep) : "v"(T[t - 1]));
              const LAS float* Ar = A + t * 32 + dep;
#pragma unroll
              for (int s4 = 0; s4 < 8; ++s4) { if (4 * s4 >= t) continue; const f32x4 a4 = *(const LAS f32x4*)(Ar + 4 * s4);
#pragma unroll
                  for (int e = 0; e < 4; ++e) if (4 * s4 + e < t) acc4[e] -= a4[e] * T[4 * s4 + e]; }
              T[t] = (acc4[0] + acc4[1]) + (acc4[2] + acc4[3]); asm volatile("" ::: "memory"); }
          LDS_WAIT(); asm volatile("" ::: "memory"); __builtin_amdgcn_sched_barrier(0);
#pragma unroll
          for (int t = 0; t < 32; ++t) if (hh == 0) *(LAS bf16*)(L + PR_BI + t * JT_PITCH + 2 * m) = (bf16)f2bf(T[t]);
        }
        LDS_WAIT(); asm volatile("" ::: "memory"); __builtin_amdgcn_sched_barrier(0);
        f32x16 Wk0 = zero16(), Wk1 = zero16(), Wv = zero16();
#pragma unroll
        for (int ks = 0; ks < 2; ++ks) {
            const bf16x8 ft = *(const LAS bf16x8*)(L + PR_BI + m * JT_PITCH + 32 * ks + 16 * hh);
            const bf16x8 fb0 = *(const LAS bf16x8*)(L + PR_KKGT + m * JT_PITCH + 32 * ks + 16 * hh), fb1 = *(const LAS bf16x8*)(L + PR_KKGT + (32 + m) * JT_PITCH + 32 * ks + 16 * hh);
            Wk0 = MFMA32(ft, fb0, Wk0); Wk1 = MFMA32(ft, fb1, Wk1);
            Wv = MFMA32(ld_perm(L + PR_BI + m * JT_PITCH, ks, hh), acc_frag(Akv, ks), Wv);
        }
        __builtin_amdgcn_sched_barrier(0);
        { f32x16 q0 = zero16(), q1 = zero16(), ae = zero16();
#pragma unroll
          for (int ks = 0; ks < 2; ++ks) { const bf16x8 fa = acc_frag(ArbT, ks); q0 = MFMA32(fa, acc_frag(Wk0, ks), q0); q1 = MFMA32(fa, acc_frag(Wk1, ks), q1); ae = MFMA32(fa, acc_frag(Wv, ks), ae); }
          const LAS unsigned char* rgb = L + PR_RG + (4 * hh) * IMG_PITCH + 2 * m; unsigned char* qb = op + ROP_QE + (4 * hh) * 128 + 2 * m; unsigned char* ab = op + ROP_AE + (4 * hh) * 64 + 2 * m;
#pragma unroll
          for (int r = 0; r < 16; ++r) { const int rc = 8 * (r >> 2) + (r & 3);
              const float rg0 = bflo(*(const LAS bf16*)(rgb + rc * IMG_PITCH)), rg1 = bflo(*(const LAS bf16*)(rgb + rc * IMG_PITCH + 64));
              const float v0 = rg0 - q0[r], v1 = rg1 - q1[r], v2 = Ark[r] - ae[r]; const float n0 = dpp_xor1(v0), n1 = dpp_xor1(v1), n2 = dpp_xor1(v2);
              { unsigned c0_ = pk2h_raw(v0, n0), c1_ = pk2h_raw(v1, n1), c2_ = pk2h_raw(v2, n2); if (FENCE_OPS) cvt_fence3(c0_, c1_, c2_); if (!(lane & 1)) { *(unsigned*)(qb + rc * 128) = c0_; *(unsigned*)(qb + rc * 128 + 64) = c1_; *(unsigned*)(ab + rc * 64) = c2_; } } }
        }
        __builtin_amdgcn_sched_barrier(0);
#pragma unroll
        for (int mt = 0; mt < 2; ++mt) {
            f32x16 g0 = zero16(), g1 = zero16(), ke = zero16();
#pragma unroll
            for (int ks = 0; ks < 2; ++ks) { const bf16x8 fa = ld_perm(L + PR_BIT + (32 * mt + m) * JT_PITCH, ks, hh); g0 = MFMA32(fa, acc_frag(Wk0, ks), g0); g1 = MFMA32(fa, acc_frag(Wk1, ks), g1); ke = MFMA32(fa, acc_frag(Wv, ks), ke); }
            const LAS unsigned char* gmb = L + PR_GAM + 4 * (4 * hh); const LAS unsigned char* kib = L + PR_KI + m * IMG_PITCH + 2 * (4 * hh);
            unsigned char* gb = op + ROP_G + (4 * hh) * 128 + 2 * m; unsigned char* kb = op + ROP_KE + (4 * hh) * 64 + 2 * m;
#pragma unroll
            for (int q = 0; q < 4; ++q) { const int jc = 32 * mt + 8 * q; const f32x4 gam = *(const LAS f32x4*)(gmb + 4 * jc); const v2u kiv = *(const LAS v2u*)(kib + 2 * jc); const f32x4 ki4 = unpk4(kiv);
#pragma unroll
                for (int e = 0; e < 4; ++e) { const int r = 4 * q + e, je = jc + e;
                    const float v0 = gam[e] * (((mh == je) ? 1.0f : 0.f) - g0[r]), v1 = gam[e] * (((mh == je - 32) ? 1.0f : 0.f) - g1[r]), v2 = gam[e] * (ki4[e] - ke[r]);
                    const float n0 = dpp_xor1(v0), n1 = dpp_xor1(v1), n2 = dpp_xor1(v2);
                    { unsigned c0_ = pk2h_raw(v0, n0), c1_ = pk2h_raw(v1, n1), c2_ = pk2h_raw(v2, n2); if (FENCE_OPS) cvt_fence3(c0_, c1_, c2_); if (!(lane & 1)) { *(unsigned*)(gb + je * 128) = c0_; *(unsigned*)(gb + je * 128 + 64) = c1_; *(unsigned*)(kb + je * 64) = c2_; } } } }
        }
        LDS_WAIT(); asm volatile("" ::: "memory"); __builtin_amdgcn_sched_barrier(0);
    }
}

struct SeqOpsR { v2u qe[8]; v4u ae[2]; v4u ke[4]; v4u vt[2]; v2u g[16]; };
__device__ __forceinline__ void seqr_load(SeqOpsR& L, const unsigned char* op, const unsigned char* vt, int nt, int lane) {
    const int m = lane & 31, h = lane >> 5;
#pragma unroll
    for (int ks = 0; ks < 4; ++ks) { L.qe[2 * ks] = *(const v2u*)(op + ROP_QE + m * 128 + 2 * (16 * ks + 4 * h)); L.qe[2 * ks + 1] = *(const v2u*)(op + ROP_QE + m * 128 + 2 * (16 * ks + 8 + 4 * h)); }
#pragma unroll
    for (int ks = 0; ks < 2; ++ks) { L.ae[ks] = *(const v4u*)(op + ROP_AE + m * 64 + 2 * (16 * ks + 8 * h)); L.vt[ks] = *(const v4u*)(vt + (32 * nt + m) * 64 + 2 * (16 * ks + 8 * h)); }
#pragma unroll
    for (int mt = 0; mt < 2; ++mt) {
#pragma unroll
        for (int ks = 0; ks < 2; ++ks) L.ke[2 * mt + ks] = *(const v4u*)(op + ROP_KE + (32 * mt + m) * 64 + 2 * (16 * ks + 8 * h));
#pragma unroll
        for (int ks = 0; ks < 4; ++ks) { L.g[8 * mt + 2 * ks] = *(const v2u*)(op + ROP_G + (32 * mt + m) * 128 + 2 * (16 * ks + 4 * h)); L.g[8 * mt + 2 * ks + 1] = *(const v2u*)(op + ROP_G + (32 * mt + m) * 128 + 2 * (16 * ks + 8 + 4 * h)); }
    }
}
__device__ __forceinline__ bf16x8 cat2(v2u a, v2u b) { const v4u p = {a.x, a.y, b.x, b.y}; return __builtin_bit_cast(bf16x8, p); }
__device__ __forceinline__ void phase_seq_rwkv(int unit0, int ustride, int lane, const RopMap& M, bf16* yr, float* out) {
    for (int u = unit0; u < 64 * 2; u += ustride) {
        const int bh = u >> 1, nt = u & 1, b = bh >> 3, h = bh & 7, m = lane & 31, hh = lane >> 5;
        const unsigned char* op0 = rop_ptr(M, bh); const unsigned char* vt0 = rvt_ptr(M, bh);
        f32x16 H0 = zero16(), H1 = zero16();
        bf16x8 HB[4];
#pragma unroll
        for (int i = 0; i < 4; ++i) HB[i] = (bf16x8){0, 0, 0, 0, 0, 0, 0, 0};
        SeqOpsR cur, nxt;
        seqr_load(cur, op0, vt0, nt, lane);
        for (int c = 0; c < 64; ++c) {
            const int cn = (c + 1 < 64) ? c + 1 : c;
            seqr_load(nxt, op0 + (size_t)cn * ROP_STRIDE, vt0 + (size_t)cn * RVT_STRIDE, nt, lane);
            f32x16 O = zero16();
#pragma unroll
            for (int ks = 0; ks < 4; ++ks) O = MFMA32(cat2(cur.qe[2 * ks], cur.qe[2 * ks + 1]), HB[ks], O);
#pragma unroll
            for (int ks = 0; ks < 2; ++ks) O = MFMA32(__builtin_bit_cast(bf16x8, cur.ae[ks]), __builtin_bit_cast(bf16x8, cur.vt[ks]), O);
            const int tokc = b * 2048 + 32 * c;
#pragma unroll
            for (int r = 0; r < 16; ++r) { const int t = 8 * (r >> 2) + 4 * hh + (r & 3); const float v = O[r], nb = dpp_xor1(v);
                if (!(lane & 1)) *(unsigned*)(yr + (size_t)(tokc + t) * 512 + h * 64 + 32 * nt + m) = pk2h(v, nb); }
            f32x16 N0 = zero16(), N1 = zero16();
#pragma unroll
            for (int ks = 0; ks < 4; ++ks) { N0 = MFMA32(cat2(cur.g[2 * ks], cur.g[2 * ks + 1]), HB[ks], N0); N1 = MFMA32(cat2(cur.g[8 + 2 * ks], cur.g[8 + 2 * ks + 1]), HB[ks], N1); }
#pragma unroll
            for (int ks = 0; ks < 2; ++ks) { N0 = MFMA32(__builtin_bit_cast(bf16x8, cur.ke[ks]), __builtin_bit_cast(bf16x8, cur.vt[ks]), N0); N1 = MFMA32(__builtin_bit_cast(bf16x8, cur.ke[2 + ks]), __builtin_bit_cast(bf16x8, cur.vt[ks]), N1); }
            H0 = N0; H1 = N1;
            HB[0] = acc_frag(H0, 0); HB[1] = acc_frag(H0, 1); HB[2] = acc_frag(H1, 0); HB[3] = acc_frag(H1, 1);
            cur = nxt;
        }
        float* st = out + O_WKVP + (size_t)bh * 4096 + (size_t)(32 * nt + m) * 64;
#pragma unroll
        for (int q = 0; q < 4; ++q) { *(f32x4*)(st + 8 * q + 4 * hh) = (f32x4){H0[4 * q], H0[4 * q + 1], H0[4 * q + 2], H0[4 * q + 3]};
            *(f32x4*)(st + 32 + 8 * q + 4 * hh) = (f32x4){H1[4 * q], H1[4 * q + 1], H1[4 * q + 2], H1[4 * q + 3]}; }
    }
}

constexpr int RS_QE = 0, RS_AE = 4608, RS_KE = 7168, RS_G = 12288, RS_VT = 21504, RS_SLOT = 26624;
constexpr int GS_QE = 0, GS_AE = 4608, GS_KE = 7168, GS_VT = 12288, GS_GAM = 22528, GS_SLOT = 22784;
static_assert(4 * RS_SLOT <= RING_BYTES && 4 * GS_SLOT <= RING_BYTES, "seq ring");
__device__ __forceinline__ int rs_piece_off(int p) {
    if (p < 256) return RS_QE + (p >> 3) * 144 + (p & 7) * 16;
    if (p < 384) { const int q = p - 256; return RS_AE + (q >> 2) * 80 + (q & 3) * 16; }
    if (p < 640) { const int q = p - 384; return RS_KE + (q >> 2) * 80 + (q & 3) * 16; }
    if (p < 1152) { const int q = p - 640; return RS_G + (q >> 3) * 144 + (q & 7) * 16; }
    const int q = p - 1152; return RS_VT + (q >> 2) * 80 + (q & 3) * 16;
}
__device__ __forceinline__ int gs_piece_off(int p) {
    if (p < 256) return GS_QE + (p >> 3) * 144 + (p & 7) * 16;
    if (p < 384) { const int q = p - 256; return GS_AE + (q >> 2) * 80 + (q & 3) * 16; }
    if (p < 640) { const int q = p - 384; return GS_KE + (q >> 2) * 80 + (q & 3) * 16; }
    if (p < 656) return GS_GAM + (p - 640) * 16;
    const int q = p - 656; return GS_VT + (q >> 2) * 80 + (q & 3) * 16;
}
template <bool IS_GLA> struct SeqCfg;
template <> struct SeqCfg<false> { static constexpr int NC = 2, NL = 6, NPIECE = 1408, SLOT = RS_SLOT, PPL = 4; };
template <> struct SeqCfg<true>  { static constexpr int NC = 4, NL = 4, NPIECE = 1168, SLOT = GS_SLOT, PPL = 5; };

__device__ __forceinline__ bf16x8 lds_frag(const LAS unsigned char* row, int ks, int h) { return *(const LAS bf16x8*)(row + 32 * ks + 16 * h); }

template <bool IS_GLA, int VAR = 0  >
__device__ __forceinline__ void phase_seq_ring(int head, int wave, int lane, LAS unsigned char* lds, const unsigned char* op0, int op_stride, const unsigned char* vt0, int vt_stride, bf16* yout, float* stout) {
    typedef SeqCfg<IS_GLA> Cfg;
    constexpr int PPL = Cfg::PPL, NLT = Cfg::NL * 64, NREC = IS_GLA ? 656 : 1152;
    if (wave >= Cfg::NC) {
        const int lt = (wave - Cfg::NC) * 64 + lane;
        const unsigned char* src[PPL]; unsigned sst[PPL]; int dst[PPL];
#pragma unroll
        for (int i = 0; i < PPL; ++i) { int p = lt + i * NLT; p = p < Cfg::NPIECE ? p : Cfg::NPIECE - 1; const bool isop = p < NREC;
            src[i] = isop ? op0 + 16 * p : vt0 + 16 * (p - NREC); sst[i] = isop ? (unsigned)op_stride : (unsigned)vt_stride; dst[i] = IS_GLA ? gs_piece_off(p) : rs_piece_off(p); }
        v4u R0[PPL], R1[PPL], R2[PPL], R3[PPL];
#define SEQ_ISSUE(RS, j) do { const int jj_ = (j) < 63 ? (j) : 63; _Pragma("unroll") for (int i = 0; i < PPL; ++i) { if (VAR & 1) RS[i] = (v4u){(unsigned)jj_, 0u, 0u, 0u}; else RS[i] = *(const v4u*)(src[i] + (size_t)jj_ * sst[i]); } } while (0)
#define SEQ_WRITE(RS, s) do { _Pragma("unroll") for (int i = 0; i < PPL; ++i) *(LAS v4u*)(lds + (s) * Cfg::SLOT + dst[i]) = RS[i]; } while (0)
        SEQ_ISSUE(R0, 0); SEQ_ISSUE(R1, 1); SEQ_ISSUE(R2, 2); SEQ_ISSUE(R3, 3);
        SEQ_WRITE(R0, 0); SEQ_ISSUE(R0, 4); SEQ_WRITE(R1, 1); SEQ_ISSUE(R1, 5);
        LDS_BARRIER();
        for (int c4 = 0; c4 < 64; c4 += 4) {
            SEQ_WRITE(R2, 2); SEQ_ISSUE(R2, c4 + 6); LDS_BARRIER();
            SEQ_WRITE(R3, 3); SEQ_ISSUE(R3, c4 + 7); LDS_BARRIER();
            SEQ_WRITE(R0, 0); SEQ_ISSUE(R0, c4 + 8); LDS_BARRIER();
            SEQ_WRITE(R1, 1); SEQ_ISSUE(R1, c4 + 9); LDS_BARRIER();
        }
#undef SEQ_ISSUE
#undef SEQ_WRITE
    } else {
        const int m = lane & 31, hh = lane >> 5, nt = wave;
        const int b = IS_GLA ? (head >> 2) : (head >> 3), h = IS_GLA ? (head & 3) : (head & 7);
        f32x16 H0 = zero16(), H1 = zero16();
        bf16x8 HB[4];
#pragma unroll
        for (int i = 0; i < 4; ++i) HB[i] = (bf16x8){0, 0, 0, 0, 0, 0, 0, 0};
        LDS_BARRIER();
        f32x16 Oprev = zero16();
#define SEQ_STORE_O(OV, cc) do { bf16* yb_ = yout + (size_t)(b * 2048 + 32 * (cc) + 4 * hh + (lane & 1)) * 512 + (IS_GLA ? h * 128 : h * 64) + 32 * nt + (m & ~1); \
            _Pragma("unroll") for (int q = 0; q < 8; ++q) { const float e0 = OV[2 * q], e1 = OV[2 * q + 1]; const bool odd = lane & 1; const float snd = odd ? e0 : e1, rcv = dpp_xor1(snd); \
                *(unsigned*)(yb_ + (size_t)(8 * (q >> 1) + 2 * (q & 1)) * 512) = odd ? pk2h(rcv, e1) : pk2h(e0, rcv); } } while (0)
        for (int c4 = 0; c4 < 64; c4 += 4) {
#pragma unroll
            for (int ci = 0; ci < 4; ++ci) {
                const int c = c4 + ci;
                if (VAR & 2) { LDS_BARRIER(); continue; }
                const LAS unsigned char* S = lds + ci * Cfg::SLOT;
                const LAS unsigned char* qrow = S + RS_QE + m * 144; const LAS unsigned char* arow = S + RS_AE + m * 80;
                const LAS unsigned char* vrow = S + (IS_GLA ? GS_VT : RS_VT) + (32 * nt + m) * 80;
                const LAS unsigned char* k0row = S + RS_KE + m * 80; const LAS unsigned char* k1row = S + RS_KE + (32 + m) * 80;
                const LAS unsigned char* g0row = S + RS_G + m * 144; const LAS unsigned char* g1row = S + RS_G + (32 + m) * 144;
                bf16x8 fq[4], fg0[4], fg1[4];
                f32x4 gm0[4], gm1[4];
#pragma unroll
                for (int ks = 0; ks < 4; ++ks) fq[ks] = ld_perm(qrow, ks, hh);
                if (!IS_GLA) {
#pragma unroll
                    for (int ks = 0; ks < 4; ++ks) { fg0[ks] = ld_perm(g0row, ks, hh); fg1[ks] = ld_perm(g1row, ks, hh); }
                } else {
#pragma unroll
                    for (int q = 0; q < 4; ++q) { gm0[q] = *(const LAS f32x4*)(S + GS_GAM + 4 * (8 * q + 4 * hh)); gm1[q] = *(const LAS f32x4*)(S + GS_GAM + 4 * (32 + 8 * q + 4 * hh)); }
                }
                const bf16x8 fv0 = lds_frag(vrow, 0, hh), fv1 = lds_frag(vrow, 1, hh), fa0 = lds_frag(arow, 0, hh), fa1 = lds_frag(arow, 1, hh);
                const bf16x8 fk00 = lds_frag(k0row, 0, hh), fk01 = lds_frag(k0row, 1, hh), fk10 = lds_frag(k1row, 0, hh), fk11 = lds_frag(k1row, 1, hh);
                __builtin_amdgcn_sched_barrier(0);
                const int cprev = c > 0 ? c - 1 : 0;
                bf16* ybp = yout + (size_t)(b * 2048 + 32 * cprev + 4 * hh + (lane & 1)) * 512 + (IS_GLA ? h * 128 : h * 64) + 32 * nt + (m & ~1);
#define SEQ_PIECE2(qa, qb_) do { const bool odd_ = lane & 1; const float a0_ = Oprev[2 * (qa)], a1_ = Oprev[2 * (qa) + 1], b0_ = Oprev[2 * (qb_)], b1_ = Oprev[2 * (qb_) + 1]; \
                    const float ra_ = dpp_xor1(odd_ ? a0_ : a1_), rb_ = dpp_xor1(odd_ ? b0_ : b1_); \
                    unsigned pa_ = odd_ ? pk2h_raw(ra_, a1_) : pk2h_raw(a0_, ra_), pb_ = odd_ ? pk2h_raw(rb_, b1_) : pk2h_raw(b0_, rb_); if (FENCE_RING) cvt_fence2(pa_, pb_); \
                    *(unsigned*)(ybp + (size_t)(8 * ((qa) >> 1) + 2 * ((qa) & 1)) * 512) = pa_; *(unsigned*)(ybp + (size_t)(8 * ((qb_) >> 1) + 2 * ((qb_) & 1)) * 512) = pb_; } while (0)
                f32x16 O = zero16(), N0, N1;
                if (IS_GLA) {
                    N0 = H0; N1 = H1;
                    O = MFMA32(fq[0], HB[0], O); O = MFMA32(fq[1], HB[1], O);
#pragma unroll
                    for (int q = 0; q < 4; ++q) {
#pragma unroll
                        for (int e = 0; e < 4; ++e) { N0[4 * q + e] *= gm0[q][e]; N1[4 * q + e] *= gm1[q][e]; } }
                    __builtin_amdgcn_sched_barrier(0);
                    O = MFMA32(fq[2], HB[2], O); N0 = MFMA32(fk00, fv0, N0); SEQ_PIECE2(0, 1); __builtin_amdgcn_sched_barrier(0);
                    O = MFMA32(fq[3], HB[3], O); N1 = MFMA32(fk10, fv0, N1); SEQ_PIECE2(2, 3); __builtin_amdgcn_sched_barrier(0);
                    O = MFMA32(fa0, fv0, O); N0 = MFMA32(fk01, fv1, N0); SEQ_PIECE2(4, 5); __builtin_amdgcn_sched_barrier(0);
                    O = MFMA32(fa1, fv1, O); N1 = MFMA32(fk11, fv1, N1); SEQ_PIECE2(6, 7); __builtin_amdgcn_sched_barrier(0);
                } else {
                    N0 = zero16(); N1 = zero16();
                    O = MFMA32(fq[0], HB[0], O); N0 = MFMA32(fg0[0], HB[0], N0); N1 = MFMA32(fg1[0], HB[0], N1); __builtin_amdgcn_sched_barrier(0);
                    O = MFMA32(fq[1], HB[1], O); N0 = MFMA32(fg0[1], HB[1], N0); N1 = MFMA32(fg1[1], HB[1], N1); SEQ_PIECE2(0, 1); __builtin_amdgcn_sched_barrier(0);
                    O = MFMA32(fq[2], HB[2], O); N0 = MFMA32(fg0[2], HB[2], N0); N1 = MFMA32(fg1[2], HB[2], N1); __builtin_amdgcn_sched_barrier(0);
                    O = MFMA32(fq[3], HB[3], O); N0 = MFMA32(fg0[3], HB[3], N0); N1 = MFMA32(fg1[3], HB[3], N1); SEQ_PIECE2(2, 3); __builtin_amdgcn_sched_barrier(0);
                    O = MFMA32(fa0, fv0, O); N0 = MFMA32(fk00, fv0, N0); N1 = MFMA32(fk10, fv0, N1); SEQ_PIECE2(4, 5); __builtin_amdgcn_sched_barrier(0);
                    O = MFMA32(fa1, fv1, O); N0 = MFMA32(fk01, fv1, N0); N1 = MFMA32(fk11, fv1, N1); SEQ_PIECE2(6, 7); __builtin_amdgcn_sched_barrier(0);
                }
#undef SEQ_PIECE2
                H0 = N0; H1 = N1;
                HB[0] = acc_frag(H0, 0); HB[1] = acc_frag(H0, 1); HB[2] = acc_frag(H1, 0); HB[3] = acc_frag(H1, 1);
                Oprev = O;
                LDS_BARRIER();
            }
        }
        if (!(VAR & 2)) SEQ_STORE_O(Oprev, 63);
#undef SEQ_STORE_O
        if (IS_GLA) { float* st = stout + (size_t)head * 8192 + (size_t)(4 * hh) * 128 + 32 * nt + m;
#pragma unroll
            for (int r = 0; r < 16; ++r) { const int dc = 8 * (r >> 2) + (r & 3); st[(size_t)dc * 128] = H0[r]; st[(size_t)(32 + dc) * 128] = H1[r]; }
        } else { float* st = stout + (size_t)head * 4096 + (size_t)(32 * nt + m) * 64 + 4 * hh;
#pragma unroll
            for (int q = 0; q < 4; ++q) { *(f32x4*)(st + 8 * q) = (f32x4){H0[4 * q], H0[4 * q + 1], H0[4 * q + 2], H0[4 * q + 3]}; *(f32x4*)(st + 32 + 8 * q) = (f32x4){H1[4 * q], H1[4 * q + 1], H1[4 * q + 2], H1[4 * q + 3]}; }
        }
    }
    __syncthreads();
}

struct Args { const float* in[N_IN]; float* out; unsigned char* ws; int ph_lo, ph_hi, use_bar, pad; };
#ifndef MK_N_LAUNCHES
#define MK_N_LAUNCHES 1
#endif

__global__ void __launch_bounds__(NWAVES * 64, 2) mega_fwd(Args args) {
    extern __shared__ __attribute__((aligned(16))) unsigned char lds_raw[];
    LAS unsigned char* lds = (LAS unsigned char*)lds_raw;
    volatile LAS unsigned* MISC = (volatile LAS unsigned*)(lds + MISC_OFF);
    const int tid = threadIdx.x, lane = tid & 63, wave = __builtin_amdgcn_readfirstlane(tid >> 6);
    const int G = gridDim.x, bx = blockIdx.x, vcu = (G % 8 == 0) ? (bx % 8) * (G / 8) + bx / 8 : bx;
    const int gw = vcu * NWAVES + wave, NGW = G * NWAVES;
    const float* const* in = args.in; float* out = args.out; unsigned char* ws = args.ws;
    for (int u = tid; u < (LDS_BYTES - LDSCTL_OFF) / 4; u += NWAVES * 64) ((LAS unsigned*)(lds + LDSCTL_OFF))[u] = 0u;
    __syncthreads();
    unsigned* ctl = (unsigned*)(ws + WS_CTL);
    XcdBarrier bar; bar.bar = ctl + CW_BAR; bar.x = 0; bar.st = nullptr; bar.wave = wave;
    if (args.use_bar) bar = xcd_barrier_post(ctl + CW_BAR, MISC + 8, wave);
    const int lo = args.ph_lo, hi = args.ph_hi;
#ifndef PROBE_MASK
#define PROBE_MASK 0
#endif
#ifndef PROBE_SUB
#define PROBE_SUB 0
#endif
#define REPS(k) (1 + ((PROBE_MASK >> (k)) & 1))
#define IN_PH(k) (lo <= (k) && (k) < hi)
#define PH_BEGIN(k) if (IN_PH(k)) { int lane = (int)__builtin_amdgcn_mbcnt_hi(~0u, __builtin_amdgcn_mbcnt_lo(~0u, 0u)); int tid = wave * 64 + lane;   _Pragma("unroll 1") for (int rep_ = 0; rep_ < REPS(k); ++rep_) { if (rep_ > 0) xcd_barrier(bar);
#define PH_END }}
#define SEAM(k) do { if (IN_PH(k) && IN_PH((k) + 1)) xcd_barrier(bar); } while (0)
    unsigned char* slotw = ws + WS_SLOTW;
    unsigned char* lateW = (unsigned char*)out; unsigned char* s5w = lateW + 16 * MiB;
    bf16* w2t = (bf16*)(out + O_REP);
    float* RM = (float*)(ws + WS_RM); bf16* RMB = (bf16*)(ws + WS_RM); bf16* RH = (bf16*)(ws + WS_RH);
    bf16* P = (bf16*)(ws + WS_R2); bf16* gbuf = (bf16*)(ws + WS_R2 + 119 * MiB); bf16* HID = (bf16*)(ws + WS_R2); bf16* UB = (bf16*)(ws + WS_R2);
    bf16* yr = (bf16*)RM; bf16* og = (bf16*)out;
    unsigned char* gopA = ws + WS_RM + 17 * MiB; unsigned char* gopB = ws + WS_RM + 50 * MiB; unsigned char* gvt = ws + WS_RM + 34 * MiB;
    float* wdec = out; bf16* abuf = (bf16*)((unsigned char*)out + 34 * MiB); float* ebuf = (float*)((unsigned char*)out + 51 * MiB);
    bf16* xresb = (bf16*)(ws + WS_RM + 34 * MiB);
    LAS float* scr = (LAS float*)(lds + wave * 16384);

    PH_BEGIN(0) {
        transpose_matrix(in[I_WMIXIN], 1024, NMIX_REAL, NMIX, (bf16*)(slotw + SW_W1T), 0, scr, gw, NGW, lane);
        transpose_matrix(in[I_WMIXOUT], 1024, 1024, 1024, w2t, 0, scr, gw, NGW, lane);
        transpose_matrix(in[I_W2], 64, 512, 512, (bf16*)(slotw + SW_LW2), 0, scr, gw, NGW, lane);
        transpose_matrix(in[I_A2], 64, 512, 512, (bf16*)(slotw + SW_LA2), 0, scr, gw, NGW, lane);
        transpose_matrix(in[I_G2], 128, 512, 512, (bf16*)(slotw + SW_LG2), 0, scr, gw, NGW, lane);
        { bf16* wa2T = (bf16*)(slotw + SW_LWA2); for (int i = bx * (NWAVES * 64) + tid; i < 256 * 16; i += G * NWAVES * 64) { const int n = i >> 4, k = i & 15; wa2T[i] = (bf16)f2bf(in[I_WA2][k * 256 + n]); } }
        rowfix_rows<false, 0, 0, true, 0>(vcu, wave, lane, in[I_XP], in[I_XS], nullptr, nullptr, nullptr, nullptr, nullptr, in[I_NMPRE], RH);
    }
    PH_END
    SEAM(0);
    PH_BEGIN(1) { pg8::Gemm g{RH, (const bf16*)(slotw + SW_W1T), TT, NMIX, 1024}; pg8::StaticOrder S; S.init(TT, NMIX, G, bx, 1024);
        pg8::EpiBf16<0> E{P, NMIX}; pg8::gemm_phase<pg8::EpiBf16<0>, pg8::StaticOrder, true, true>(lds, g, S, E, tid); }
    PH_END
    SEAM(1);
    PH_BEGIN(2) phase_prep<0, 0, NWAVES, 0, TP / 32>(gw, NGW, lane, in, P, (const bf16*)(slotw + SW_LW2), (const bf16*)(slotw + SW_LA2), (const bf16*)(slotw + SW_LG2), (const bf16*)(slotw + SW_LWA2), wdec, abuf, gbuf, ebuf);
    PH_END
    SEAM(2);
#define FFN_WEIGHTS(layer, wb, gw_, NGW_) do { \
        transpose_matrix(in[I_WUP] + (size_t)(layer) * 1024 * 4096, 1024, 4096, 4096, (bf16*)((wb) + SW_UP), 0, scr, gw_, NGW_, lane); \
        transpose_matrix(in[I_WDN] + (size_t)(layer) * 4096 * 1024, 4096, 1024, 1024, (bf16*)((wb) + SW_DN), 0, scr, gw_, NGW_, lane); } while (0)
    RopMap rmap; rmap.a = ws + WS_RM + 17 * MiB; rmap.b = (unsigned char*)RH; rmap.c = slotw + SW_W1T;
    PH_BEGIN(3) {
        if (wave < 4) phase_pre_rwkv(vcu, G, wave, 0, lds, in, P, wdec, abuf, rmap);
        else { phase_prep<0, 1, 4>(vcu * 4 + (wave - 4), G * 4, 0, in, P, (const bf16*)(slotw + SW_LW2), (const bf16*)(slotw + SW_LA2), (const bf16*)(slotw + SW_LG2), (const bf16*)(slotw + SW_LWA2), wdec, abuf, gbuf, ebuf);
            phase_prep<0, 0, 4, TP / 32, TS / 32>(vcu * 4 + (wave - 4), G * 4, 0, in, P, (const bf16*)(slotw + SW_LW2), (const bf16*)(slotw + SW_LA2), (const bf16*)(slotw + SW_LG2), (const bf16*)(slotw + SW_LWA2), wdec, abuf, gbuf, ebuf); } }
    PH_END
    SEAM(3);
    PH_BEGIN(4) {
        const bool do_ring = !(rep_ > 0 && PROBE_SUB == 2), do_scan = !(rep_ > 0 && PROBE_SUB == 1);
        if (bx < 64) { if (do_ring) phase_seq_ring<false>(bx, wave, lane, lds, rop_ptr(rmap, bx), ROP_STRIDE, rvt_ptr(rmap, bx), RVT_STRIDE, yr, out + O_WKVP); }
        else if (do_scan) { ScanCtx C; C.in = in; C.out = out; C.P = P; C.wdec = wdec; C.abuf = abuf; C.ebuf = ebuf; C.yr = yr; C.og = og; C.sb = bx - 64; C.nsb = G - 64; phase_scan<0>(C, lds, tid); }
    }
    PH_END
    SEAM(4);
    PH_BEGIN(5) phase_pre_gla(gw, NGW, lane, lds + wave * 16384, P, ebuf, gopA, gopB, gvt);
    PH_END
    SEAM(5);
    PH_BEGIN(6) { const bool do_ring = !(rep_ > 0 && PROBE_SUB == 2), do_post = !(rep_ > 0 && PROBE_SUB == 1);
        if (bx < 32) { if (do_ring) phase_seq_ring<true>(bx, wave, lane, lds, gop_ptr(gopA, gopB, bx), GOP_STRIDE, gvt + (size_t)bx * 64 * GVT_STRIDE, GVT_STRIDE, og, out + O_GLAP); }
        else if (do_post) { phase_post<true, false>((bx - 32) * NWAVES + wave, (G - 32) * NWAVES, lane, in, out, P, yr, og, abuf, gbuf, RH);
            if (rep_ == 0) FFN_WEIGHTS(0, slotw, (bx - 32) * NWAVES + wave, (G - 32) * NWAVES); } }
    PH_END
    SEAM(6);
    PH_BEGIN(7) phase_post<false, true>(gw, NGW, lane, in, out, P, yr, og, abuf, gbuf, RH);
    PH_END
    SEAM(7);
    PH_BEGIN(8) { pg8::Gemm g{RH, w2t, TT, 1024, 1024}; pg8::SplitOrder S; S.init(TP, TS, 1024, G, bx, 1024, 4);
        pg8::EpiF32 E{RMB, 1024, (float*)(ws + WS_R2), TP, TS}; pg8::gemm_phase<pg8::EpiF32, pg8::SplitOrder, true, true>(lds, g, S, E, tid); }
    PH_END
    SEAM(8);
#define FFN_UP(wb) do { pg8::Gemm g{RH, (const bf16*)((wb) + SW_UP), TT, 4096, 1024}; pg8::StaticOrder S; S.init(TT, 4096, G, bx, 1024); \
        pg8::EpiBf16<3> E{HID, 4096}; pg8::gemm_phase<pg8::EpiBf16<3>, pg8::StaticOrder, true, true>(lds, g, S, E, tid); } while (0)
#define FFN_DOWN(wb) do { pg8::Gemm g{HID, (const bf16*)((wb) + SW_DN), TT, 1024, 4096}; pg8::SplitOrder S; S.init(TP, TS, 1024, G, bx, 4096, 8); \
        pg8::EpiF32 E{RMB, 1024, (float*)RH, TP, TS}; pg8::gemm_phase<pg8::EpiF32, pg8::SplitOrder, true, true>(lds, g, S, E, tid); } while (0)
    PH_BEGIN(9) { rowfix_rows<true, 0, 1, true, 4>(vcu, wave, lane, in[I_XP], in[I_XS], xresb, RMB, (const float*)(ws + WS_R2), in[I_NMPOST], nullptr, in[I_NFPRE], RH); }
    PH_END
    SEAM(9);
    PH_BEGIN(10) { FFN_UP(slotw);
        const int nlast = (TT / 256) * 16 - 4 * G;
        if (G == 256 && bx >= nlast) { const int gw2 = (bx - nlast) * NWAVES + wave, NGW2 = (G - nlast) * NWAVES;
            FFN_WEIGHTS(1, lateW, gw2, NGW2);
            transpose_matrix(in[I_S5WIN], 1024, 1024, 1024, (bf16*)(s5w + SW_S5IN), 0, scr, gw2, NGW2, lane);
            transpose_matrix(in[I_S5WOUT], 1024, 2048, 2048, (bf16*)(s5w + SW_S5OUT), 1, scr, gw2, NGW2, lane);
            s5_tables((bx - nlast) * (NWAVES * 64) + tid, (G - nlast) * NWAVES * 64, in, (f32x2*)(s5w + SW_LAM), (bf16*)(s5w + SW_BOP), (bf16*)(s5w + SW_COP));
            s5_gop((bx - nlast) * (NWAVES * 64) + tid, (G - nlast) * NWAVES * 64, in, (bf16*)(s5w + SW_GOP)); } }
    PH_END
    SEAM(10);
    PH_BEGIN(11) { FFN_DOWN(slotw);
        if (G == 256 && bx >= 128) { s5_wop((bx - 128) * (NWAVES * 64) + tid, (G - 128) * NWAVES * 64, in, (bf16*)(s5w + SW_WOP));
            s5_mop((bx - 128) * (NWAVES * 64) + tid, (G - 128) * NWAVES * 64, in, (bf16*)(s5w + SW_MOP)); } }
    PH_END
    SEAM(11);
    PH_BEGIN(12) {
        rowfix_rows<true, 1, 1, true, 8>(vcu, wave, lane, nullptr, nullptr, xresb, RMB, (const float*)RH, in[I_NFPOST], nullptr, in[I_NMPRE] + 1024, RH);
    }
    PH_END
    SEAM(12);
    PH_BEGIN(13) { pg8::Gemm g{RH, (const bf16*)(s5w + SW_S5IN), TT, 1024, 1024}; pg8::SplitOrder S; S.init(TP, TS, 1024, G, bx, 1024, 4);
        pg8::EpiBf16S E{UB, 1024, (float*)(ws + WS_R2 + 40 * MiB), TP, TS}; pg8::gemm_phase<pg8::EpiBf16S, pg8::SplitOrder, true, true>(lds, g, S, E, tid); }
    PH_END
    SEAM(13);
    PH_BEGIN(14) { S5Ctx C; C.U = UB; C.YG = RH; C.Bop = (const bf16*)(s5w + SW_BOP); C.Cop = (const bf16*)(s5w + SW_COP); C.Lam = (const f32x2*)(s5w + SW_LAM); C.Wop = (const bf16*)(s5w + SW_WOP); C.Gop = (const bf16*)(s5w + SW_GOP); C.Mop = (const bf16*)(s5w + SW_MOP); C.dskip = in[I_S5D]; C.Us = (const float*)(ws + WS_R2 + 40 * MiB);
        phase_s5<0>(C, in, out, lds, tid, vcu, G); }
    PH_END
    SEAM(14);
    PH_BEGIN(15) { pg8::Gemm g{RH, (const bf16*)(s5w + SW_S5OUT), TT, 2048, 1024}; pg8::StaticOrder S; S.init(TT, 2048, G, bx, 1024);
        pg8::EpiGlu E{RMB, 1024}; pg8::gemm_phase<pg8::EpiGlu, pg8::StaticOrder, true, true>(lds, g, S, E, tid); }
    PH_END
    SEAM(15);
    PH_BEGIN(16) { rowfix_rows<true, 1, 1, true, 0>(vcu, wave, lane, nullptr, nullptr, xresb, RMB, nullptr, in[I_NMPOST] + 1024, nullptr, in[I_NFPRE] + 1024, RH); }
    PH_END
    SEAM(16);
    PH_BEGIN(17) FFN_UP(lateW);
    PH_END
    SEAM(17);
    PH_BEGIN(18) FFN_DOWN(lateW);
    PH_END
    SEAM(18);
    PH_BEGIN(19) rowfix_rows<true, 1, 2, false, 8>(vcu, wave, lane, nullptr, nullptr, xresb, RMB, (const float*)RH, in[I_NFPOST] + 1024, out + O_Y, nullptr, nullptr);
    PH_END
#ifdef PROBE_EXTRA
    if (args.use_bar) { xcd_barrier(bar); int lane = (int)__builtin_amdgcn_mbcnt_hi(~0u, __builtin_amdgcn_mbcnt_lo(~0u, 0u)); int tid = wave * 64 + lane;
#if PROBE_EXTRA == 1
        FFN_UP(slotw);
#elif PROBE_EXTRA == 2
        FFN_DOWN(slotw);
#elif PROBE_EXTRA == 3
        { pg8::Gemm g{RH, (const bf16*)(slotw), TT, NMIX, 1024}; pg8::StaticOrder S; S.init(TT, NMIX, G, bx, 1024); pg8::EpiBf16<0> E{P, NMIX}; pg8::gemm_phase<pg8::EpiBf16<0>, pg8::StaticOrder, true, true>(lds, g, S, E, tid); }
#elif PROBE_EXTRA >= 10 && PROBE_EXTRA < 20
        { ScanCtx C; C.in = in; C.out = (float*)(ws + WS_R2); C.P = P; C.wdec = (float*)(ws + WS_RM); C.abuf = (bf16*)(ws + WS_RH); C.ebuf = (float*)(ws + WS_RM); C.yr = (bf16*)(ws + WS_RH); C.og = (bf16*)(ws + WS_RH); C.sb = bx; C.nsb = G; phase_scan<PROBE_EXTRA - 10>(C, lds, tid); }
#elif PROBE_EXTRA >= 40 && PROBE_EXTRA < 44
        phase_prep<PROBE_EXTRA - 40>(gw, NGW, lane, in, P, (const bf16*)(slotw + SW_LW2), (const bf16*)(slotw + SW_LA2), (const bf16*)(slotw + SW_LG2), (const bf16*)(slotw + SW_LWA2), (float*)(ws + WS_RM), (bf16*)(ws + WS_RM + 36 * MiB), (bf16*)(ws + WS_RH), (float*)(ws + WS_R2 + 100 * MiB));
#elif PROBE_EXTRA == 5
        for (int i_ = 0; i_ < 20; ++i_) xcd_barrier(bar);
#elif PROBE_EXTRA == 6
        phase_post<true, true>(gw, NGW, lane, in, (float*)(ws + WS_R2), P, yr, og, abuf, gbuf, RH);
#elif PROBE_EXTRA == 7
        rowfix_rows<true, 1, 1, true, 0>(vcu, wave, lane, nullptr, nullptr, (bf16*)(ws + WS_R2), RMB, nullptr, in[I_NMPOST], nullptr, in[I_NFPRE], RH);
#elif PROBE_EXTRA == 8
        FFN_WEIGHTS(1, slotw, gw, NGW);
#elif PROBE_EXTRA == 20
        if (bx < 32) phase_seq_ring<true>(bx, wave, lane, lds, gop_ptr(gopA, gopB, bx), GOP_STRIDE, gvt + (size_t)bx * 64 * GVT_STRIDE, GVT_STRIDE, (bf16*)(ws + WS_R2), (float*)(ws + WS_R2 + 64 * MiB));
#elif PROBE_EXTRA == 23 || PROBE_EXTRA == 24
        if (bx < 64) phase_seq_ring<false, PROBE_EXTRA - 22>(bx, wave, lane, lds, rop_ptr(rmap, bx), ROP_STRIDE, rvt_ptr(rmap, bx), RVT_STRIDE, (bf16*)(ws + WS_R2), (float*)(ws + WS_R2 + 64 * MiB));
#elif PROBE_EXTRA == 21
        if (bx < 64) phase_seq_ring<false>(bx, wave, lane, lds, rop_ptr(rmap, bx), ROP_STRIDE, rvt_ptr(rmap, bx), RVT_STRIDE, (bf16*)(ws + WS_R2), (float*)(ws + WS_R2 + 64 * MiB));
#elif PROBE_EXTRA == 30 || PROBE_EXTRA == 31 || PROBE_EXTRA == 33
        { S5Ctx C; C.U = UB; C.YG = (bf16*)(ws + WS_R2 + 64 * MiB); C.Bop = (const bf16*)(s5w + SW_BOP); C.Cop = (const bf16*)(s5w + SW_COP); C.Lam = (const f32x2*)(s5w + SW_LAM); C.Wop = (const bf16*)(s5w + SW_WOP); C.Gop = (const bf16*)(s5w + SW_GOP); C.Mop = (const bf16*)(s5w + SW_MOP); C.dskip = in[I_S5D]; C.Us = (const float*)(ws + WS_R2 + 40 * MiB);
          phase_s5<PROBE_EXTRA == 30 ? 2 : (PROBE_EXTRA == 31 ? 1 : 5)>(C, in, (float*)(ws + WS_R2 + 100 * MiB) - O_REP, lds, tid, vcu, G); }
#elif PROBE_EXTRA == 32
        { RopMap dm; dm.a = ws + WS_R2; dm.b = ws + WS_R2 + 60 * MiB; dm.c = ws + WS_R2 + 100 * MiB; phase_pre_rwkv(vcu, G, wave, lane, lds, in, P, (const float*)(ws + WS_RM), (const bf16*)(ws + WS_RM), dm); }
#elif PROBE_EXTRA == 22
        if (bx >= 64) { ScanCtx C; C.in = in; C.out = (float*)(ws + WS_R2); C.P = P; C.wdec = (float*)(ws + WS_RM); C.abuf = (bf16*)(ws + WS_RH); C.ebuf = (float*)(ws + WS_RM); C.yr = (bf16*)(ws + WS_RH); C.og = (bf16*)(ws + WS_RH); C.sb = bx - 64; C.nsb = G - 64; phase_scan<0>(C, lds, tid); }
#elif PROBE_EXTRA == 4
        { pg8::Gemm g{RH, (const bf16*)(slotw), TT, 1024, 1024}; pg8::StaticOrder S; S.init(TT, 1024, G, bx, 1024); pg8::EpiF32 E{RMB, 1024, nullptr, 0, 0}; pg8::gemm_phase<pg8::EpiF32, pg8::StaticOrder, true, true>(lds, g, S, E, tid); }
#endif
    }
#endif
}

extern "C" void kernel_launch(void* const* d_in, const int* in_sizes, int n_in, void* d_out, int out_size, void* d_ws, size_t ws_size, hipStream_t stream) {
    static int grid = 0;
    if (grid == 0) {
        if (n_in != N_IN || out_size != (int)O_END || ws_size < WS_END) { fprintf(stderr, "kernel_launch: unexpected problem shape (n_in %d, out %d, ws %zu); nothing launched\n", n_in, out_size, ws_size); grid = -1; return; }
        int dev = 0, cus = 0, per_cu = 0;
        if (hipGetDevice(&dev) != hipSuccess || hipDeviceGetAttribute(&cus, hipDeviceAttributeMultiprocessorCount, dev) != hipSuccess) { grid = -1; return; }
        if (hipFuncSetAttribute((const void*)mega_fwd, hipFuncAttributeMaxDynamicSharedMemorySize, LDS_BYTES) != hipSuccess) { fprintf(stderr, "kernel_launch: hipFuncSetAttribute failed\n"); grid = -1; return; }
        if (hipOccupancyMaxActiveBlocksPerMultiprocessor(&per_cu, (const void*)mega_fwd, NWAVES * 64, LDS_BYTES) != hipSuccess || per_cu < 1) { fprintf(stderr, "kernel_launch: occupancy query reports %d blocks per CU\n", per_cu); per_cu = 0; }
        (void)hipGetLastError();
        if (cus < 256 || per_cu < 1) { fprintf(stderr, "kernel_launch: needs 256 CUs with one resident workgroup each (cus %d, per_cu %d); nothing launched\n", cus, per_cu); grid = -1; return; }
        grid = 256;
    }
    if (grid < 0) return;
    if (hipMemsetAsync((char*)d_ws + WS_CTL, 0, CTL_ZERO_BYTES, stream) != hipSuccess) return;
    Args a{};
    for (int i = 0; i < N_IN; ++i) a.in[i] = (const float*)d_in[i];
    a.out = (float*)d_out; a.ws = (unsigned char*)d_ws;
#if MK_N_LAUNCHES == 1
    a.ph_lo = 0; a.ph_hi = N_PHASES; a.use_bar = 1;
    { void* kargs[] = {&a}; hipError_t e = hipLaunchCooperativeKernel((const void*)mega_fwd, dim3(grid), dim3(NWAVES * 64), kargs, LDS_BYTES, stream);
      if (e != hipSuccess) fprintf(stderr, "kernel_launch: cooperative launch failed: %s\n", hipGetErrorString(e)); }
#else
    for (int li = 0; li < N_PHASES; ++li) { a.ph_lo = li; a.ph_hi = li + 1; a.use_bar = 0;
        hipLaunchKernelGGL(mega_fwd, dim3(grid), dim3(NWAVES * 64), LDS_BYTES, stream, a); }
#endif
}
```
